# Optimizing an MI355X kernel written in HIP

```python
import jax, jax.numpy as jnp
from jax import lax
import numpy as np

D_MODEL = 4096
BATCH = 2
SEQ = 4096
DEPTH = 1
DEC_BATCH = 2
DEC_SEQ = 8192
PAST_LEN = 128

HEAD_DIM = 128
N_HEADS = D_MODEL // HEAD_DIM
N_KV_HEADS = N_HEADS // 4
Q_BLOCK = 128
ROPE_THETA = 10000.0
GRID_W = 64
ATT_WIDTH = N_HEADS * HEAD_DIM
KV_WIDTH = N_KV_HEADS * HEAD_DIM
N_FGROUPS = 8
FGROUP_DIM = D_MODEL // 16
F_WIDTH = N_FGROUPS * FGROUP_DIM
SPLITS = [int(v) for v in np.cumsum([ATT_WIDTH, KV_WIDTH, KV_WIDTH, F_WIDTH, D_MODEL])]
IN_WIDTH = ATT_WIDTH + 2 * KV_WIDTH + F_WIDTH + 2 * D_MODEL
PEER_HEADS = 8
PEER_NKEYS = 128
PEER_N = PEER_NKEYS * PEER_NKEYS
PEER_DKEY = 256
PEER_HALF = PEER_DKEY // 2
PEER_TOPK = 16
TOKEN_BLOCK = 128
EPS = 1e-6

kernel_name = 'hybrid_gqa_fnet_peer_encoder'


def rmsnorm(x, g):
    xf = x.astype(jnp.float32)
    y = xf * lax.rsqrt(jnp.mean(xf * xf, axis=-1, keepdims=True) + EPS)
    return (y * g.astype(jnp.float32)).astype(x.dtype)


def axial_rope_tables(seq_len):
    rows = seq_len // GRID_W
    row_ids = jnp.repeat(jnp.arange(rows), GRID_W).astype(jnp.float32)
    col_ids = jnp.tile(jnp.arange(GRID_W), rows).astype(jnp.float32)
    axis_dim = HEAD_DIM // 2
    inv_freq = ROPE_THETA ** (-jnp.arange(0, axis_dim, 2, dtype=jnp.float32) / axis_dim)
    ang = jnp.concatenate([row_ids[:, None] * inv_freq, col_ids[:, None] * inv_freq], axis=-1)
    return jnp.cos(ang), jnp.sin(ang)


def apply_rope(x, cos, sin):
    xf = x.astype(jnp.float32).reshape(x.shape[:-1] + (HEAD_DIM // 2, 2))
    x1, x2 = xf[..., 0], xf[..., 1]
    c = cos[None, :, None, :]
    s = sin[None, :, None, :]
    out = jnp.stack([x1 * c - x2 * s, x1 * s + x2 * c], axis=-1).reshape(x.shape)
    return out.astype(x.dtype)


def block_attention(q, k, v):
    b, s = q.shape[0], q.shape[1]
    grp = N_HEADS // N_KV_HEADS
    nblk = s // Q_BLOCK
    qb = q.reshape(b, nblk, Q_BLOCK, N_KV_HEADS, grp, HEAD_DIM).transpose(1, 0, 2, 3, 4, 5)
    scale = HEAD_DIM ** -0.5

    def one_block(qblk):
        sc = jnp.einsum('bqhgd,bkhd->bhgqk', qblk, k, preferred_element_type=jnp.float32) * scale
        p = jax.nn.softmax(sc, axis=-1).astype(v.dtype)
        return jnp.einsum('bhgqk,bkhd->bqhgd', p, v)

    out = lax.map(one_block, qb)
    return out.transpose(1, 0, 2, 3, 4, 5).reshape(b, s, ATT_WIDTH)


def fourier_mix(u):
    b, s = u.shape[0], u.shape[1]
    ug = u.astype(jnp.float32).reshape(b, s, N_FGROUPS, FGROUP_DIM)
    y = jnp.fft.fftn(ug, axes=(1, 3), norm='ortho').real
    return y.reshape(b, s, F_WIDTH).astype(u.dtype)


def peer_ffn(h, w_q, keys, u_tab, v_tab):
    b, s, d = h.shape
    t = b * s
    hf = h.reshape(t, d)
    q = (hf @ w_q).reshape(t, PEER_HEADS, 2, PEER_HALF)
    sc = jnp.einsum('thpc,hpnc->thpn', q, keys).astype(jnp.float32)
    top_v, top_i = lax.top_k(sc, PEER_TOPK)
    cand_v = top_v[:, :, 0, :, None] + top_v[:, :, 1, None, :]
    cand_i = top_i[:, :, 0, :, None] * PEER_NKEYS + top_i[:, :, 1, None, :]
    kk = PEER_TOPK * PEER_TOPK
    best_v, best_pos = lax.top_k(cand_v.reshape(t, PEER_HEADS, kk), PEER_TOPK)
    best_i = jnp.take_along_axis(cand_i.reshape(t, PEER_HEADS, kk), best_pos, axis=-1)
    gates = jax.nn.softmax(best_v, axis=-1)
    n_sel = PEER_HEADS * PEER_TOPK
    idx = best_i.reshape(t, n_sel).astype(jnp.int32)
    gw = gates.reshape(t, n_sel).astype(h.dtype)
    nblk = t // TOKEN_BLOCK

    def one_block(args):
        xb, ib, gb = args
        ub = jnp.take(u_tab, ib, axis=0)
        act = jax.nn.gelu(jnp.einsum('td,ted->te', xb, ub), approximate=False)
        vb = jnp.take(v_tab, ib, axis=0)
        return jnp.einsum('te,ted->td', act * gb, vb)

    out = lax.map(one_block, (hf.reshape(nblk, TOKEN_BLOCK, d),
                              idx.reshape(nblk, TOKEN_BLOCK, n_sel),
                              gw.reshape(nblk, TOKEN_BLOCK, n_sel)))
    return out.reshape(b, s, d)


def encoder_layer(x, c, cos, sin, w_ada, b_ada, norm1_g, norm2_g, w_in, q_norm_g, k_norm_g,
                  w_attn_br, w_four_br, w_out, w_peer_q, peer_keys, peer_u, peer_v):
    b, s, _ = x.shape
    mod = (jax.nn.silu(c) @ w_ada + b_ada)[:, None, :]
    sh1, sc1, g1, sh2, sc2, g2 = jnp.split(mod, 6, axis=-1)

    h = rmsnorm(x, norm1_g) * (1.0 + sc1) + sh1
    proj = h @ w_in
    q, k, v, f, ga, gf = jnp.split(proj, SPLITS, axis=-1)
    q = apply_rope(rmsnorm(q.reshape(b, s, N_HEADS, HEAD_DIM), q_norm_g), cos, sin)
    k = apply_rope(rmsnorm(k.reshape(b, s, N_KV_HEADS, HEAD_DIM), k_norm_g), cos, sin)
    v = v.reshape(b, s, N_KV_HEADS, HEAD_DIM)
    a_br = block_attention(q, k, v) @ w_attn_br
    f_br = fourier_mix(f) @ w_four_br
    merged = jax.nn.sigmoid(ga) * a_br + jax.nn.sigmoid(gf) * f_br
    x = x + g1 * (merged @ w_out)

    h2 = rmsnorm(x, norm2_g) * (1.0 + sc2) + sh2
    x = x + g2 * peer_ffn(h2, w_peer_q, peer_keys, peer_u, peer_v)
    return x


def run_trunk(x, c, w_ada, b_ada, norm1_g, norm2_g, w_in, q_norm_g, k_norm_g, w_attn_br,
              w_four_br, w_out, w_peer_q, peer_keys, peer_u, peer_v, final_g):
    cos, sin = axial_rope_tables(x.shape[1])
    for l in range(DEPTH):
        x = encoder_layer(x, c, cos, sin, w_ada[l], b_ada[l], norm1_g[l], norm2_g[l], w_in[l],
                          q_norm_g[l], k_norm_g[l], w_attn_br[l], w_four_br[l], w_out[l],
                          w_peer_q[l], peer_keys[l], peer_u[l], peer_v[l])
    return rmsnorm(x, final_g)


def setup_inputs(seed: int = 0) -> dict:
    key = jax.random.key(seed)
    ks = jax.random.split(key, 20)
    f32 = jnp.float32
    nrm = lambda k, shape, sc: jax.random.normal(k, shape, f32) * sc
    gain = lambda k, shape: 1.0 + 0.02 * jax.random.normal(k, shape, f32)
    L, D = DEPTH, D_MODEL
    return {
        'x_prompt': nrm(ks[0], (BATCH, SEQ, D), 1.0),
        'x_sample': nrm(ks[1], (DEC_BATCH, DEC_SEQ, D), 1.0),
        'c_prompt': nrm(ks[2], (BATCH, D), 1.0),
        'c_sample': nrm(ks[3], (DEC_BATCH, D), 1.0),
        'w_ada': nrm(ks[4], (L, D, 6 * D), 0.5 * D ** -0.5),
        'b_ada': nrm(ks[5], (L, 6 * D), 0.01),
        'norm1_g': gain(ks[6], (L, D)),
        'norm2_g': gain(ks[7], (L, D)),
        'w_in': nrm(ks[8], (L, D, IN_WIDTH), D ** -0.5),
        'q_norm_g': gain(ks[9], (L, HEAD_DIM)),
        'k_norm_g': gain(ks[10], (L, HEAD_DIM)),
        'w_attn_br': nrm(ks[11], (L, ATT_WIDTH, D), ATT_WIDTH ** -0.5),
        'w_four_br': nrm(ks[12], (L, F_WIDTH, D), F_WIDTH ** -0.5),
        'w_out': nrm(ks[13], (L, D, D), D ** -0.5),
        'w_peer_q': nrm(ks[14], (L, D, PEER_HEADS * PEER_DKEY), D ** -0.5),
        'peer_keys': nrm(ks[15], (L, PEER_HEADS, 2, PEER_NKEYS, PEER_HALF), PEER_HALF ** -0.5),
        'peer_u': nrm(ks[16], (L, PEER_N, D), D ** -0.5),
        'peer_v': nrm(ks[17], (L, PEER_N, D), PEER_HEADS ** -0.5),
        'final_g': gain(ks[18], (D,)),
    }


def reference(x_prompt, x_sample, c_prompt, c_sample, w_ada, b_ada, norm1_g, norm2_g, w_in,
              q_norm_g, k_norm_g, w_attn_br, w_four_br, w_out, w_peer_q, peer_keys, peer_u,
              peer_v, final_g):
    y_prompt = run_trunk(x_prompt, c_prompt, w_ada, b_ada, norm1_g, norm2_g, w_in, q_norm_g,
                         k_norm_g, w_attn_br, w_four_br, w_out, w_peer_q, peer_keys, peer_u,
                         peer_v, final_g)
    y_sample = run_trunk(x_sample, c_sample, w_ada, b_ada, norm1_g, norm2_g, w_in, q_norm_g,
                         k_norm_g, w_attn_br, w_four_br, w_out, w_peer_q, peer_keys, peer_u,
                         peer_v, final_g)
    return (y_prompt, y_sample)
```

```cpp
#include <hip/hip_runtime.h>
#include <hip/hip_bf16.h>
#include <cstdio>
#include <cstdint>

#define GAS __attribute__((address_space(1)))
#define LAS __attribute__((address_space(3)))
typedef unsigned short bf16_t;
typedef short bf16x8 __attribute__((ext_vector_type(8)));
typedef short s16x4 __attribute__((ext_vector_type(4)));
typedef float f32x2 __attribute__((ext_vector_type(2)));
typedef float f32x4 __attribute__((ext_vector_type(4)));
typedef float f32x16 __attribute__((ext_vector_type(16)));
typedef unsigned u32x2 __attribute__((ext_vector_type(2)));
typedef unsigned u32x4 __attribute__((ext_vector_type(4)));
typedef unsigned u32x6 __attribute__((ext_vector_type(6)));
typedef int i32x8 __attribute__((ext_vector_type(8)));
typedef float f32x32 __attribute__((ext_vector_type(32)));

constexpr int DM = 4096;
constexpr int SP = 4096, SS = 8192;
constexpr int TP = 2 * SP, TS = 2 * SS, TT = TP + TS;
constexpr int NIN = 16384;
constexpr int HD = 128, NH = 32, NKV = 8;
constexpr int FW = 2048, FG = 256, NFG = 8;
constexpr int PH = 8, PNK = 128, PHALF = 128, PTOPK = 16, PQW = 2048, NSEL = 128, PN = 16384;
constexpr float EPS = 1e-6f;
constexpr int PROW = 3072;

__device__ __forceinline__ int cb_of_row(int m) { return m < SP ? 0 : (m < TP ? 1 : (m < TP + SS ? 2 : 3)); }

__device__ __forceinline__ unsigned cvt_pk_bf16(float lo, float hi) { unsigned r; asm volatile("v_cvt_pk_bf16_f32 %0, %1, %2" : "=v"(r) : "v"(lo), "v"(hi)); return r; }
__device__ __forceinline__ float bf_lo(unsigned w) { return __uint_as_float(w << 16); }
__device__ __forceinline__ float bf_hi(unsigned w) { return __uint_as_float(w & 0xffff0000u); }
__device__ __forceinline__ u32x4 pack8(f32x4 v0, f32x4 v1) { u32x4 w; w.x = cvt_pk_bf16(v0[0], v0[1]); w.y = cvt_pk_bf16(v0[2], v0[3]); w.z = cvt_pk_bf16(v1[0], v1[1]); w.w = cvt_pk_bf16(v1[2], v1[3]); return w; }
__device__ __forceinline__ void unpack8(u32x4 w, f32x4& v0, f32x4& v1) { v0 = (f32x4){bf_lo(w.x), bf_hi(w.x), bf_lo(w.y), bf_hi(w.y)}; v1 = (f32x4){bf_lo(w.z), bf_hi(w.z), bf_lo(w.w), bf_hi(w.w)}; }
__device__ __forceinline__ void unpack8_fp8(u32x2 w, f32x4& v0, f32x4& v1) {
    const f32x2 a = __builtin_amdgcn_cvt_pk_f32_fp8((int)w.x, false), b = __builtin_amdgcn_cvt_pk_f32_fp8((int)w.x, true);
    const f32x2 c = __builtin_amdgcn_cvt_pk_f32_fp8((int)w.y, false), d = __builtin_amdgcn_cvt_pk_f32_fp8((int)w.y, true);
    v0 = (f32x4){a[0], a[1], b[0], b[1]}; v1 = (f32x4){c[0], c[1], d[0], d[1]}; }
__device__ __forceinline__ void unpack8_u8(u32x2 w, f32x4& v0, f32x4& v1) {
    v0 = (f32x4){(float)(w.x & 0xffu), (float)((w.x >> 8) & 0xffu), (float)((w.x >> 16) & 0xffu), (float)(w.x >> 24)};
    v1 = (f32x4){(float)(w.y & 0xffu), (float)((w.y >> 8) & 0xffu), (float)((w.y >> 16) & 0xffu), (float)(w.y >> 24)}; }
__device__ __forceinline__ u32x2 pack8_u8(f32x4 y0, f32x4 y1) {
    unsigned w0 = 0u, w1 = 0u;
#pragma unroll
    for (int i = 0; i < 4; ++i) { w0 = __builtin_amdgcn_cvt_pk_u8_f32(y0[i], (unsigned)i, w0); w1 = __builtin_amdgcn_cvt_pk_u8_f32(y1[i], (unsigned)i, w1); }
    return (u32x2){w0, w1}; }
__device__ __forceinline__ float sigmoidf_(float v) { return __builtin_amdgcn_rcpf(1.0f + __builtin_amdgcn_exp2f(-1.4426950408889634f * v)); }

__device__ __forceinline__ int opaque_tid(const int wave) { int l = (int)__builtin_amdgcn_mbcnt_hi(~0u, __builtin_amdgcn_mbcnt_lo(~0u, 0u)); asm volatile("" : "+v"(l)); return (wave << 6) | l; }

namespace pg8 {
#define PG8_LAS __attribute__((address_space(3)))
constexpr int BM = 256, BK = 64, HALF = 128, HTB = HALF * BK * 2  , STAGE_BYTES = 8 * HTB, NXCD = 8, WGM = 8;

__host__ __device__ __forceinline__ int lds_byte(int r, int c) { const int st = (r >> 4) * 2 + (c >> 5), rr = r & 15, cc = c & 31, ob = rr * 64 + cc * 2; return st * 1024 + (ob ^ (((ob >> 9) & 1) << 5)); }
__host__ __device__ __forceinline__ void stage_rc(int b, int& R, int& C) { const int st = b / 1024, sb = b % 1024, swz = sb ^ (((sb >> 9) & 1) << 5); R = (st >> 1) * 16 + swz / 64; C = (st & 1) * 32 + (swz % 64) / 2; }
__host__ __device__ __forceinline__ int perm32(int rho) { const int n = rho >> 4, i = rho & 15; return 8 * (i >> 2) + 4 * n + (i & 3); }

struct Unit { int pm, pn; };

struct StaticOrder {
    int nM, nN, nwg, G, c;
    __host__ __device__ void init(int M, int N, int G_, int c_) { nM = M / BM; nN = N / BM; nwg = nM * nN; G = G_; c = c_; }
    __host__ __device__ bool next(int i, Unit& u) const {
        const long L = (long)i * G + c; if (L >= nwg) return false;
        int wgid = (int)L; { const int q = nwg / NXCD, r = nwg % NXCD, xcd = wgid % NXCD, off = wgid / NXCD; wgid = (xcd < r ? xcd * (q + 1) : r * (q + 1) + (xcd - r) * q) + off; }
        const int nig = WGM * nN, gid = wgid / nig, fm = gid * WGM, gsz = (nM - fm) < WGM ? (nM - fm) : WGM;
        u.pm = fm + ((wgid % nig) % gsz); u.pn = (wgid % nig) / gsz; return true;
    }
};

struct GemmPlain {
    const bf16_t* A; const bf16_t* Bt; int K, lda, ldb;
    __device__ __forceinline__ const char* a_ptr(const Unit& u) const { return (const char*)A + (size_t)u.pm * BM * lda * 2; }
    __device__ __forceinline__ const char* b_ptr(const Unit& u) const { return (const char*)Bt + (size_t)u.pn * BM * ldb * 2; }
    __device__ __forceinline__ int b_rowoff(int Rb) const { return Rb; }
    __device__ __forceinline__ size_t b_hstep() const { return (size_t)HALF * ldb * 2; }
};

template <class Epi, class Ops, bool ALIGN_EPI = true, bool SP2 = true, bool FP8 = false>
__device__ __forceinline__ void gemm_phase(PG8_LAS unsigned char* lds, const Ops g, const StaticOrder& S, const Epi& E, const int wave) {
    const int tid = opaque_tid(wave), wid = wave, lane = tid & 63, wr = wid >> 2, wc = wid & 3, fr = lane & 15, fq = lane >> 4;
    const int K = g.K, nt = K / BK;
    unsigned voffA[2], voffB[2];
#pragma unroll
    for (int i = 0; i < 2; ++i) { int R, C; stage_rc(tid * 16 + i * 8192, R, C); const int Rb = ((R & ~31) + perm32(R & 31));
        voffA[i] = (unsigned)(R * g.lda + C) * 2u; voffB[i] = (unsigned)(g.b_rowoff(Rb) * g.ldb + C) * 2u; }
    const size_t kstep = (size_t)(BK * 2);
    const size_t hstepA = (size_t)HALF * g.lda * 2, hstepB = g.b_hstep();
    const unsigned ldsw = (unsigned)wid * 1024u;
    const int aoff = FP8 ? lds_byte(wr * 64 + fr, 16 * fq) : lds_byte(wr * 64 + fr, fq * 8), boff = FP8 ? lds_byte(wc * 32 + fr, 16 * fq) : lds_byte(wc * 32 + fr, fq * 8);
    const int aoff1 = lds_byte(wr * 64 + fr, 16 * fq + 8), boff1 = lds_byte(wc * 32 + fr, 16 * fq + 8);
#define PG8_SA(b, h) (((b) * 2 + (h)) * HTB)
#define PG8_SB(b, h) ((4 + (b) * 2 + (h)) * HTB)
#define PG8_STAGE(bufoff, gbase, voff) do { _Pragma("unroll") for (int _i = 0; _i < 2; ++_i) \
        __builtin_amdgcn_global_load_lds((const unsigned*)((const char*)(gbase) + (voff)[_i]), (PG8_LAS unsigned*)(lds + (bufoff) + ldsw + _i * 8192), 16, 0, 0); } while (0)
#define PG8_LDA(dst, b, h) do { if constexpr (FP8) { _Pragma("unroll") for (int m = 0; m < 4; ++m) { const u32x4 _l = *(const PG8_LAS u32x4*)(lds + PG8_SA(b, h) + aoff + m * 2048), _h = *(const PG8_LAS u32x4*)(lds + PG8_SA(b, h) + aoff1 + m * 2048); \
            dst##8[m] = (i32x8){(int)_l.x, (int)_l.y, (int)_l.z, (int)_l.w, (int)_h.x, (int)_h.y, (int)_h.z, (int)_h.w}; } } \
        else { _Pragma("unroll") for (int m = 0; m < 4; ++m) _Pragma("unroll") for (int k = 0; k < 2; ++k) dst[m][k] = *(const PG8_LAS bf16x8*)(lds + PG8_SA(b, h) + aoff + m * 2048 + k * 1024); } } while (0)
#define PG8_LDB(dst, b, h) do { if constexpr (FP8) { _Pragma("unroll") for (int n = 0; n < 2; ++n) { const u32x4 _l = *(const PG8_LAS u32x4*)(lds + PG8_SB(b, h) + boff + n * 2048), _h = *(const PG8_LAS u32x4*)(lds + PG8_SB(b, h) + boff1 + n * 2048); \
            dst##8[n] = (i32x8){(int)_l.x, (int)_l.y, (int)_l.z, (int)_l.w, (int)_h.x, (int)_h.y, (int)_h.z, (int)_h.w}; } } \
        else { _Pragma("unroll") for (int n = 0; n < 2; ++n) _Pragma("unroll") for (int k = 0; k < 2; ++k) dst[n][k] = *(const PG8_LAS bf16x8*)(lds + PG8_SB(b, h) + boff + n * 2048 + k * 1024); } } while (0)
#define PG8_MMA(ai, bj, At, Bt) do { __builtin_amdgcn_s_setprio(1); if constexpr (FP8) { _Pragma("unroll") for (int m = 0; m < 4; ++m) _Pragma("unroll") for (int n = 0; n < 2; ++n) \
            asm volatile("v_mfma_scale_f32_16x16x128_f8f6f4 %0, %1, %2, %0, %3, %3 op_sel_hi:[0,0,0]" : "+v"(acc[ai][bj][m][n]) : "v"(Bt##8[n]), "v"(At##8[m]), "v"(one_scale)); } \
        else { _Pragma("unroll") for (int m = 0; m < 4; ++m) _Pragma("unroll") for (int n = 0; n < 2; ++n) _Pragma("unroll") for (int k = 0; k < 2; ++k) \
            acc[ai][bj][m][n] = __builtin_amdgcn_mfma_f32_16x16x32_bf16(Bt[n][k], At[m][k], acc[ai][bj][m][n], 0, 0, 0); } __builtin_amdgcn_s_setprio(0); } while (0)
#define PG8_WAIT_V(n) asm volatile("s_waitcnt vmcnt(" #n ")" ::: "memory")
#define PG8_WAIT_L(n) asm volatile("s_waitcnt lgkmcnt(" #n ")" ::: "memory")
#define PG8_BAR __builtin_amdgcn_s_barrier()
#define PG8_SCHED __builtin_amdgcn_sched_barrier(0)
    Unit cur, nxt; int ui = 0;
    if (!S.next(0, cur)) return;
    f32x4 acc[2][2][4][2];
#pragma unroll
    for (int a = 0; a < 2; ++a)
#pragma unroll
        for (int b = 0; b < 2; ++b)
#pragma unroll
            for (int m = 0; m < 4; ++m)
#pragma unroll
                for (int n = 0; n < 2; ++n) acc[a][b][m][n] = (f32x4){0.f, 0.f, 0.f, 0.f};
    bf16x8 At[4][2], B0[2][2], B1[2][2]; i32x8 At8[4], B08[2], B18[2];
    const int one_scale = 0x7F7F7F7F;
    const char* cA = g.a_ptr(cur); const char* cB = g.b_ptr(cur);
    if constexpr (SP2) {
        PG8_STAGE(PG8_SB(0, 0), cB, voffB); PG8_STAGE(PG8_SB(0, 1), cB + hstepB, voffB); PG8_STAGE(PG8_SA(0, 0), cA, voffA); PG8_STAGE(PG8_SA(0, 1), cA + hstepA, voffA);
        if (wr == 1) PG8_BAR;
        PG8_WAIT_V(2); PG8_BAR;
        PG8_STAGE(PG8_SB(1, 0), cB + kstep, voffB); PG8_STAGE(PG8_SA(1, 0), cA + kstep, voffA); PG8_STAGE(PG8_SB(1, 1), cB + hstepB + kstep, voffB);
        PG8_WAIT_V(6); PG8_BAR;
    } else {
        PG8_STAGE(PG8_SB(0, 0), cB, voffB); PG8_STAGE(PG8_SA(0, 0), cA, voffA); PG8_STAGE(PG8_SB(0, 1), cB + hstepB, voffB); PG8_STAGE(PG8_SA(0, 1), cA + hstepA, voffA);
        if (wr == 1) PG8_BAR;
        PG8_WAIT_V(4); PG8_BAR;
        PG8_STAGE(PG8_SB(1, 0), cB + kstep, voffB); PG8_STAGE(PG8_SA(1, 0), cA + kstep, voffA); PG8_STAGE(PG8_SB(1, 1), cB + hstepB + kstep, voffB);
        PG8_WAIT_V(6); PG8_BAR;
    }
    for (;;) {
        const bool has_next = S.next(ui + 1, nxt);
        const char* nA = has_next ? g.a_ptr(nxt) : cA; const char* nB = has_next ? g.b_ptr(nxt) : cB;
        for (int t = 0; t < nt; t += 2) {
            const bool last = (t == nt - 2);
            const char* a1 = cA + (size_t)(t + 1) * kstep;
            const char* a2 = last ? nA : cA + (size_t)(t + 2) * kstep; const char* b2 = last ? nB : cB + (size_t)(t + 2) * kstep;
            const char* a3 = a2 + kstep; const char* b3 = b2 + kstep;
            if constexpr (SP2) {
            PG8_LDB(B0, 0, 0); PG8_LDB(B1, 0, 1); PG8_SCHED; PG8_LDA(At, 0, 0); PG8_STAGE(PG8_SA(1, 1), a1 + hstepA, voffA);
            PG8_WAIT_V(8); PG8_WAIT_L(0); PG8_BAR; PG8_MMA(0, 0, At, B0); PG8_MMA(0, 1, At, B1); PG8_BAR; PG8_SCHED;
            PG8_LDA(At, 0, 1); PG8_STAGE(PG8_SB(0, 0), b2, voffB); PG8_STAGE(PG8_SB(0, 1), b2 + hstepB, voffB); PG8_STAGE(PG8_SA(0, 0), a2, voffA);
            PG8_WAIT_V(8); PG8_WAIT_L(0); PG8_BAR; PG8_MMA(1, 0, At, B0); PG8_MMA(1, 1, At, B1); PG8_BAR; PG8_SCHED;
            PG8_LDB(B0, 1, 0); PG8_LDB(B1, 1, 1); PG8_SCHED; PG8_LDA(At, 1, 0); PG8_STAGE(PG8_SA(0, 1), a2 + hstepA, voffA);
            PG8_WAIT_V(8); PG8_WAIT_L(0); PG8_BAR; PG8_MMA(0, 0, At, B0); PG8_MMA(0, 1, At, B1); PG8_BAR; PG8_SCHED;
            PG8_LDA(At, 1, 1); PG8_STAGE(PG8_SB(1, 0), b3, voffB); PG8_STAGE(PG8_SB(1, 1), b3 + hstepB, voffB); PG8_STAGE(PG8_SA(1, 0), a3, voffA);
            PG8_WAIT_V(8); PG8_WAIT_L(0); PG8_BAR; PG8_MMA(1, 0, At, B0); PG8_MMA(1, 1, At, B1); PG8_BAR; PG8_SCHED;
            } else {
            PG8_LDB(B0, 0, 0); PG8_SCHED; PG8_LDA(At, 0, 0); PG8_STAGE(PG8_SA(1, 1), a1 + hstepA, voffA);
            PG8_WAIT_L(8); PG8_BAR; PG8_WAIT_L(0); PG8_MMA(0, 0, At, B0); PG8_BAR; PG8_SCHED;
            PG8_LDB(B1, 0, 1); PG8_STAGE(PG8_SB(0, 0), b2, voffB);
            PG8_BAR; PG8_WAIT_L(0); PG8_MMA(0, 1, At, B1); PG8_BAR;
            PG8_LDA(At, 0, 1); PG8_STAGE(PG8_SA(0, 0), a2, voffA);
            PG8_BAR; PG8_WAIT_L(0); PG8_MMA(1, 0, At, B0); PG8_BAR; PG8_SCHED;
            PG8_STAGE(PG8_SB(0, 1), b2 + hstepB, voffB);
            PG8_WAIT_V(6); PG8_BAR; PG8_MMA(1, 1, At, B1); PG8_BAR;
            PG8_LDB(B0, 1, 0); PG8_SCHED; PG8_LDA(At, 1, 0); PG8_STAGE(PG8_SA(0, 1), a2 + hstepA, voffA);
            PG8_WAIT_L(8); PG8_BAR; PG8_WAIT_L(0); PG8_MMA(0, 0, At, B0); PG8_BAR; PG8_SCHED;
            PG8_LDB(B1, 1, 1); PG8_STAGE(PG8_SB(1, 0), b3, voffB);
            PG8_BAR; PG8_WAIT_L(0); PG8_MMA(0, 1, At, B1); PG8_BAR;
            PG8_LDA(At, 1, 1); PG8_STAGE(PG8_SA(1, 0), a3, voffA);
            PG8_BAR; PG8_WAIT_L(0); PG8_MMA(1, 0, At, B0); PG8_BAR; PG8_SCHED;
            PG8_STAGE(PG8_SB(1, 1), b3 + hstepB, voffB);
            PG8_WAIT_V(6); PG8_BAR; PG8_MMA(1, 1, At, B1); PG8_BAR;
            }
        }
        if constexpr (ALIGN_EPI) { if (wr == 0) PG8_BAR; }
        if constexpr (FP8) asm volatile("s_nop 15\n\ts_nop 15" ::: "memory");
        E(acc, cur, wr, wc, fr, fq);
        if (!has_next) break;
#pragma unroll
        for (int a = 0; a < 2; ++a)
#pragma unroll
            for (int b = 0; b < 2; ++b)
#pragma unroll
                for (int m = 0; m < 4; ++m)
#pragma unroll
                    for (int n = 0; n < 2; ++n) acc[a][b][m][n] = (f32x4){0.f, 0.f, 0.f, 0.f};
        cur = nxt; cA = nA; cB = nB; ++ui;
        if constexpr (ALIGN_EPI) { if (wr == 1) PG8_BAR; }
    }
    PG8_WAIT_V(0);
    if constexpr (!ALIGN_EPI) { if (wr == 0) PG8_BAR; }
    PG8_BAR;
#undef PG8_SA
#undef PG8_SB
#undef PG8_STAGE
#undef PG8_LDA
#undef PG8_LDB
#undef PG8_MMA
#undef PG8_WAIT_V
#undef PG8_WAIT_L
#undef PG8_BAR
#undef PG8_SCHED
}
}

namespace attn {
using bf16 = __hip_bfloat16;
constexpr int D = 128, NW = 8, QBLK = 32, KVBLK = 64;
constexpr float SCALE = 0.088388347648318440f;
constexpr float THR = 8.f;
constexpr int SDEPTH = 2;
constexpr int LDQ = NH * HD, LDK = NKV * HD, LDO = LDQ;
constexpr size_t SHM_V = KVBLK * D * 2, SHM_K = KVBLK * D * 2, SHM_ATTN = 2 * SHM_V + 2 * SHM_K + NW * 64 * 4;
using f32x8  = __attribute__((ext_vector_type(8))) float;
#define KSWZ(row, colB) ((row) * 256 + ((colB) ^ (((row) & 7) << 4)))
#define SBAR() __builtin_amdgcn_sched_barrier(0)
__device__ __forceinline__ int crow(int r, int hi) { return (r & 3) + 8 * (r >> 2) + 4 * hi; }
__device__ __forceinline__ unsigned cvtpk(float lo, float hi) {
  unsigned r; asm volatile("v_cvt_pk_bf16_f32 %0, %1, %2" : "=v"(r) : "v"(lo), "v"(hi)); return r;
}
template <typename TIn> struct Stage;
template <> struct Stage<bf16>  { using T = bf16x8;
  __device__ static __forceinline__ T ld8(const bf16* p) { return *reinterpret_cast<const bf16x8*>(p); }
  __device__ static __forceinline__ bf16x8 tobf(T x) { return x; } };
template <> struct Stage<float> { using T = f32x8;
  __device__ static __forceinline__ T ld8(const float* p) { return *reinterpret_cast<const f32x8*>(p); }
  __device__ static __forceinline__ bf16x8 tobf(T x) {
    u32x4 w = {cvtpk(x[0], x[1]), cvtpk(x[2], x[3]), cvtpk(x[4], x[5]), cvtpk(x[6], x[7])}; return *reinterpret_cast<bf16x8*>(&w); } };

__device__ __forceinline__ void partialSM(f32x16& p0, f32x16& p1, float& m_reg, float& mn, float& alpha) {
  constexpr float C = SCALE * 1.4426950408889634f;
  float pmax = p0[0]; for (int r = 1; r < 16; ++r) pmax = fmaxf(pmax, p0[r]); for (int r = 0; r < 16; ++r) pmax = fmaxf(pmax, p1[r]);
  { auto rr = __builtin_amdgcn_permlane32_swap(__float_as_uint(pmax), __float_as_uint(pmax), false, false);
    pmax = fmaxf(__uint_as_float(rr[0]), __uint_as_float(rr[1])); }
  if (__builtin_expect(__all(pmax - m_reg <= THR / SCALE), 1)) { mn = m_reg; alpha = 1.f; }
  else { mn = fmaxf(m_reg, pmax); alpha = __builtin_amdgcn_exp2f((m_reg - mn) * C); m_reg = mn; }
  float mnC = -mn * C;
  for (int r = 0; r < 16; ++r) p0[r] = fmaf(p0[r], C, mnC); for (int r = 0; r < 16; ++r) p1[r] = fmaf(p1[r], C, mnC);
  for (int r = 0; r < 16; ++r) p0[r] = __builtin_amdgcn_exp2f(p0[r]);
}
__device__ __forceinline__ void finishSM(f32x16& p0, f32x16& p1, float alpha, float& l_reg, bf16x8& pa0, bf16x8& pa1, bf16x8& pa2, bf16x8& pa3) {
  for (int r = 0; r < 16; ++r) p1[r] = __builtin_amdgcn_exp2f(p1[r]);
  float ps = 0; for (int r = 0; r < 16; ++r) ps += p0[r]; for (int r = 0; r < 16; ++r) ps += p1[r];
  { auto rr = __builtin_amdgcn_permlane32_swap(__float_as_uint(ps), __float_as_uint(ps), false, false);
    ps = __uint_as_float(rr[0]) + __uint_as_float(rr[1]); }
  l_reg = l_reg * alpha + ps;
#define PK4(P, BASE, OUT) do { unsigned a0 = cvtpk(P[BASE + 0], P[BASE + 1]), a1 = cvtpk(P[BASE + 2], P[BASE + 3]);   \
    unsigned b0 = cvtpk(P[BASE + 4], P[BASE + 5]), b1 = cvtpk(P[BASE + 6], P[BASE + 7]);                              \
    auto r0 = __builtin_amdgcn_permlane32_swap(a0, b0, false, false); auto r1 = __builtin_amdgcn_permlane32_swap(a1, b1, false, false); \
    u32x4 w = {r0[0], r1[0], r0[1], r1[1]}; OUT = *reinterpret_cast<bf16x8*>(&w); } while (0)
  PK4(p0, 0, pa0); PK4(p0, 8, pa1); PK4(p1, 0, pa2); PK4(p1, 8, pa3);
#undef PK4
}
__device__ __forceinline__ void qkt(f32x16& p0, f32x16& p1, const bf16* Ks, const bf16x8* qr, int r32, int hi) {
  p0 = f32x16{}; p1 = f32x16{};
  for (int d0 = 0; d0 < 8; ++d0) { int cb = (d0 * 16 + hi * 8) * 2;
    bf16x8 b0 = *reinterpret_cast<const bf16x8*>((const char*)Ks + KSWZ(r32, cb));
    bf16x8 b1 = *reinterpret_cast<const bf16x8*>((const char*)Ks + KSWZ(32 + r32, cb));
    p0 = __builtin_amdgcn_mfma_f32_32x32x16_bf16(b0, qr[d0], p0, 0, 0, 0);
    p1 = __builtin_amdgcn_mfma_f32_32x32x16_bf16(b1, qr[d0], p1, 0, 0, 0); }
}
__device__ __forceinline__ int v_st(int k, int c) { const int kk = (k & ~0xC) | ((k & 4) << 1) | ((k & 8) >> 1); return ((kk >> 3) * 4 + (c >> 5)) * 512 + ((kk & 7) * 32 + (c & 31)) * 2; }
__device__ __forceinline__ int v_rd_base(int lane) { return ((lane & 3) << 3) | (((lane >> 2) & 3) << 6) | (((lane >> 4) & 1) << 5) | (((lane >> 5) & 1) << 8); }
constexpr int v_rd_off(int d0, int ks, int half) { return d0 * 512 + ks * 4096 + half * 2048; }
template <int OFF> __device__ __forceinline__ s16x4 tr_read(int vb) {
  s16x4 r; asm volatile("ds_read_b64_tr_b16 %0, %1 offset:%2" : "=&v"(r) : "v"(vb), "i"(OFF) : "memory"); return r;
}
template <int D0> __device__ __forceinline__ void pv_one(f32x16& od, int vb, bf16x8 pa0, bf16x8 pa1, bf16x8 pa2, bf16x8 pa3) {
  const s16x4 l0 = tr_read<v_rd_off(D0, 0, 0)>(vb), h0 = tr_read<v_rd_off(D0, 0, 1)>(vb), l1 = tr_read<v_rd_off(D0, 1, 0)>(vb), h1 = tr_read<v_rd_off(D0, 1, 1)>(vb);
  const s16x4 l2 = tr_read<v_rd_off(D0, 2, 0)>(vb), h2 = tr_read<v_rd_off(D0, 2, 1)>(vb), l3 = tr_read<v_rd_off(D0, 3, 0)>(vb), h3 = tr_read<v_rd_off(D0, 3, 1)>(vb);
  asm volatile("s_waitcnt lgkmcnt(0)" ::: "memory"); SBAR();
#define PK(L, H) (bf16x8){L[0], L[1], L[2], L[3], H[0], H[1], H[2], H[3]}
  od = __builtin_amdgcn_mfma_f32_32x32x16_bf16(pa0, PK(l0, h0), od, 0, 0, 0);
  od = __builtin_amdgcn_mfma_f32_32x32x16_bf16(pa1, PK(l1, h1), od, 0, 0, 0);
  od = __builtin_amdgcn_mfma_f32_32x32x16_bf16(pa2, PK(l2, h2), od, 0, 0, 0);
  od = __builtin_amdgcn_mfma_f32_32x32x16_bf16(pa3, PK(l3, h3), od, 0, 0, 0);
#undef PK
}
__device__ __forceinline__ void pv_d0(f32x16* o, int vb, bf16x8 pa0, bf16x8 pa1, bf16x8 pa2, bf16x8 pa3) {
  pv_one<0>(o[0], vb, pa0, pa1, pa2, pa3); pv_one<1>(o[1], vb, pa0, pa1, pa2, pa3); pv_one<2>(o[2], vb, pa0, pa1, pa2, pa3); pv_one<3>(o[3], vb, pa0, pa1, pa2, pa3);
}

template <typename TQ>
__device__ __forceinline__ void attn_dense_body(const TQ* __restrict__ Qb, const bf16* __restrict__ Kh, const bf16* __restrict__ Vh,
                                                float* __restrict__ Ob, int seq, char* lds) {
  using St = Stage<bf16>; using SQ = Stage<TQ>;
  const int tid = threadIdx.x, wid = tid >> 6, lane = tid & 63, r32 = lane & 31, hi = lane >> 5;
  bf16* V_lds = (bf16*)lds; bf16* K_lds = (bf16*)(lds + 2 * SHM_V);
  float* ws = (float*)(lds + 2 * SHM_V + 2 * SHM_K) + wid * 64; float* li_l = ws; float* al_l = ws + 32;
  float m_reg = -1e30f, l_reg = 0; f32x16 o[4] = {}; bf16x8 qr[8];
  const TQ* Qw = Qb + (long)(wid * QBLK + r32) * LDQ + hi * 8;
#pragma unroll
  for (int d0 = 0; d0 < 8; ++d0) qr[d0] = SQ::tobf(SQ::ld8(Qw + d0 * 16));
  const int sr = tid >> 4, sc = (tid & 15) * 8, vst0 = v_st(sr, sc), vst1 = v_st(32 + sr, sc);
  const int vb0 = (int)(uintptr_t)V_lds + v_rd_base(lane);
  struct { typename St::T vs0, vs1, ks0, ks1; } sr_[SDEPTH];
#define SLOAD(i, k0) do { sr_[i].vs0 = St::ld8(&Vh[(long)((k0) + sr) * LDK + sc]); sr_[i].vs1 = St::ld8(&Vh[(long)((k0) + 32 + sr) * LDK + sc]); \
    sr_[i].ks0 = St::ld8(&Kh[(long)((k0) + sr) * LDK + sc]); sr_[i].ks1 = St::ld8(&Kh[(long)((k0) + 32 + sr) * LDK + sc]); } while (0)
#define SWRITE(b, i) do { *(bf16x8*)((char*)V_lds + (b) * SHM_V + vst0) = St::tobf(sr_[i].vs0);          \
    *(bf16x8*)((char*)V_lds + (b) * SHM_V + vst1) = St::tobf(sr_[i].vs1); int kc = sc * 2;               \
    *(bf16x8*)((char*)K_lds + (b) * SHM_K + KSWZ(sr, kc)) = St::tobf(sr_[i].ks0);                       \
    *(bf16x8*)((char*)K_lds + (b) * SHM_K + KSWZ(32 + sr, kc)) = St::tobf(sr_[i].ks1); } while (0)
#define SWAIT() do { if constexpr (SDEPTH == 2) asm volatile("s_waitcnt vmcnt(4)" ::: "memory"); else asm volatile("s_waitcnt vmcnt(0)" ::: "memory"); } while (0)
#define RESC(a) do { if (__any((a) < 1.f)) { if (hi == 0) al_l[r32] = (a); asm volatile("s_waitcnt lgkmcnt(0)" ::: "memory"); \
    for (int d = 0; d < 4; ++d) for (int r = 0; r < 16; ++r) o[d][r] *= al_l[crow(r, hi)]; } } while (0)
  f32x16 pA0, pA1, pB0, pB1; float mnA, mnB, alA, alB; bf16x8 pa0, pa1, pa2, pa3; const int NT = seq / KVBLK;
  constexpr int SE = 0, SO = SDEPTH - 1;
  SLOAD(SE, 0); asm volatile("s_waitcnt vmcnt(0)" ::: "memory"); SWRITE(0, SE); __syncthreads();
  qkt(pA0, pA1, K_lds, qr, r32, hi); partialSM(pA0, pA1, m_reg, mnA, alA);
  SLOAD(SO, KVBLK); if constexpr (SDEPTH == 2) { if (2 < NT) SLOAD(SE, 2 * KVBLK); }
  SWAIT(); SWRITE(1, SO); __syncthreads();
  for (int j = 1; j + 1 < NT; j += 2) {
    SBAR(); qkt(pB0, pB1, (bf16*)((char*)K_lds + SHM_K), qr, r32, hi);
    finishSM(pA0, pA1, alA, l_reg, pa0, pa1, pa2, pa3); SBAR();
    SLOAD(SO, (j + SDEPTH) * KVBLK); SBAR();
    pv_d0(o, vb0, pa0, pa1, pa2, pa3); partialSM(pB0, pB1, m_reg, mnB, alB);
    __syncthreads(); SWAIT(); SWRITE(0, SE);
    RESC(alB); __syncthreads();
    SBAR(); qkt(pA0, pA1, K_lds, qr, r32, hi);
    finishSM(pB0, pB1, alB, l_reg, pa0, pa1, pa2, pa3); SBAR();
    if (SDEPTH == 1 || j + 3 < NT) SLOAD(SE, (j + 1 + SDEPTH) * KVBLK); SBAR();
    pv_d0(o, vb0 + (int)SHM_V, pa0, pa1, pa2, pa3); partialSM(pA0, pA1, m_reg, mnA, alA);
    __syncthreads(); SWAIT(); SWRITE(1, SO);
    RESC(alA); __syncthreads();
  }
  SBAR(); qkt(pB0, pB1, (bf16*)((char*)K_lds + SHM_K), qr, r32, hi);
  finishSM(pA0, pA1, alA, l_reg, pa0, pa1, pa2, pa3); SBAR();
  pv_d0(o, vb0, pa0, pa1, pa2, pa3); partialSM(pB0, pB1, m_reg, mnB, alB);
  __syncthreads(); RESC(alB);
  finishSM(pB0, pB1, alB, l_reg, pa0, pa1, pa2, pa3); SBAR();
  pv_d0(o, vb0 + (int)SHM_V, pa0, pa1, pa2, pa3);
  if (hi == 0) li_l[r32] = l_reg; asm volatile("s_waitcnt lgkmcnt(0)" ::: "memory");
  float rli[16];
#pragma unroll
  for (int r = 0; r < 16; ++r) rli[r] = __builtin_amdgcn_rcpf(li_l[crow(r, hi)]);
  unsigned char* Ow = (unsigned char*)Ob + (long)(wid * QBLK) * LDO;
#pragma unroll
  for (int r = 0; r < 16; ++r) { int orow = crow(r, hi);
    for (int d0 = 0; d0 < 4; ++d0) { const float ov_ = __builtin_amdgcn_fmed3f(o[d0][r] * rli[r] * 8.f, -448.f, 448.f); Ow[(long)orow * LDO + d0 * 32 + r32] = (unsigned char)(__builtin_amdgcn_cvt_pk_fp8_f32(ov_, ov_, 0, false) & 0xff); } }
  __syncthreads();
#undef SLOAD
#undef SWRITE
#undef SWAIT
#undef RESC
}

}

namespace attn8 {
using attn::crow;
using f32x16 = __attribute__((ext_vector_type(16))) float;
using i32x8 = __attribute__((ext_vector_type(8))) int;
using i32x4 = __attribute__((ext_vector_type(4))) int;
#define A8_LAS __attribute__((address_space(3)))
constexpr float SCALE = 0.088388347648318440f, QMUL = SCALE * 1.4426950408889634f, THR2 = 4.32f, PSH = 4.f;
constexpr int TILE = 8192, KRING = 0, VRING = 3 * TILE, WSP = 6 * TILE;
constexpr long TSTRIDE = 8 * TILE;
#define A8_SBAR() __builtin_amdgcn_sched_barrier(0)
#ifndef ATT_PROBE
#define ATT_PROBE 0
#endif
template <int VAR = 0>
__device__ __forceinline__ f32x16 mfma8(const i32x8 a, const i32x8 b, const f32x16 c) {
  if constexpr ((VAR & 1) != 0) { f32x16 r = c; r[0] += __int_as_float(a[0] ^ b[0]); return r; }
  else return __builtin_amdgcn_mfma_scale_f32_32x32x64_f8f6f4(a, b, c, 0, 0, 0, 0x7F7F7F7F, 0, 0x7F7F7F7F);
}
template <int VAR = 0> __device__ __forceinline__ float ex2(float x) { if constexpr ((VAR & 2) != 0) return x; else return __builtin_amdgcn_exp2f(x); }
template <int VAR = 0>
__device__ __forceinline__ i32x8 frag(const A8_LAS char* lds, int a0) {
  if constexpr ((VAR & 4) != 0) { return (i32x8){a0, a0, a0, a0, a0, a0, a0, a0}; }
  const i32x4 x = *(const A8_LAS i32x4*)(lds + a0), y = *(const A8_LAS i32x4*)(lds + (a0 ^ 16));
  return (i32x8){x[0], x[1], x[2], x[3], y[0], y[1], y[2], y[3]};
}
template <int VAR = 0>
__device__ __forceinline__ void partialSM(f32x16& p0, f32x16& p1, f32x16& negm, float& alpha, i32x8& pw, const bool first) {
  float pmax = p0[0]; for (int r = 1; r < 16; ++r) pmax = fmaxf(pmax, p0[r]); for (int r = 0; r < 16; ++r) pmax = fmaxf(pmax, p1[r]);
  { auto rr = __builtin_amdgcn_permlane32_swap(__float_as_uint(pmax), __float_as_uint(pmax), false, false);
    pmax = fmaxf(__uint_as_float(rr[0]), __uint_as_float(rr[1])); }
  if (__builtin_expect(!first && __all(pmax <= PSH + THR2), 1)) { alpha = 1.f; }
  else { const float delta = first ? pmax - PSH : fmaxf(pmax - PSH, 0.f); alpha = __builtin_amdgcn_exp2f(-delta);
    for (int r = 0; r < 16; ++r) { p0[r] -= delta; p1[r] -= delta; }
    const float nm = negm[0] - delta; for (int r = 0; r < 16; ++r) negm[r] = nm; }
  for (int r = 0; r < 16; ++r) p0[r] = ex2<VAR>(p0[r]);
#pragma unroll
  for (int i = 0; i < 4; ++i) { int w = __float_as_int(p0[4 * i]); w = __builtin_amdgcn_cvt_pk_fp8_f32(p0[4 * i], p0[4 * i + 1], w, false); w = __builtin_amdgcn_cvt_pk_fp8_f32(p0[4 * i + 2], p0[4 * i + 3], w, true); pw[i] = w; }
}
template <int VAR = 0>
__device__ __forceinline__ void finishSM(f32x16& p1, i32x8& pw) {
  for (int r = 0; r < 16; ++r) p1[r] = ex2<VAR>(p1[r]);
#pragma unroll
  for (int i = 0; i < 4; ++i) { int w = __float_as_int(p1[4 * i]); w = __builtin_amdgcn_cvt_pk_fp8_f32(p1[4 * i], p1[4 * i + 1], w, false); w = __builtin_amdgcn_cvt_pk_fp8_f32(p1[4 * i + 2], p1[4 * i + 3], w, true); pw[4 + i] = w; }
}
template <int VAR = 0>
__device__ __forceinline__ void body(const unsigned char* __restrict__ Qb, const unsigned char* __restrict__ Kt, const unsigned char* __restrict__ Vt,
                                     unsigned char* __restrict__ Ob, int seq, A8_LAS char* lds, const int wave) {
  const int tid = opaque_tid(wave), wid = wave, lane = tid & 63, r32 = lane & 31, hi = lane >> 5;
  A8_LAS float* al_l = (A8_LAS float*)(lds + WSP) + wid * 64;
  f32x16 o[4], lacc, negm;
  { float z = 0.f, ps = PSH; asm volatile("" : "+v"(z), "+v"(ps));
#pragma unroll
    for (int r = 0; r < 16; ++r) { negm[r] = ps; lacc[r] = z; o[0][r] = z; o[1][r] = z; o[2][r] = z; o[3][r] = z; } }
  const int NT = seq / 64;
  const int ko0 = r32 * 128 + (((2 * hi) ^ ((r32 >> 1) & 7)) << 4), ko1 = r32 * 128 + (((4 + 2 * hi) ^ ((r32 >> 1) & 7)) << 4);
  const int vo = r32 * 64 + (((2 * hi) ^ ((r32 >> 2) & 3)) << 4);
  const unsigned voff = wid * 1024 + lane * 16;
#define A8_DMA(gp, ring, slot) __builtin_amdgcn_global_load_lds((const unsigned*)((gp) + voff), (A8_LAS unsigned*)(lds + (ring) + (slot) * TILE + wid * 1024), 16, 0, 0)
#define A8_TILE(j) ((long)((j) < NT ? (j) : NT - 1) * TSTRIDE)
#define A8_BAR(n) do { asm volatile("s_waitcnt vmcnt(" #n ") lgkmcnt(0)" ::: "memory"); __builtin_amdgcn_s_barrier(); asm volatile("" ::: "memory"); A8_SBAR(); } while (0)
  i32x8 q0, q1;
  { const unsigned char* qp = Qb + (long)(wid * 32 + r32) * 4096 + hi * 32;
    const i32x4 a = *(const i32x4*)qp, b = *(const i32x4*)(qp + 16), c = *(const i32x4*)(qp + 64), d = *(const i32x4*)(qp + 80);
    q0 = (i32x8){a[0], a[1], a[2], a[3], b[0], b[1], b[2], b[3]}; q1 = (i32x8){c[0], c[1], c[2], c[3], d[0], d[1], d[2], d[3]}; }
  asm volatile("" : "+v"(q0), "+v"(q1));
  A8_DMA(Kt, KRING, 0); A8_DMA(Vt, VRING, 0); A8_DMA(Kt + A8_TILE(1), KRING, 1); A8_DMA(Vt + A8_TILE(1), VRING, 1);
  A8_BAR(3);
  const bool late = wid >= 4;
  if (late) A8_BAR(1);
  int sl = 0, sf = 2;
  i32x8 kf0 = frag<VAR>(lds + KRING, ko0), kf1 = frag<VAR>(lds + KRING + 4096, ko0), kf2 = frag<VAR>(lds + KRING, ko1), kf3 = frag<VAR>(lds + KRING + 4096, ko1);
  for (int j = 0; j < NT; ++j) {
    f32x16 p0, p1; i32x8 pw; float al;
    if constexpr ((VAR & 8) == 0) A8_DMA(Kt + A8_TILE(j + 2), KRING, sf);
    __builtin_amdgcn_s_setprio(2);
    p0 = mfma8<VAR>(kf0, q0, negm); p1 = mfma8<VAR>(kf1, q0, negm); p0 = mfma8<VAR>(kf2, q1, p0); p1 = mfma8<VAR>(kf3, q1, p1);
    __builtin_amdgcn_s_setprio(0);
    if constexpr ((VAR & 16) != 0) { al = 1.f; for (int i = 0; i < 4; ++i) { pw[i] = __float_as_int(p0[i]); pw[4 + i] = __float_as_int(p1[i]); } }
    else partialSM<VAR>(p0, p1, negm, al, pw, j == 0);
    if (__any(al < 1.f)) { if (hi == 0) al_l[r32] = al; asm volatile("s_waitcnt lgkmcnt(0)" ::: "memory");
      for (int r = 0; r < 16; ++r) { const float a_ = al_l[crow(r, hi)]; lacc[r] *= a_; for (int d = 0; d < 4; ++d) o[d][r] *= a_; } }
    A8_BAR(2);
    if constexpr ((VAR & 8) == 0) A8_DMA(Vt + A8_TILE(j + 2), VRING, sf);
    { const A8_LAS char* Vs = lds + VRING + sl * TILE;
      const i32x8 b0 = frag<VAR>(Vs, vo), b1 = frag<VAR>(Vs + 2048, vo), b2 = frag<VAR>(Vs + 4096, vo), b3 = frag<VAR>(Vs + 6144, vo);
      A8_SBAR();
      if constexpr ((VAR & 16) == 0) finishSM<VAR>(p1, pw);
      int one = 0x38383838; asm volatile("" : "+v"(one));
      A8_SBAR();
      __builtin_amdgcn_s_setprio(2);
      o[0] = mfma8<VAR>(pw, b0, o[0]); o[1] = mfma8<VAR>(pw, b1, o[1]); o[2] = mfma8<VAR>(pw, b2, o[2]); o[3] = mfma8<VAR>(pw, b3, o[3]);
      lacc = mfma8<VAR>(pw, (i32x8){one, one, one, one, one, one, one, one}, lacc);
      __builtin_amdgcn_s_setprio(0); }
    A8_SBAR();
    sf = sl; sl = sl == 2 ? 0 : sl + 1;
    { const A8_LAS char* Ks = lds + KRING + sl * TILE;
      kf0 = frag<VAR>(Ks, ko0); kf1 = frag<VAR>(Ks + 4096, ko0); kf2 = frag<VAR>(Ks, ko1); kf3 = frag<VAR>(Ks + 4096, ko1); }
    A8_BAR(1);
  }
  if (!late) A8_BAR(2);
  float rli[16];
#pragma unroll
  for (int r = 0; r < 16; ++r) rli[r] = __builtin_amdgcn_rcpf(lacc[r]);
  unsigned char* Ow = Ob + (long)(wid * 32) * 4096;
#pragma unroll
  for (int r = 0; r < 16; ++r) { int orow = crow(r, hi);
    for (int d0 = 0; d0 < 4; ++d0) { const float ov_ = __builtin_amdgcn_fmed3f(o[d0][r] * rli[r] * 8.f, -448.f, 448.f); Ow[(long)orow * 4096 + d0 * 32 + r32] = (unsigned char)(__builtin_amdgcn_cvt_pk_fp8_f32(ov_, ov_, 0, false) & 0xff); } }
  asm volatile("s_waitcnt vmcnt(0)" ::: "memory");
  A8_BAR(0);
#undef A8_DMA
#undef A8_TILE
#undef A8_BAR
}

__device__ __forceinline__ void pack16(const f32x16& p, int* w) {
#pragma unroll
  for (int i = 0; i < 4; ++i) { int x = __float_as_int(p[4 * i]); x = __builtin_amdgcn_cvt_pk_fp8_f32(p[4 * i], p[4 * i + 1], x, false); x = __builtin_amdgcn_cvt_pk_fp8_f32(p[4 * i + 2], p[4 * i + 3], x, true); w[i] = x; }
}
__device__ __forceinline__ void body128(const unsigned char* __restrict__ Qb, const unsigned char* __restrict__ Kt, const unsigned char* __restrict__ Vt,
                                        unsigned char* __restrict__ Ob, int seq, A8_LAS char* lds, const int wave) {
  const int tid = opaque_tid(wave), wid = wave, lane = tid & 63, r32 = lane & 31, hi = lane >> 5;
  constexpr int SLOT = 2 * TILE, KR = 0, VR = 3 * SLOT, WS2 = 6 * SLOT;
  A8_LAS float* al_l = (A8_LAS float*)(lds + WS2) + wid * 64;
  f32x16 o[4], lacc, negm;
  { float z = 0.f, ps = PSH; asm volatile("" : "+v"(z), "+v"(ps));
#pragma unroll
    for (int r = 0; r < 16; ++r) { negm[r] = ps; lacc[r] = z; o[0][r] = z; o[1][r] = z; o[2][r] = z; o[3][r] = z; } }
  const int NS = seq / 128;
  const int ko0 = r32 * 128 + (((2 * hi) ^ ((r32 >> 1) & 7)) << 4), ko1 = r32 * 128 + (((4 + 2 * hi) ^ ((r32 >> 1) & 7)) << 4);
  const int vo = r32 * 64 + (((2 * hi) ^ ((r32 >> 2) & 3)) << 4);
  const unsigned voff = wid * 1024 + lane * 16;
#define B_DMA(gp, ring, slot, sub) __builtin_amdgcn_global_load_lds((const unsigned*)((gp) + voff), (A8_LAS unsigned*)(lds + (ring) + (slot) * SLOT + (sub) * TILE + wid * 1024), 16, 0, 0)
#define B_STEP(j) ((long)((j) < NS ? (j) : NS - 1) * 2 * TSTRIDE)
#define B_DMA2(base, ring, slot, j) do { B_DMA((base) + B_STEP(j), ring, slot, 0); B_DMA((base) + B_STEP(j) + TSTRIDE, ring, slot, 1); } while (0)
#define B_BAR(n) do { asm volatile("s_waitcnt vmcnt(" #n ") lgkmcnt(0)" ::: "memory"); __builtin_amdgcn_s_barrier(); asm volatile("" ::: "memory"); A8_SBAR(); } while (0)
  i32x8 q0, q1;
  { const unsigned char* qp = Qb + (long)(wid * 32 + r32) * 4096 + hi * 32;
    const i32x4 a = *(const i32x4*)qp, b = *(const i32x4*)(qp + 16), c = *(const i32x4*)(qp + 64), d = *(const i32x4*)(qp + 80);
    q0 = (i32x8){a[0], a[1], a[2], a[3], b[0], b[1], b[2], b[3]}; q1 = (i32x8){c[0], c[1], c[2], c[3], d[0], d[1], d[2], d[3]}; }
  asm volatile("" : "+v"(q0), "+v"(q1));
  B_DMA2(Kt, KR, 0, 0); B_DMA2(Vt, VR, 0, 0); B_DMA2(Kt, KR, 1, 1); B_DMA2(Vt, VR, 1, 1);
  B_BAR(6);
  const bool late = wid >= 4;
  if (late) { __builtin_amdgcn_s_setprio(1); B_BAR(4); }
  int sl = 0, sf = 2;
  for (int j = 0; j < NS; ++j) {
    f32x16 p0, p1, p2, p3; int pw[16]; float al;
    B_DMA2(Kt, KR, sf, j + 2);
    { const A8_LAS char* Ks = lds + KR + sl * SLOT;
      { const i32x8 a0 = frag<0>(Ks, ko0), a1 = frag<0>(Ks + 4096, ko0), a2 = frag<0>(Ks, ko1), a3 = frag<0>(Ks + 4096, ko1);
        p0 = mfma8<0>(a0, q0, negm); p1 = mfma8<0>(a1, q0, negm); p0 = mfma8<0>(a2, q1, p0); p1 = mfma8<0>(a3, q1, p1); }
      { const i32x8 a0 = frag<0>(Ks + TILE, ko0), a1 = frag<0>(Ks + TILE + 4096, ko0), a2 = frag<0>(Ks + TILE, ko1), a3 = frag<0>(Ks + TILE + 4096, ko1);
        p2 = mfma8<0>(a0, q0, negm); p3 = mfma8<0>(a1, q0, negm); p2 = mfma8<0>(a2, q1, p2); p3 = mfma8<0>(a3, q1, p3);
        } }
    { float pmax = p0[0];
      for (int r = 1; r < 16; ++r) pmax = fmaxf(pmax, p0[r]);
      for (int r = 0; r < 16; ++r) pmax = fmaxf(pmax, p1[r]);
      for (int r = 0; r < 16; ++r) pmax = fmaxf(pmax, p2[r]);
      for (int r = 0; r < 16; ++r) pmax = fmaxf(pmax, p3[r]);
      { auto rr = __builtin_amdgcn_permlane32_swap(__float_as_uint(pmax), __float_as_uint(pmax), false, false);
        pmax = fmaxf(__uint_as_float(rr[0]), __uint_as_float(rr[1])); }
      const bool first = j == 0;
      if (__builtin_expect(!first && __all(pmax <= PSH + THR2), 1)) { al = 1.f; }
      else { const float delta = first ? pmax - PSH : fmaxf(pmax - PSH, 0.f); al = __builtin_amdgcn_exp2f(-delta);
        for (int r = 0; r < 16; ++r) { p0[r] -= delta; p1[r] -= delta; p2[r] -= delta; p3[r] -= delta; }
        const float nm = negm[0] - delta; for (int r = 0; r < 16; ++r) negm[r] = nm; }
      for (int r = 0; r < 16; ++r) { p0[r] = __builtin_amdgcn_exp2f(p0[r]); p1[r] = __builtin_amdgcn_exp2f(p1[r]); }
      pack16(p0, pw); pack16(p1, pw + 4); }
    if (__any(al < 1.f)) { if (hi == 0) al_l[r32] = al; asm volatile("s_waitcnt lgkmcnt(0)" ::: "memory");
      for (int r = 0; r < 16; ++r) { const float a_ = al_l[crow(r, hi)]; lacc[r] *= a_; for (int d = 0; d < 4; ++d) o[d][r] *= a_; } }
    B_BAR(4);
    B_DMA2(Vt, VR, sf, j + 2);
    { const A8_LAS char* Vs = lds + VR + sl * SLOT;
      int one = 0x38383838; asm volatile("" : "+v"(one));
      const i32x8 ones = (i32x8){one, one, one, one, one, one, one, one};
      { const i32x8 b0 = frag<0>(Vs, vo), b1 = frag<0>(Vs + 2048, vo), b2 = frag<0>(Vs + 4096, vo), b3 = frag<0>(Vs + 6144, vo);
        A8_SBAR();
        for (int r = 0; r < 16; ++r) { p2[r] = __builtin_amdgcn_exp2f(p2[r]); p3[r] = __builtin_amdgcn_exp2f(p3[r]); }
        pack16(p2, pw + 8); pack16(p3, pw + 12);
        A8_SBAR();
        const i32x8 pa = (i32x8){pw[0], pw[1], pw[2], pw[3], pw[4], pw[5], pw[6], pw[7]};
        o[0] = mfma8<0>(pa, b0, o[0]); o[1] = mfma8<0>(pa, b1, o[1]); o[2] = mfma8<0>(pa, b2, o[2]); o[3] = mfma8<0>(pa, b3, o[3]);
        lacc = mfma8<0>(pa, ones, lacc); }
      { const i32x8 b0 = frag<0>(Vs + TILE, vo), b1 = frag<0>(Vs + TILE + 2048, vo), b2 = frag<0>(Vs + TILE + 4096, vo), b3 = frag<0>(Vs + TILE + 6144, vo);
        const i32x8 pb = (i32x8){pw[8], pw[9], pw[10], pw[11], pw[12], pw[13], pw[14], pw[15]};
        o[0] = mfma8<0>(pb, b0, o[0]); o[1] = mfma8<0>(pb, b1, o[1]); o[2] = mfma8<0>(pb, b2, o[2]); o[3] = mfma8<0>(pb, b3, o[3]);
        lacc = mfma8<0>(pb, ones, lacc);
        } }
    B_BAR(4);
    sf = sl; sl = sl == 2 ? 0 : sl + 1;
  }
  if (!late) B_BAR(4); else __builtin_amdgcn_s_setprio(0);
  float rli[16];
#pragma unroll
  for (int r = 0; r < 16; ++r) rli[r] = __builtin_amdgcn_rcpf(lacc[r]);
  { A8_LAS unsigned char* st = (A8_LAS unsigned char*)(lds + WS2 + 2048 + wid * 4096 + (wid == 7 ? 4096 : 0));
#pragma unroll
    for (int r = 0; r < 16; ++r) { const int orow = crow(r, hi);
#pragma unroll
      for (int d0 = 0; d0 < 4; ++d0) { const float ov_ = __builtin_amdgcn_fmed3f(o[d0][r] * rli[r] * 8.f, -448.f, 448.f);
        st[orow * 128 + d0 * 32 + r32] = (unsigned char)(__builtin_amdgcn_cvt_pk_fp8_f32(ov_, ov_, 0, false) & 0xff); } }
    asm volatile("s_waitcnt lgkmcnt(0)" ::: "memory");
    unsigned char* Ow = Ob + (long)(wid * 32) * 4096;
#pragma unroll
    for (int i = 0; i < 4; ++i) { const int c = lane + 64 * i; const i32x4 v = *(const A8_LAS i32x4*)(st + c * 16);
      *(i32x4*)(Ow + (long)(c >> 3) * 4096 + (c & 7) * 16) = v; } }
  asm volatile("s_waitcnt vmcnt(0)" ::: "memory");
  B_BAR(0);
#undef B_DMA
#undef B_STEP
#undef B_DMA2
#undef B_BAR
}
}

constexpr size_t MiB = 1u << 20;
constexpr size_t WS_CTL = 0, CTL_ZERO_BYTES = 64 * 1024;
constexpr size_t WS_SCU = 1 * MiB, WS_SCV = WS_SCU + 64 * 1024;
constexpr size_t WS_CS = WS_SCU + 128 * 1024;
constexpr size_t WS_KEYS = WS_SCU + 384 * 1024;
constexpr size_t WS_SCIN = WS_SCU + 896 * 1024;
constexpr float ACT8 = 8.f;
constexpr size_t WS_MODF = 2 * MiB;
constexpr size_t WS_MODP = 3 * MiB;
constexpr size_t WS_WIN = 6 * MiB, WS_WATT = 134 * MiB, WS_WFOUR = 166 * MiB, WS_WOUT = 182 * MiB, WS_WPQ = 214 * MiB;
constexpr size_t WS_U8 = 230 * MiB, WS_V8 = 294 * MiB;
constexpr size_t WS_D128 = 358 * MiB, WS_DS64 = WS_D128 + 128 * 1024, WS_DS32 = WS_DS64 + 128 * 1024;
constexpr size_t WS_H = 359 * MiB;
constexpr size_t WS_Q = 551 * MiB;
constexpr size_t WS_K = 743 * MiB, WS_V = 791 * MiB;
constexpr size_t WS_F = 839 * MiB;
constexpr size_t WS_GA = 935 * MiB, WS_GF = 1127 * MiB;
constexpr size_t WS_IDX = 1319 * MiB, WS_GATE = 1331 * MiB;
constexpr size_t WS_L1 = 1343 * MiB;
constexpr size_t WS_END = 1535 * MiB + 4096;
#ifndef ATTN_FP8
#define ATTN_FP8 1
#endif
constexpr size_t WS_GA8 = WS_Q + 96 * MiB;
constexpr float GATE8 = 255.f;
constexpr size_t DO_Q8 = 0, DO_K8 = 96 * MiB, DO_V8 = 120 * MiB;
constexpr int CW_BAR = 4096;

constexpr int NWAVES = 8;
constexpr int LDS_BYTES = 147456;
constexpr int MISC_OFF = 131072 + 320;

#define XB_TMO      128
#define XB_XCNT(j)  (256  + 64 * (j))
#define XB_XSUB(j)  (1280 + 64 * (j))
#define XB_XGEN(j)  (2304 + 64 * (j))
#define XB_TOP      3328
#define XB_TOPGEN   3392
#define XCD_BAR_WORDS 3456
#define XB_SPIN_CAP (1u << 18)

__device__ __forceinline__ unsigned xb_ld(unsigned* p)              { return __hip_atomic_load(p, __ATOMIC_RELAXED, __HIP_MEMORY_SCOPE_AGENT); }
__device__ __forceinline__ unsigned xb_add(unsigned* p, unsigned v) { return __hip_atomic_fetch_add(p, v, __ATOMIC_RELAXED, __HIP_MEMORY_SCOPE_AGENT); }
__device__ __forceinline__ unsigned xb_xcc_id() { return (unsigned)__builtin_amdgcn_s_getreg((3 << 11) | 20) & 0xFu; }
#define XB_SPIN(cond, bar) do { unsigned _sp = 0; while (cond) { __builtin_amdgcn_s_sleep(1); \
    if ((++_sp & 255u) == 0u) { if (xb_ld(&(bar)[XB_TMO])) break; if (_sp > XB_SPIN_CAP) { atomicAdd(&(bar)[XB_TMO], 1u); break; } } } } while (0)

struct XcdBarrier {
    unsigned* bar; unsigned x;
    volatile LAS unsigned* st;
};
__device__ __forceinline__ XcdBarrier xcd_barrier_post(unsigned* bar, volatile LAS unsigned* st, const int tid) {
    XcdBarrier b; b.bar = bar; b.x = xb_xcc_id(); b.st = st;
    if (tid == 0) (void)xb_add(&bar[XB_XCNT(b.x)], 1u);
    return b;
}
__device__ __forceinline__ void xcd_barrier_complete(unsigned* bar, unsigned x, unsigned& nloc, unsigned& nx) {
    const unsigned G = gridDim.x * gridDim.y * gridDim.z;
    unsigned sum, cnt, mine, sp = 0u;
    for (;;) {
        sum = 0u; cnt = 0u; mine = 0u;
#pragma unroll
        for (unsigned j = 0; j < 16; ++j) { const unsigned c = xb_ld(&bar[XB_XCNT(j)]); sum += c; cnt += (c > 0u) ? 1u : 0u; mine = (j == x) ? c : mine; }
        if (sum == G) break;
        __builtin_amdgcn_s_sleep(1);
        if ((++sp & 255u) == 0u) { if (xb_ld(&bar[XB_TMO])) break; if (sp > XB_SPIN_CAP) { atomicAdd(&bar[XB_TMO], 1u); break; } }
    }
    nloc = mine > 0u ? mine : 1u; nx = cnt > 0u ? cnt : 1u;
}
__device__ __forceinline__ void xcd_barrier(const XcdBarrier& b, const int tid) {
    asm volatile("s_waitcnt vmcnt(0)" ::: "memory");
    __syncthreads();
    if (tid == 0) {
        unsigned* bar = b.bar;
        __builtin_amdgcn_s_waitcnt(0);
        unsigned nloc = b.st[0], nx = b.st[1];
        if (nloc == 0u) { xcd_barrier_complete(bar, b.x, nloc, nx); b.st[0] = nloc; b.st[1] = nx; }
        const unsigned old = xb_add(&bar[XB_XSUB(b.x)], 1u);
        const unsigned gen = old / nloc;
        if (old + 1u == (gen + 1u) * nloc) {
            __builtin_amdgcn_fence(__ATOMIC_RELEASE, "agent");
            asm volatile("s_waitcnt vmcnt(0)" ::: "memory");
            const unsigned og = xb_add(&bar[XB_TOP], 1u);
            const unsigned tg = og / nx;
            if (og + 1u == (tg + 1u) * nx) xb_add(&bar[XB_TOPGEN], 1u);
            else XB_SPIN(xb_ld(&bar[XB_TOPGEN]) == tg, bar);
            __builtin_amdgcn_fence(__ATOMIC_ACQUIRE, "agent");
            xb_add(&bar[XB_XGEN(b.x)], 1u);
            asm volatile("s_waitcnt vmcnt(0)" ::: "memory");
        } else {
            XB_SPIN(xb_ld(&bar[XB_XGEN(b.x)]) == gen, bar);
            __builtin_amdgcn_fence(__ATOMIC_ACQUIRE, "agent");
            asm volatile("s_waitcnt vmcnt(0)" ::: "memory");
        }
    }
    __syncthreads();
}

struct Frame {
    LAS unsigned char* lds;
    int tid, lane, wave;
    int vcu, G;
    float* out; unsigned char* ws;
};
enum { A_XP = 0, A_XS, A_CP, A_CS, A_WADA, A_BADA, A_N1G, A_N2G, A_WIN, A_QNG, A_KNG, A_WATT, A_WFOUR, A_WOUT, A_WPQ, A_KEYS, A_PU, A_PV, A_FING };
__device__ __forceinline__ const float* karg(int k) {
    unsigned off = (unsigned)k * 8u; asm volatile("" : "+s"(off));
    typedef const float* cfp;
    return *(const __attribute__((address_space(4))) cfp*)((const __attribute__((address_space(4))) char*)__builtin_amdgcn_kernarg_segment_ptr() + off);
}
#define LDS_WAIT() asm volatile("s_waitcnt lgkmcnt(0)" ::: "memory")
#define VM_WAIT() asm volatile("s_waitcnt vmcnt(0)" ::: "memory")
__device__ __forceinline__ unsigned f2bf(float f) { unsigned u = __builtin_bit_cast(unsigned, f); return (u + 0x7fffu + ((u >> 16) & 1u)) >> 16; }
__device__ __forceinline__ unsigned pk2(float lo, float hi) { return f2bf(lo) | (f2bf(hi) << 16); }
__device__ __forceinline__ float wave_sum(float v) {
#pragma unroll
    for (int o = 1; o < 64; o <<= 1) v += __shfl_xor(v, o);
    return v;
}
__device__ __forceinline__ float wave_max(float v) {
#pragma unroll
    for (int o = 1; o < 64; o <<= 1) v = fmaxf(v, __shfl_xor(v, o));
    return v;
}

__device__ __forceinline__ void p0_transpose_item(const float* W, int K, int N, bf16_t* WT, LAS float* scr, int item, int lane) {
    const int nblk = N / 32, kb = item / nblk, nb = item % nblk, k0 = 64 * kb, n0 = 32 * nb;
#pragma unroll 8
    for (int i = 0; i < 32; ++i) { const int kk = 2 * i + (lane >> 5); scr[kk * 33 + (lane & 31)] = W[(size_t)(k0 + kk) * N + n0 + (lane & 31)]; }
    LDS_WAIT(); asm volatile("" ::: "memory");
    const int c = lane & 7;
#pragma unroll
    for (int j = 0; j < 4; ++j) { const int n = (lane >> 3) + 8 * j; const LAS float* s = scr + (8 * c) * 33 + n;
        u32x4 o; o.x = pk2(s[0 * 33], s[1 * 33]); o.y = pk2(s[2 * 33], s[3 * 33]); o.z = pk2(s[4 * 33], s[5 * 33]); o.w = pk2(s[6 * 33], s[7 * 33]);
        *(GAS u32x4*)(WT + (size_t)(n0 + n) * K + k0 + 8 * c) = o; }
    LDS_WAIT(); asm volatile("" ::: "memory");
}
__device__ __forceinline__ void p0_transpose_item_fp8(const float* W, int K, int N, unsigned char* WT, LAS float* scr, int item, int lane, float sc) {
    const int nblk = N / 32, kb = item / nblk, nb = item % nblk, k0 = 64 * kb, n0 = 32 * nb;
#pragma unroll 8
    for (int i = 0; i < 32; ++i) { const int kk = 2 * i + (lane >> 5); scr[kk * 33 + (lane & 31)] = __builtin_amdgcn_fmed3f(W[(size_t)(k0 + kk) * N + n0 + (lane & 31)] * sc, -448.f, 448.f); }
    LDS_WAIT(); asm volatile("" ::: "memory");
    const int c = lane & 3;
#pragma unroll
    for (int j = 0; j < 2; ++j) { const int n = (lane >> 2) + 16 * j; const LAS float* t = scr + (16 * c) * 33 + n; unsigned w[4];
#pragma unroll
        for (int q = 0; q < 4; ++q) { int v = 0; v = __builtin_amdgcn_cvt_pk_fp8_f32(t[(4 * q + 0) * 33], t[(4 * q + 1) * 33], v, false); v = __builtin_amdgcn_cvt_pk_fp8_f32(t[(4 * q + 2) * 33], t[(4 * q + 3) * 33], v, true); w[q] = (unsigned)v; }
        *(GAS u32x4*)(WT + (size_t)(n0 + n) * K + k0 + 16 * c) = (u32x4){w[0], w[1], w[2], w[3]}; }
    LDS_WAIT(); asm volatile("" ::: "memory");
}
__device__ __forceinline__ u32x6 fp6_settle(u32x6 q) { unsigned a = q[0], b = q[1], c = q[2], d = q[3], e = q[4], f = q[5];
    asm volatile("s_nop 15\n\ts_nop 15" : "+v"(a), "+v"(b), "+v"(c), "+v"(d), "+v"(e), "+v"(f)); return (u32x6){a, b, c, d, e, f}; }
constexpr int FP6_INV_OFF = 132096;
__device__ __forceinline__ void fp6_calibrate(Frame& F) {
    f32x16 a, b, a2, b2;
#pragma unroll
    for (int k = 0; k < 16; ++k) { a[k] = (float)(k & 7) * 0.125f; b[k] = (float)((k + 16) & 7) * 0.125f; a2[k] = (float)(k >> 3) * 0.125f; b2[k] = (float)((k + 16) >> 3) * 0.125f; }
    const u32x6 q1 = fp6_settle(__builtin_amdgcn_cvt_scalef32_2xpk16_fp6_f32(a, b, 1.0f)), q2 = fp6_settle(__builtin_amdgcn_cvt_scalef32_2xpk16_fp6_f32(a2, b2, 1.0f));
    const f32x32 d1 = __builtin_amdgcn_cvt_scalef32_pk32_f32_fp6(q1, 1.0f), d2 = __builtin_amdgcn_cvt_scalef32_pk32_f32_fp6(q2, 1.0f);
    LAS int* inv = (LAS int*)(F.lds + FP6_INV_OFF) + 32 * F.wave;
#pragma unroll
    for (int i = 0; i < 32; ++i) { const int k = ((int)(d1[i] * 8.f + 0.5f) & 7) + 8 * ((int)(d2[i] * 8.f + 0.5f) & 3); inv[k] = i; }
    LDS_WAIT(); asm volatile("" ::: "memory");
}
__device__ __forceinline__ void p0_fp6_row(const float* src, unsigned char* dst, float* scale_out, LAS float* stg, const LAS int* inv, int lane) {
    f32x4 v[16]; float mx = 0.f;
#pragma unroll
    for (int j = 0; j < 16; ++j) { v[j] = *(const GAS f32x4*)(src + (j >> 3) * 2048 + 256 * (j & 7) + 4 * lane); mx = fmaxf(mx, fmaxf(fmaxf(fabsf(v[j].x), fabsf(v[j].y)), fmaxf(fabsf(v[j].z), fabsf(v[j].w)))); }
    mx = wave_max(mx);
    const float sc = mx > 0.f ? mx * (1.f / 7.f) : 1.f, isc = 1.f / sc;
#pragma unroll
    for (int j = 0; j < 16; ++j) { stg[(4 * j + 0) * 64 + lane] = v[j].x * isc; stg[(4 * j + 1) * 64 + lane] = v[j].y * isc; stg[(4 * j + 2) * 64 + lane] = v[j].z * isc; stg[(4 * j + 3) * 64 + lane] = v[j].w * isc; }
    LDS_WAIT(); asm volatile("" ::: "memory");
    unsigned w[12];
#pragma unroll
    for (int grp = 0; grp < 2; ++grp) { f32x16 a, b;
#pragma unroll
        for (int k = 0; k < 16; ++k) { a[k] = stg[(32 * grp + inv[k]) * 64 + lane]; b[k] = stg[(32 * grp + inv[16 + k]) * 64 + lane]; }
        const u32x6 q = fp6_settle(__builtin_amdgcn_cvt_scalef32_2xpk16_fp6_f32(a, b, 1.0f));
#pragma unroll
        for (int i = 0; i < 6; ++i) w[6 * grp + i] = q[i]; }
#pragma unroll
    for (int j = 0; j < 3; ++j) *(GAS u32x4*)(dst + 1024 * j + 16 * lane) = (u32x4){w[4 * j], w[4 * j + 1], w[4 * j + 2], w[4 * j + 3]};
    if (lane == 0) *scale_out = sc;
    LDS_WAIT(); asm volatile("" ::: "memory");
}

__device__ __forceinline__ void p0_prologue(Frame& F, const int parts = 31) {
    const int gw = F.vcu * NWAVES + F.wave, NGW = F.G * NWAVES, lane = F.lane;
    const float* const a_cp = karg(A_CP); const float* const a_cs = karg(A_CS); const float* const a_wada = karg(A_WADA);
    if (parts & 1) {
        LAS float* sl = (LAS float*)(F.lds);
        LAS float* red = (LAS float*)(F.lds + 65536);
        for (int i = F.tid; i < 4 * DM; i += NWAVES * 64) { const int cb = i >> 12, k = i & (DM - 1); const float c = (cb < 2 ? a_cp[cb * DM + k] : a_cs[(cb - 2) * DM + k]); sl[i] = c * sigmoidf_(c); }
        __syncthreads();
        float* modp = (float*)(F.ws + WS_MODP);
        for (int it = F.vcu; it < 96 * 8; it += F.G) {
            const int cbk = it % 96, ks = it / 96, kbase = ks * 512 + F.wave * 64;
            const GAS f32x4* wp = (const GAS f32x4*)(a_wada + (size_t)kbase * (6 * DM) + cbk * 256) + lane;
            f32x4 a0 = {0.f, 0.f, 0.f, 0.f}, a1 = a0, a2 = a0, a3 = a0;
#pragma unroll 8
            for (int k = 0; k < 64; ++k) { const f32x4 w = wp[(size_t)k * (6 * DM / 4)];
                const float s0 = sl[kbase + k], s1 = sl[DM + kbase + k], s2 = sl[2 * DM + kbase + k], s3 = sl[3 * DM + kbase + k];
                a0 += w * s0; a1 += w * s1; a2 += w * s2; a3 += w * s3; }
            LAS f32x4* r4 = (LAS f32x4*)red + F.wave * 256 + lane;
            r4[0] = a0; r4[64] = a1; r4[128] = a2; r4[192] = a3;
            __syncthreads();
            for (int o = F.tid; o < 1024; o += NWAVES * 64) { float s = 0.f;
#pragma unroll
                for (int w = 0; w < 8; ++w) s += red[w * 1024 + o];
                const int cb = o >> 8, col = o & 255; modp[((size_t)ks * 4 + cb) * (6 * DM) + cbk * 256 + col] = s; }
            __syncthreads();
        }
    }
    if (parts & 2) {
        LAS float* scr = (LAS float*)(F.lds + F.wave * 16384);
        auto w_scale = [&](const float* wsm, int slot) -> float { float q = 0.f;
#pragma unroll 8
          for (int i = 0; i < 128; ++i) { const f32x4 v = *(const GAS f32x4*)(wsm + (size_t)(i * 64 + lane) * 4); q += (v.x * v.x + v.y * v.y) + (v.z * v.z + v.w * v.w); }
          q = wave_sum(q) * (1.f / 32768.f);
          const float e = q > 0.f ? 3.f - 0.5f * __builtin_amdgcn_logf(q) : 0.f;
          const float sc = __builtin_amdgcn_exp2f(__builtin_rintf(e));
          if (gw == 0 && lane == 0) ((float*)(F.ws + WS_SCIN))[slot] = 1.f / sc;
          return sc; };
        const float sc_win = w_scale(karg(A_WIN), 0), sc_watt = w_scale(karg(A_WATT), 1), sc_wout = w_scale(karg(A_WOUT), 2), sc_wfour = w_scale(karg(A_WFOUR), 3);
        const float* const a_win = karg(A_WIN); const float* const a_watt = karg(A_WATT); const float* const a_wfour = karg(A_WFOUR); const float* const a_wout = karg(A_WOUT); const float* const a_wpq = karg(A_WPQ);
        constexpr int I_IN = (DM / 64) * (NIN / 32), I_ATT = (DM / 64) * (DM / 32), I_FOUR = (FW / 64) * (DM / 32), I_OUT = I_ATT, I_PQ = (DM / 64) * (PQW / 32);
        constexpr int NITEMS = I_IN + I_ATT + I_FOUR + I_OUT + I_PQ;
        for (int it = gw; it < NITEMS; it += NGW) {
            int r = it;
            if (r < I_IN) { p0_transpose_item_fp8(a_win, DM, NIN, F.ws + WS_WIN, scr, r, lane, sc_win); continue; } r -= I_IN;
            if (r < I_ATT) { p0_transpose_item_fp8(a_watt, DM, DM, F.ws + WS_WATT, scr, r, lane, sc_watt); continue; } r -= I_ATT;
            if (r < I_FOUR) { p0_transpose_item_fp8(a_wfour, FW, DM, F.ws + WS_WFOUR, scr, r, lane, sc_wfour); continue; } r -= I_FOUR;
            if (r < I_OUT) { p0_transpose_item_fp8(a_wout, DM, DM, F.ws + WS_WOUT, scr, r, lane, sc_wout); continue; } r -= I_OUT;
            p0_transpose_item(a_wpq, DM, PQW, (bf16_t*)(F.ws + WS_WPQ), scr, r, lane);
        }
    }
    const float* const a_pu = karg(A_PU); const float* const a_pv = karg(A_PV);
    __syncthreads();
    fp6_calibrate(F);
    if (parts & 4) {
        LAS float* stg = (LAS float*)(F.lds + F.wave * 16384); const LAS int* inv = (const LAS int*)(F.lds + FP6_INV_OFF) + 32 * F.wave;
        for (int r = gw; r < 2 * PN; r += NGW) {
            if (r < PN) p0_fp6_row(a_pu + (size_t)r * DM, F.ws + WS_U8 + (size_t)r * PROW, (float*)(F.ws + WS_SCU) + r, stg, inv, lane);
            else { const int q = r - PN; p0_fp6_row(a_pv + (size_t)q * DM, F.ws + WS_V8 + (size_t)q * PROW, (float*)(F.ws + WS_SCV) + q, stg, inv, lane); }
        }
    }
    if (parts & 8) {
        bf16_t* d128 = (bf16_t*)(F.ws + WS_D128); bf16_t* ds64 = (bf16_t*)(F.ws + WS_DS64); bf16_t* ds32 = (bf16_t*)(F.ws + WS_DS32);
        for (int i = F.vcu * (NWAVES * 64) + F.tid; i < 3 * 65536; i += F.G * NWAVES * 64) {
            const int which = i >> 16, r = (i >> 8) & 255, k = i & 255; float v;
            if (which == 0) {
                const int k2 = r & 127, n2 = k & 127; const float rev = (float)((k2 * n2) & 127) * (1.f / 128.f);
                const float cs = __builtin_amdgcn_cosf(rev), sn = __builtin_amdgcn_sinf(rev);
                v = (r < 128) ? (k < 128 ? cs : -sn) : (k < 128 ? -sn : -cs);
            } else {
                const int S1 = which == 1 ? 64 : 32; v = 0.f;
                if (r < S1 && k < 2 * S1) { const int n1 = k & (S1 - 1); const float rev = (float)((r * n1) & (S1 - 1)) / (float)S1; v = (k < S1) ? __builtin_amdgcn_cosf(rev) : __builtin_amdgcn_sinf(rev); }
            }
            (which == 0 ? d128 : (which == 1 ? ds64 : ds32))[i & 65535] = (bf16_t)f2bf(v);
        }
    }
    if (parts & 16) {
        bf16_t* cs = (bf16_t*)(F.ws + WS_CS);
        for (int i = F.vcu * (NWAVES * 64) + F.tid; i < 512 * 256; i += F.G * NWAVES * 64) {
            const int r = i >> 8, k = i & 255, part = r >> 8, c = r & 255;
            const float rev = (float)((c * k) & 255) * (1.f / 256.f) - (part ? 0.25f : 0.f);
            cs[i] = (bf16_t)f2bf(__builtin_amdgcn_cosf(rev) * (1.f / 16.f));
        }
        bf16_t* kb = (bf16_t*)(F.ws + WS_KEYS); const float* const a_keys = karg(A_KEYS);
        for (int i = F.vcu * (NWAVES * 64) + F.tid; i < PH * 2 * PNK * PHALF; i += F.G * NWAVES * 64) kb[i] = (bf16_t)f2bf(a_keys[i]);
    }
}

template <bool SECOND>
__device__ __forceinline__ void p_normmod(Frame& F) {
    LAS float* Av = (LAS float*)(F.lds); LAS float* Bv = Av + DM;
    const float* const g = karg(SECOND ? A_N2G : A_N1G); const float* const a_bada = karg(A_BADA); const float* const a_xp = karg(A_XP); const float* const a_xs = karg(A_XS);
    const float* modp = (const float*)(F.ws + WS_MODP); const float* modf = (const float*)(F.ws + WS_MODF);
    bf16_t* H = (bf16_t*)(F.ws + WS_H);
    for (int cb = 0; cb < 4; ++cb) {
        for (int i = F.tid; i < DM; i += NWAVES * 64) {
            float sh, sc;
            if (SECOND) { sh = modf[cb * 6 * DM + 3 * DM + i]; sc = modf[cb * 6 * DM + 4 * DM + i]; }
            else { sh = a_bada[i]; sc = a_bada[DM + i];
#pragma unroll
                for (int ks = 0; ks < 8; ++ks) { sh += modp[((size_t)ks * 4 + cb) * (6 * DM) + i]; sc += modp[((size_t)ks * 4 + cb) * (6 * DM) + DM + i]; } }
            Av[i] = g[i] * (1.f + sc); Bv[i] = sh;
        }
        __syncthreads();
        const int base = cb == 0 ? 0 : (cb == 1 ? SP : (cb == 2 ? TP : TP + SS)), n = cb < 2 ? SP : SS;
        for (int r = F.vcu * NWAVES + F.wave; r < n; r += F.G * NWAVES) {
            const int m = base + r;
            if constexpr (SECOND) {
                const GAS u32x4* xr = (const GAS u32x4*)((const bf16_t*)(F.ws + WS_GF) + (size_t)m * DM) + F.lane;
                u32x4 raw[8]; float ss = 0.f;
#pragma unroll
                for (int j = 0; j < 8; ++j) raw[j] = xr[64 * j];
                __builtin_amdgcn_sched_barrier(0);
                f32x4 v[8][2];
#pragma unroll
                for (int j = 0; j < 8; ++j) { unpack8(raw[j], v[j][0], v[j][1]);
                    ss += ((v[j][0].x * v[j][0].x + v[j][0].y * v[j][0].y) + (v[j][0].z * v[j][0].z + v[j][0].w * v[j][0].w)) + ((v[j][1].x * v[j][1].x + v[j][1].y * v[j][1].y) + (v[j][1].z * v[j][1].z + v[j][1].w * v[j][1].w)); }
                const float rs = __builtin_amdgcn_rsqf(wave_sum(ss) * (1.f / DM) + EPS);
                GAS u32x4* o16 = (GAS u32x4*)(H + (size_t)m * DM) + F.lane;
#pragma unroll
                for (int j = 0; j < 8; ++j) { const int c4 = 2 * (F.lane + 64 * j);
                    const f32x4 a0 = ((LAS f32x4*)Av)[c4], a1 = ((LAS f32x4*)Av)[c4 + 1], b0 = ((LAS f32x4*)Bv)[c4], b1 = ((LAS f32x4*)Bv)[c4 + 1];
                    o16[64 * j] = pack8(v[j][0] * rs * a0 + b0, v[j][1] * rs * a1 + b1); }
            } else {
            const GAS f32x4* xr = (const GAS f32x4*)(m < TP ? a_xp + (size_t)m * DM : a_xs + (size_t)(m - TP) * DM) + F.lane;
            f32x4 v[16]; float ss = 0.f;
#pragma unroll
            for (int j = 0; j < 16; ++j) v[j] = xr[64 * j];
            __builtin_amdgcn_sched_barrier(0);
#pragma unroll
            for (int j = 0; j < 16; ++j) ss += (v[j].x * v[j].x + v[j].y * v[j].y) + (v[j].z * v[j].z + v[j].w * v[j].w);
            const float rs = __builtin_amdgcn_rsqf(wave_sum(ss) * (1.f / DM) + EPS);
            GAS unsigned* o4 = (GAS unsigned*)((unsigned char*)H + (size_t)m * DM) + F.lane;
#pragma unroll
            for (int j = 0; j < 16; ++j) { const f32x4 a = ((LAS f32x4*)Av)[F.lane + 64 * j], b = ((LAS f32x4*)Bv)[F.lane + 64 * j];
                f32x4 y = v[j] * rs * a + b;
#pragma unroll
                for (int i = 0; i < 4; ++i) y[i] = __builtin_amdgcn_fmed3f(y[i], -448.f, 448.f);
                int w = 0; w = __builtin_amdgcn_cvt_pk_fp8_f32(y.x, y.y, w, false); w = __builtin_amdgcn_cvt_pk_fp8_f32(y.z, y.w, w, true); o4[64 * j] = (unsigned)w; }
            }
        }
        __syncthreads();
    }
    if (!SECOND) {
        float* mf = (float*)(F.ws + WS_MODF);
        for (int i = F.vcu * (NWAVES * 64) + F.tid; i < 4 * 6 * DM; i += F.G * NWAVES * 64) { const int cb = i / (6 * DM), n = i % (6 * DM); float s = a_bada[n];
#pragma unroll
            for (int ks = 0; ks < 8; ++ks) s += modp[((size_t)ks * 4 + cb) * (6 * DM) + n];
            mf[i] = s; }
    }
}

__device__ __forceinline__ u32x2 pack8_fp8(f32x4 y0, f32x4 y1) { int w0 = 0, w1 = 0;
#pragma unroll
    for (int i = 0; i < 4; ++i) { y0[i] = __builtin_amdgcn_fmed3f(y0[i], -448.f, 448.f); y1[i] = __builtin_amdgcn_fmed3f(y1[i], -448.f, 448.f); }
    w0 = __builtin_amdgcn_cvt_pk_fp8_f32(y0[0], y0[1], w0, false); w0 = __builtin_amdgcn_cvt_pk_fp8_f32(y0[2], y0[3], w0, true);
    w1 = __builtin_amdgcn_cvt_pk_fp8_f32(y1[0], y1[1], w1, false); w1 = __builtin_amdgcn_cvt_pk_fp8_f32(y1[2], y1[3], w1, true);
    return (u32x2){(unsigned)w0, (unsigned)w1}; }
typedef f32x4 AccT[2][2][4][2];
#define EPI_LOOP_BEGIN _Pragma("unroll") for (int ai = 0; ai < 2; ++ai) _Pragma("unroll") for (int m = 0; m < 4; ++m) { const int row = u.pm * 256 + wr * 64 + fr + ai * 128 + m * 16; _Pragma("unroll") for (int bj = 0; bj < 2; ++bj) { const int ct = wc * 32 + 8 * fq + bj * 128; f32x4 v0 = acc[ai][bj][m][0], v1 = acc[ai][bj][m][1];
#define EPI_LOOP_END } }

struct EpiProj {
    unsigned char* ws;
    __device__ __forceinline__ void operator()(const AccT& acc, const pg8::Unit& u, int wr, int wc, int fr, int fq) const {
        const float isc = *(const GAS float*)(ws + WS_SCIN + 0 * (size_t)(fr & 0));
        const int colt = u.pn * 256; unsigned char* base; int ld, c0, kind = 1;
        if (colt < 4096) { base = ws + WS_Q; ld = 4096; c0 = colt; }
        else if (colt < 5120) { base = ws + WS_K; ld = 1024; c0 = colt - 4096; }
        else if (colt < 6144) { base = ws + WS_V; ld = 1024; c0 = colt - 5120; }
        else if (colt < 8192) { base = ws + WS_F; ld = 2048; c0 = colt - 6144; kind = 0; }
        else if (colt < 12288) { base = ws + WS_GA8; ld = 4096; c0 = colt - 8192; kind = 2; }
        else { base = ws + WS_GF; ld = 4096; c0 = colt - 12288; kind = 2; }
        if (kind == 0) {
            EPI_LOOP_BEGIN
                v0 = v0 * isc; v1 = v1 * isc;
                *(GAS u32x4*)((bf16_t*)base + (size_t)row * ld + c0 + ct) = pack8(v0, v1);
            EPI_LOOP_END
        } else if (kind == 1) {
            EPI_LOOP_BEGIN
                v0 = v0 * isc; v1 = v1 * isc;
                *(GAS u32x2*)(base + (size_t)row * ld + c0 + ct) = pack8_fp8(v0, v1);
            EPI_LOOP_END
        } else {
            EPI_LOOP_BEGIN
                v0 = v0 * isc; v1 = v1 * isc;
#pragma unroll
                for (int j = 0; j < 4; ++j) { v0[j] = sigmoidf_(v0[j]) * GATE8; v1[j] = sigmoidf_(v1[j]) * GATE8; }
                *(GAS u32x2*)(base + (size_t)row * ld + c0 + ct) = pack8_u8(v0, v1);
            EPI_LOOP_END
        }
    }
};
struct GemmSt0 {
    const bf16_t* A; const bf16_t* Fb; int K, lda, ldb; int S1, lg_tpg, lg_tps; long row_base, S;
    __device__ __forceinline__ const char* a_ptr(const pg8::Unit& u) const { return (const char*)A + (size_t)u.pm * 256 * lda * 2; }
    __device__ __forceinline__ const char* b_ptr(const pg8::Unit& u) const { const long g = u.pn >> lg_tpg, tt = u.pn & ((1 << lg_tpg) - 1), b = tt >> lg_tps, ti = tt & ((1 << lg_tps) - 1);
        return (const char*)Fb + ((row_base + b * S + 2 * ti) * ldb + g * 256) * 2; }
    __device__ __forceinline__ int b_rowoff(int Rb) const { return S1 * Rb; }
    __device__ __forceinline__ size_t b_hstep() const { return (size_t)ldb * 2; }
};
struct EpiSt0 {
    bf16_t* L0; int S1, lg_tpg, lg_tps;
    __device__ __forceinline__ void operator()(const AccT& acc, const pg8::Unit& u, int wr_, int wc_, int, int) const {
        const int tz = opaque_tid(wr_ * 4 + wc_), wid = __builtin_amdgcn_readfirstlane(tz >> 6), lane = tz & 63, wr = wid >> 2, wc = wid & 3, fr = lane & 15, fq = lane >> 4;
        const int g = u.pn >> lg_tpg, tt = u.pn & ((1 << lg_tpg) - 1), b = tt >> lg_tps, ti = tt & ((1 << lg_tps) - 1), bg = b * 8 + g, part = u.pm;
        const unsigned loff = ((unsigned)(64 * wr + fr) * (unsigned)S1 * 256u + (unsigned)(wc * 32 + 8 * fq)) * 2u;
#pragma unroll
        for (int ai = 0; ai < 2; ++ai)
#pragma unroll
            for (int m = 0; m < 4; ++m)
#pragma unroll
                for (int bj = 0; bj < 2; ++bj) {
                    const char* ub = (const char*)(L0 + ((((size_t)(bg * 256 + 128 * ai + 16 * m) * S1 + 2 * ti + bj) * 2 + part) * 128));
                    *(GAS u32x4*)(ub + loff) = pack8(acc[ai][bj][m][0], acc[ai][bj][m][1]);
                }
    }
};
struct EpiSt1 {
    bf16_t* L1p; bf16_t* L1s;
    __device__ __forceinline__ void operator()(const AccT& acc, const pg8::Unit& u, int wr_, int wc_, int, int) const {
        const int tz = opaque_tid(wr_ * 4 + wc_), wid = __builtin_amdgcn_readfirstlane(tz >> 6), lane = tz & 63, wr = wid >> 2, wc = wid & 3, fr = lane & 15, fq = lane >> 4;
        const bool smp = u.pn >= 512; const int lgS1 = smp ? 6 : 5, S1 = 1 << lgS1, nt0 = (smp ? u.pn - 512 : u.pn) * 256;
        const float invS = smp ? (1.f / 8192.f) : (1.f / 4096.f);
        const char* base = (const char*)(smp ? L1s : L1p);
#pragma unroll
        for (int m = 0; m < 4; ++m)
#pragma unroll
            for (int bj = 0; bj < 2; ++bj) {
                const int k2 = 64 * wr + 16 * m + fr, n0 = nt0 + wc * 32 + 8 * fq + bj * 128, bgc = n0 >> lgS1, n10 = n0 & (S1 - 1), bg = bgc >> 8, c = bgc & 255;
                const f32x4 r0 = acc[0][bj][m][0], r1 = acc[0][bj][m][1], i0 = acc[1][bj][m][0], i1 = acc[1][bj][m][1];
                float re[8] = {r0[0], r0[1], r0[2], r0[3], r1[0], r1[1], r1[2], r1[3]}, im[8] = {i0[0], i0[1], i0[2], i0[3], i1[0], i1[1], i1[2], i1[3]}, ore[8], oim[8];
#pragma unroll
                for (int j = 0; j < 8; ++j) { const float rev = (float)((n10 + j) * k2) * invS, cs = __builtin_amdgcn_cosf(rev), sn = __builtin_amdgcn_sinf(rev);
                    ore[j] = re[j] * cs + im[j] * sn; oim[j] = im[j] * cs - re[j] * sn; }
                const unsigned off = (((unsigned)((bg * 128 + k2) * 256 + c) * 2u) * (unsigned)S1 + (unsigned)n10) * 2u;
                *(GAS u32x4*)(base + off) = (u32x4){cvt_pk_bf16(ore[0], ore[1]), cvt_pk_bf16(ore[2], ore[3]), cvt_pk_bf16(ore[4], ore[5]), cvt_pk_bf16(ore[6], ore[7])};
                *(GAS u32x4*)(base + off + 2 * S1) = (u32x4){cvt_pk_bf16(oim[0], oim[1]), cvt_pk_bf16(oim[2], oim[3]), cvt_pk_bf16(oim[4], oim[5]), cvt_pk_bf16(oim[6], oim[7])};
            }
    }
};
struct EpiSt2 {
    unsigned char* out; int S1; long S; float scale;
    __device__ __forceinline__ void operator()(const AccT& acc, const pg8::Unit& u, int wr_, int wc_, int, int) const {
        const int tz = opaque_tid(wr_ * 4 + wc_), wid = __builtin_amdgcn_readfirstlane(tz >> 6), lane = tz & 63, wr = wid >> 2, wc = wid & 3, fr = lane & 15, fq = lane >> 4;
        const long bg = u.pn >> 7, k2 = u.pn & 127, b = bg >> 3, g = bg & 7;
        if (wr == 0) {
#pragma unroll
            for (int m = 0; m < 4; ++m) if (16 * m < S1)
#pragma unroll
                for (int bj = 0; bj < 2; ++bj) {
                    const long k1 = 16 * m + fr, ct = wc * 32 + 8 * fq + bj * 128;
                    *(GAS u32x2*)(out + (b * S + 128 * k1 + k2) * FW + g * 256 + ct) = pack8_fp8(acc[0][bj][m][0] * scale, acc[0][bj][m][1] * scale);
                }
        }
    }
};
#define EPI_ROWCOL(ai, m, bj) const int row = u.pm * 256 + wr * 64 + fr + (ai) * 128 + (m) * 16, ct = wc * 32 + 8 * fq + (bj) * 128
struct EpiGateA {
    bf16_t* ga; const unsigned char* ga8; const float* scp;
    __device__ __forceinline__ void operator()(const AccT& acc, const pg8::Unit& u, int wr, int wc, int fr, int fq) const {
        const float sc = *(const GAS float*)(scp + (fr & 0)) * (1.f / (ACT8 * GATE8));
#pragma unroll
        for (int ai = 0; ai < 2; ++ai) {
            u32x2 gv[4][2];
#pragma unroll
            for (int m = 0; m < 4; ++m)
#pragma unroll
                for (int bj = 0; bj < 2; ++bj) { EPI_ROWCOL(ai, m, bj); gv[m][bj] = *(const GAS u32x2*)(ga8 + (size_t)row * DM + u.pn * 256 + ct); }
            __builtin_amdgcn_sched_barrier(0);
#pragma unroll
            for (int m = 0; m < 4; ++m)
#pragma unroll
                for (int bj = 0; bj < 2; ++bj) { EPI_ROWCOL(ai, m, bj); f32x4 g0, g1; unpack8_u8(gv[m][bj], g0, g1);
                    *(GAS u32x4*)(ga + (size_t)row * DM + u.pn * 256 + ct) = pack8(g0 * (acc[ai][bj][m][0] * sc), g1 * (acc[ai][bj][m][1] * sc)); }
        }
    }
};
struct EpiGateF {
    const bf16_t* ga; const unsigned char* gf; unsigned char* m8; const float* scp;
    __device__ __forceinline__ void operator()(const AccT& acc, const pg8::Unit& u, int wr, int wc, int fr, int fq) const {
        const float sc = *(const GAS float*)(scp + (fr & 0)) * (1.f / GATE8);
#pragma unroll
        for (int ai = 0; ai < 2; ++ai) {
            u32x4 mv[4][2]; u32x2 gv[4][2];
#pragma unroll
            for (int m = 0; m < 4; ++m)
#pragma unroll
                for (int bj = 0; bj < 2; ++bj) { EPI_ROWCOL(ai, m, bj); mv[m][bj] = *(const GAS u32x4*)(ga + (size_t)row * DM + u.pn * 256 + ct); gv[m][bj] = *(const GAS u32x2*)(gf + (size_t)row * DM + u.pn * 256 + ct); }
            __builtin_amdgcn_sched_barrier(0);
#pragma unroll
            for (int m = 0; m < 4; ++m)
#pragma unroll
                for (int bj = 0; bj < 2; ++bj) { EPI_ROWCOL(ai, m, bj); f32x4 m0, m1, g0, g1; unpack8(mv[m][bj], m0, m1); unpack8_u8(gv[m][bj], g0, g1);
                    *(GAS u32x2*)(m8 + (size_t)row * DM + u.pn * 256 + ct) = pack8_fp8(m0 + g0 * (acc[ai][bj][m][0] * sc), m1 + g1 * (acc[ai][bj][m][1] * sc)); }
        }
    }
};
struct EpiResid {
    const float* xp; const float* xs; const float* modf; bf16_t* out; const float* scp;
    __device__ __forceinline__ void operator()(const AccT& acc, const pg8::Unit& u, int wr, int wc, int fr, int fq) const {
        const float sc = *(const GAS float*)(scp + (fr & 0));
        const int cb = cb_of_row(u.pm * 256); const float* g1 = modf + (size_t)cb * 6 * DM + 2 * DM + u.pn * 256;
        f32x4 q[2][2];
#pragma unroll
        for (int bj = 0; bj < 2; ++bj) { const int ct = wc * 32 + 8 * fq + bj * 128; q[bj][0] = *(const GAS f32x4*)(g1 + ct) * sc; q[bj][1] = *(const GAS f32x4*)(g1 + ct + 4) * sc; }
#pragma unroll
        for (int ai = 0; ai < 2; ++ai) {
            f32x4 xv[4][2][2];
#pragma unroll
            for (int m = 0; m < 4; ++m)
#pragma unroll
                for (int bj = 0; bj < 2; ++bj) { EPI_ROWCOL(ai, m, bj);
                    const float* xr = (row < TP ? xp + (size_t)row * DM : xs + (size_t)(row - TP) * DM) + u.pn * 256 + ct;
                    xv[m][bj][0] = *(const GAS f32x4*)xr; xv[m][bj][1] = *(const GAS f32x4*)(xr + 4); }
            __builtin_amdgcn_sched_barrier(0);
#pragma unroll
            for (int m = 0; m < 4; ++m)
#pragma unroll
                for (int bj = 0; bj < 2; ++bj) { EPI_ROWCOL(ai, m, bj);
                    *(GAS u32x4*)(out + (size_t)row * DM + u.pn * 256 + ct) = pack8(xv[m][bj][0] + q[bj][0] * acc[ai][bj][m][0], xv[m][bj][1] + q[bj][1] * acc[ai][bj][m][1]); }
        }
    }
};
struct EpiPlain {
    bf16_t* out; int ld;
    __device__ __forceinline__ void operator()(const AccT& acc, const pg8::Unit& u, int wr, int wc, int fr, int fq) const {
        EPI_LOOP_BEGIN
            *(GAS u32x4*)(out + (size_t)row * ld + u.pn * 256 + ct) = pack8(v0, v1);
        EPI_LOOP_END
    }
};

__device__ __forceinline__ void p3_qk_rope(Frame& F) {
    const int lane = F.lane, li = lane & 15;
    bf16_t* Q = (bf16_t*)(F.ws + WS_Q); bf16_t* K = (bf16_t*)(F.ws + WS_K); unsigned char* const O8 = (unsigned char*)F.out;
    float gq[8], gk[8], ifr[4]; const float* const a_qng = karg(A_QNG); const float* const a_kng = karg(A_KNG);
#pragma unroll
    for (int d = 0; d < 8; ++d) { gq[d] = a_qng[8 * li + d]; gk[d] = a_kng[8 * li + d]; }
#pragma unroll
    for (int t = 0; t < 4; ++t) ifr[t] = __builtin_amdgcn_exp2f(-(float)((4 * li + t) & 31) * (13.287712379549449f / 32.f));
    for (int m = F.vcu * NWAVES + F.wave; m < TT; m += F.G * NWAVES) {
        const int pos = m < TP ? (m & (SP - 1)) : ((m - TP) & (SS - 1));
        const float id = (float)(li < 8 ? (pos >> 6) : (pos & 63));
        float cs[4], sn[4];
#pragma unroll
        for (int t = 0; t < 4; ++t) { const float ang = id * ifr[t]; cs[t] = __cosf(ang); sn[t] = __sinf(ang); }
        u32x2 raw[10];
#pragma unroll
        for (int jj = 0; jj < 10; ++jj) raw[jj] = *(jj < 8 ? (const GAS u32x2*)((const unsigned char*)Q + (size_t)m * 4096 + jj * 512 + lane * 8) : (const GAS u32x2*)((const unsigned char*)K + (size_t)m * 1024 + (jj - 8) * 512 + lane * 8));
        __builtin_amdgcn_sched_barrier(0);
#pragma unroll
        for (int jj = 0; jj < 10; ++jj) {
            GAS u32x4* p = jj < 8 ? (GAS u32x4*)(Q + (size_t)m * 4096 + jj * 512 + lane * 8) : (GAS u32x4*)(K + (size_t)m * 1024 + (jj - 8) * 512 + lane * 8);
            f32x4 v0, v1; unpack8_fp8(raw[jj], v0, v1);
            float ss = (v0.x * v0.x + v0.y * v0.y) + (v0.z * v0.z + v0.w * v0.w) + (v1.x * v1.x + v1.y * v1.y) + (v1.z * v1.z + v1.w * v1.w);
            ss += __shfl_xor(ss, 1); ss += __shfl_xor(ss, 2); ss += __shfl_xor(ss, 4); ss += __shfl_xor(ss, 8);
            const float rs = __builtin_amdgcn_rsqf(ss * (1.f / 128.f) + EPS);
            const float* g = jj < 8 ? gq : gk;
            float y[8] = {v0.x * rs * g[0], v0.y * rs * g[1], v0.z * rs * g[2], v0.w * rs * g[3], v1.x * rs * g[4], v1.y * rs * g[5], v1.z * rs * g[6], v1.w * rs * g[7]};
            float o[8];
#pragma unroll
            for (int t = 0; t < 4; ++t) { o[2 * t] = y[2 * t] * cs[t] - y[2 * t + 1] * sn[t]; o[2 * t + 1] = y[2 * t] * sn[t] + y[2 * t + 1] * cs[t]; }
#if ATTN_FP8
            (void)p;
            const float qm = jj < 8 ? attn8::QMUL : 1.f;
            const u32x2 pk = pack8_fp8((f32x4){o[0], o[1], o[2], o[3]} * qm, (f32x4){o[4], o[5], o[6], o[7]} * qm);
            if (jj < 8) *(GAS u32x2*)(O8 + DO_Q8 + (size_t)m * 4096 + jj * 512 + lane * 8) = pk;
            else { const int kvh = (jj - 8) * 4 + (lane >> 4), key = m & 63;
                *(GAS u32x2*)(O8 + DO_K8 + ((size_t)(m >> 6) * 8 + kvh) * 8192 + key * 128 + (((li >> 1) ^ ((key >> 1) & 7)) << 4) + (li & 1) * 8) = pk; }
#else
            *p = (u32x4){cvt_pk_bf16(o[0], o[1]), cvt_pk_bf16(o[2], o[3]), cvt_pk_bf16(o[4], o[5]), cvt_pk_bf16(o[6], o[7])};
#endif
        }
    }
}

__device__ __forceinline__ void p3_vt(Frame& F) {
    const int lane = F.lane;
    const unsigned char* V = F.ws + WS_V; unsigned char* const O8 = (unsigned char*)F.out + DO_V8;
    for (int item = F.vcu * NWAVES + F.wave; item < (TT / 64) * 16; item += F.G * NWAVES) {
        const int tile = item >> 4, kvh = (item >> 1) & 7, d = (item & 1) * 64 + lane;
        const GAS unsigned char* src = (const GAS unsigned char*)(V + (size_t)tile * 64 * 1024 + kvh * 128 + d);
        unsigned raw[64];
#pragma unroll
        for (int k = 0; k < 64; ++k) raw[k] = src[(size_t)k * 1024];
        unsigned char* row = O8 + ((size_t)tile * 8 + kvh) * 8192 + d * 64; const int sv = (d >> 2) & 3;
#pragma unroll
        for (int c = 0; c < 4; ++c) { u32x4 w;
#pragma unroll
            for (int q = 0; q < 4; ++q) { unsigned x = 0;
#pragma unroll
                for (int b = 0; b < 4; ++b) { const int beta = 16 * c + 4 * q + b, hi = beta >> 5, pp = (beta >> 4) & 1, r = beta & 15, key = 32 * pp + (r & 3) + 8 * (r >> 2) + 4 * hi;
                    x |= raw[key] << (8 * b); }
                w[q] = x; }
            *(GAS u32x4*)(row + ((c ^ sv) << 4)) = w; }
    }
}

__device__ __forceinline__ void p4_attention(Frame& F, char* lds, bool dummy) {
    bf16_t* Q = (bf16_t*)(F.ws + WS_Q); const bf16_t* K = (const bf16_t*)(F.ws + WS_K); const bf16_t* V = (const bf16_t*)(F.ws + WS_V);
    for (int L = blockIdx.x; L < 2048 + 1024; L += F.G) {
        const bool smp = L < 2048; const long Lp = smp ? L : L - 2048;
        const long x = Lp & 7, w = (Lp >> 3) & 31, i = Lp >> 8;
        const long j = smp ? (i >> 2) : (i >> 1), uu = smp ? ((i & 3) * 32 + w) : ((i & 1) * 32 + w);
        const long pair = x + 8 * j, b = pair >> 3, kvh = pair & 7;
        const long h = kvh * 4 + (smp ? (uu >> 5) : (uu >> 4)), qb = smp ? (uu & 31) : (uu & 15), S = smp ? SS : SP;
        const long r0 = (smp ? (long)TP : 0) + b * S;
        bf16_t* qp = Q + (r0 + qb * 256) * 4096 + h * 128;
        unsigned char* op = (dummy ? (unsigned char*)F.out + (size_t)256 * MiB : F.ws + WS_H) + (r0 + qb * 256) * 4096 + h * 128;
#if ATTN_FP8
        (void)qp; (void)K; (void)V; (void)lds;
        const unsigned char* const o8 = (const unsigned char*)F.out;
        if (dummy) attn8::body<ATT_PROBE>(o8 + DO_Q8 + (r0 + qb * 256) * 4096 + h * 128, o8 + DO_K8 + ((r0 >> 6) * 8 + kvh) * 8192, o8 + DO_V8 + ((r0 >> 6) * 8 + kvh) * 8192, op, (int)S, (A8_LAS char*)F.lds, F.wave);
        else attn8::body128(o8 + DO_Q8 + (r0 + qb * 256) * 4096 + h * 128, o8 + DO_K8 + ((r0 >> 6) * 8 + kvh) * 8192, o8 + DO_V8 + ((r0 >> 6) * 8 + kvh) * 8192, op, (int)S, (A8_LAS char*)F.lds, F.wave);
#else
        attn::attn_dense_body<attn::bf16>((const attn::bf16*)qp, (const attn::bf16*)(K + r0 * 1024 + kvh * 128), (const attn::bf16*)(V + r0 * 1024 + kvh * 128), (float*)op, (int)S, lds);
#endif
    }
}

__device__ __forceinline__ unsigned f2ord(float f) { const unsigned u = __float_as_uint(f); return (u & 0x80000000u) ? ~u : (u | 0x80000000u); }
__device__ __forceinline__ float ord2f(unsigned o) { return __uint_as_float((o & 0x80000000u) ? (o & 0x7fffffffu) : ~o); }
__device__ __forceinline__ unsigned umax3(unsigned a, unsigned b, unsigned c) { return max(max(a, b), c); }

#define CE_DESC(x, y) do { const unsigned _hi = max(x, y), _lo = min(x, y); x = _hi; y = _lo; } while (0)
__device__ __forceinline__ void bitonic_merge16(unsigned (&a)[16]) {
#pragma unroll
    for (int j = 8; j >= 1; j >>= 1)
#pragma unroll
        for (int i = 0; i < 16; ++i) { const int l = i ^ j; if (l > i) CE_DESC(a[i], a[l]); }
}
__device__ __forceinline__ void sort16(unsigned (&a)[16]) {
#pragma unroll
    for (int k = 2; k <= 16; k <<= 1)
#pragma unroll
        for (int j = k >> 1; j >= 1; j >>= 1)
#pragma unroll
            for (int i = 0; i < 16; ++i) { const int l = i ^ j; if (l > i) { if ((i & k) == 0) CE_DESC(a[i], a[l]); else CE_DESC(a[l], a[i]); } }
}
__device__ __forceinline__ void top16_merge(unsigned (&a)[16], const unsigned (&b)[16]) {
#pragma unroll
    for (int i = 0; i < 16; ++i) a[i] = max(a[i], b[15 - i]);
    bitonic_merge16(a);
}

__device__ __forceinline__ void p9_route(Frame& F) {
    const int lane = F.lane, r32 = lane & 31, hi = lane >> 5;
    const bf16_t* PQ = (const bf16_t*)(F.ws + WS_Q); const bf16_t* KB = (const bf16_t*)(F.ws + WS_KEYS);
    int* IDX = (int*)(F.ws + WS_IDX); float* GATE = (float*)(F.ws + WS_GATE);
    LAS unsigned* cpt = (LAS unsigned*)(F.lds + F.wave * 8192) + lane * 25;
    for (int task = F.vcu * NWAVES + F.wave; task < (TT / 32) * PH; task += F.G * NWAVES) {
        const int tile = task >> 3, h = task & 7, t0 = tile * 32;
        unsigned key[8][16];
        {
            const bf16_t* qrow = PQ + (size_t)(t0 + r32) * PQW + h * 256 + hi * 8;
            f32x16 acc[2][4];
            unsigned koff = (unsigned)(((h * 256 + r32) * 128 + hi * 8) * 2);
            asm volatile("" : "+v"(koff));
#pragma unroll
            for (int p = 0; p < 2; ++p) {
                bf16x8 bq[8];
#pragma unroll
                for (int ks = 0; ks < 8; ++ks) bq[ks] = *(const GAS bf16x8*)(qrow + p * 128 + ks * 16);
#pragma unroll
                for (int nb = 0; nb < 4; ++nb) {
                    const char* krow = (const char*)KB + (size_t)(p * 128 + nb * 32) * 256;
                    bf16x8 ka[8];
#pragma unroll
                    for (int ks = 0; ks < 8; ++ks) ka[ks] = *(const GAS bf16x8*)(krow + koff + ks * 32);
                    f32x16 a = {};
#pragma unroll
                    for (int ks = 0; ks < 8; ++ks) a = __builtin_amdgcn_mfma_f32_32x32x16_bf16(ka[ks], bq[ks], a, 0, 0, 0);
                    acc[p][nb] = a;
                    __builtin_amdgcn_sched_barrier(0);
                }
            }
#pragma unroll
            for (int nb = 0; nb < 4; ++nb)
#pragma unroll
                for (int r = 0; r < 16; ++r) {
                    auto rr = __builtin_amdgcn_permlane32_swap(__float_as_uint(acc[0][nb][r]), __float_as_uint(acc[1][nb][r]), false, false);
                    unsigned k0 = (f2ord(__uint_as_float(rr[0])) & ~127u) | (unsigned)r, k1 = (f2ord(__uint_as_float(rr[1])) & ~127u) | (unsigned)r;
                    asm volatile("" : "+v"(k0), "+v"(k1));
                    key[2 * nb][r] = k0 | (unsigned)(nb << 5); key[2 * nb + 1][r] = k1 | (unsigned)(16 + (nb << 5));
                }
        }
#pragma unroll
        for (int g = 0; g < 8; ++g) sort16(key[g]);
        top16_merge(key[0], key[1]); top16_merge(key[2], key[3]); top16_merge(key[4], key[5]); top16_merge(key[6], key[7]);
        top16_merge(key[0], key[2]); top16_merge(key[4], key[6]); top16_merge(key[0], key[4]);
        float va[16], vb[16]; int ia[16], ib[16];
#pragma unroll
        for (int i = 0; i < 16; ++i) { auto rr = __builtin_amdgcn_permlane32_swap(key[0][i], key[0][i], false, false);
            const unsigned la = rr[0] & 127u, lb = rr[1] & 127u;
            va[i] = ord2f(rr[0] & ~127u); ia[i] = (int)((la & 96u) + (la & 3u) + ((la & 12u) << 1) + ((la & 16u) >> 2));
            vb[i] = ord2f(rr[1] & ~127u); ib[i] = (int)((lb & 96u) + (lb & 3u) + ((lb & 12u) << 1) + ((lb & 16u) >> 2)); }
        unsigned ck[4][16]; int nc = 0; unsigned pend = 0u;
#pragma unroll
        for (int i = 0; i < 16; ++i)
#pragma unroll
            for (int j = 0; j < 16; ++j) if ((i + 1) * (j + 1) <= 16) {
                ck[nc >> 4][nc & 15] = (f2ord(va[i] + vb[j]) & ~63u) | (unsigned)nc;
                const unsigned id = (unsigned)(ia[i] * 128 + ib[j]);
                if (nc & 1) cpt[nc >> 1] = pend | (id << 16); else pend = id;
                ++nc; }
#pragma unroll
        for (int q = 50; q < 64; ++q) ck[q >> 4][q & 15] = 0u;
        sort16(ck[1]); sort16(ck[2]); sort16(ck[3]);
        top16_merge(ck[0], ck[1]); top16_merge(ck[2], ck[3]); top16_merge(ck[0], ck[2]);
        float bv[16]; int bi[16];
#pragma unroll
        for (int rd = 0; rd < 16; ++rd) { const unsigned mx = ck[0][rd], slot = mx & 63u;
            bv[rd] = ord2f(mx & ~63u); bi[rd] = (int)((cpt[slot >> 1] >> ((slot & 1u) * 16u)) & 0xffffu); }
        float e[16], es = 0.f;
#pragma unroll
        for (int k = 0; k < 16; ++k) { e[k] = __builtin_amdgcn_exp2f((bv[k] - bv[0]) * 1.4426950408889634f); es += e[k]; }
        const float inv = 1.f / es;
        const size_t ob = (size_t)(t0 + r32) * NSEL + h * 16 + hi * 8;
#pragma unroll
        for (int k = 0; k < 8; ++k) { IDX[ob + k] = hi ? bi[8 + k] : bi[k]; GATE[ob + k] = (hi ? e[8 + k] : e[k]) * inv; }
    }
}

__device__ __forceinline__ float dpp_row_sum(float v) {
    v += __builtin_bit_cast(float, __builtin_amdgcn_update_dpp(0, __builtin_bit_cast(int, v), 0xB1, 0xF, 0xF, false));
    v += __builtin_bit_cast(float, __builtin_amdgcn_update_dpp(0, __builtin_bit_cast(int, v), 0x4E, 0xF, 0xF, false));
    v += __builtin_bit_cast(float, __builtin_amdgcn_update_dpp(0, __builtin_bit_cast(int, v), 0x141, 0xF, 0xF, false));
    v += __builtin_bit_cast(float, __builtin_amdgcn_update_dpp(0, __builtin_bit_cast(int, v), 0x140, 0xF, 0xF, false));
    return v;
}
__device__ __forceinline__ float wave_sum_u(float v) {
    v = dpp_row_sum(v);
    return __builtin_bit_cast(float, __builtin_amdgcn_readlane(__builtin_bit_cast(int, v), 0)) + __builtin_bit_cast(float, __builtin_amdgcn_readlane(__builtin_bit_cast(int, v), 16)) +
           __builtin_bit_cast(float, __builtin_amdgcn_readlane(__builtin_bit_cast(int, v), 32)) + __builtin_bit_cast(float, __builtin_amdgcn_readlane(__builtin_bit_cast(int, v), 48));
}
#define FP8_DEC(WV, o) do { const f32x2 _a = __builtin_amdgcn_cvt_pk_f32_fp8((int)(WV)[0], false), _b = __builtin_amdgcn_cvt_pk_f32_fp8((int)(WV)[0], true), _c = __builtin_amdgcn_cvt_pk_f32_fp8((int)(WV)[1], false), _d = __builtin_amdgcn_cvt_pk_f32_fp8((int)(WV)[1], true), \
    _e = __builtin_amdgcn_cvt_pk_f32_fp8((int)(WV)[2], false), _f = __builtin_amdgcn_cvt_pk_f32_fp8((int)(WV)[2], true), _g = __builtin_amdgcn_cvt_pk_f32_fp8((int)(WV)[3], false), _h = __builtin_amdgcn_cvt_pk_f32_fp8((int)(WV)[3], true); \
    o[0] = _a.x; o[1] = _a.y; o[2] = _b.x; o[3] = _b.y; o[4] = _c.x; o[5] = _c.y; o[6] = _d.x; o[7] = _d.y; o[8] = _e.x; o[9] = _e.y; o[10] = _f.x; o[11] = _f.y; o[12] = _g.x; o[13] = _g.y; o[14] = _h.x; o[15] = _h.y; } while (0)

__device__ __forceinline__ void sort128_by_id(int& i0, float& g0, int& i1, float& g1, const int lane) {
#pragma unroll
    for (int k = 2; k <= 128; k <<= 1)
#pragma unroll
        for (int j = k >> 1; j >= 1; j >>= 1) {
            if (j == 64) { if (i0 > i1) { const int ti = i0; i0 = i1; i1 = ti; const float tg = g0; g0 = g1; g1 = tg; } }
            else {
                const bool lower = (lane & j) == 0;
                const bool up0 = (k == 128) ? true : ((lane & k) == 0), up1 = up0;
                const bool upr0 = (k == 64) ? true : up0, upr1 = (k == 64) ? false : up1;
                const int oi0 = __shfl_xor(i0, j), oi1 = __shfl_xor(i1, j); const float og0 = __shfl_xor(g0, j), og1 = __shfl_xor(g1, j);
                { const bool keep_min = (lower == upr0); const bool take = keep_min ? (oi0 < i0) : (oi0 > i0); i0 = take ? oi0 : i0; g0 = take ? og0 : g0; }
                { const bool keep_min = (lower == upr1); const bool take = keep_min ? (oi1 < i1) : (oi1 > i1); i1 = take ? oi1 : i1; g1 = take ? og1 : g1; }
            }
        }
}

__device__ __forceinline__ void p10_peer(Frame& F, const bool dummy) {
    const int lane = F.lane;
    const bf16_t* H = (const bf16_t*)(F.ws + WS_H);
    const unsigned char* U8 = F.ws + WS_U8; const unsigned char* V8 = F.ws + WS_V8;
    const float* SCU = (const float*)(F.ws + WS_SCU); const float* SCV = (const float*)(F.ws + WS_SCV);
    const int* IDX = (const int*)(F.ws + WS_IDX); const float* GATE = (const float*)(F.ws + WS_GATE);
    const float* modf = (const float*)(F.ws + WS_MODF); const float* const a_fing = karg(A_FING);
    constexpr int RING = 5;
    LAS unsigned char* const ring = F.lds + F.wave * 16384;
#define P10_FENCE() do { asm volatile("" ::: "memory"); __builtin_amdgcn_sched_barrier(0); } while (0)
#define PEER_ISSUE(TAB, slot, e) do { const int _e = (e) < NSEL ? (e) : NSEL - 1; const int _row = __builtin_amdgcn_readlane(_e < 64 ? i0 : i1, _e & 63); const char* _p = (const char*)(TAB) + (size_t)_row * PROW + 16 * lane; \
        _Pragma("unroll") for (int _s = 0; _s < 3; ++_s) __builtin_amdgcn_global_load_lds((const unsigned*)(_p + 1024 * _s), (LAS unsigned*)(ring + (slot) * PROW + 1024 * _s), 16, 0, 0); } while (0)
#define PEER_WAIT() asm volatile("s_waitcnt vmcnt(12)" ::: "memory")
#define PEER_RAW(slot) u32x4 _w0 = *(const LAS u32x4*)(ring + (slot) * PROW + 16 * lane), _w1 = *(const LAS u32x4*)(ring + (slot) * PROW + 1024 + 16 * lane), _w2 = *(const LAS u32x4*)(ring + (slot) * PROW + 2048 + 16 * lane)
#define PEER_DEC_A() __builtin_amdgcn_cvt_scalef32_pk32_f32_fp6((u32x6){_w0.x, _w0.y, _w0.z, _w0.w, _w1.x, _w1.y}, 1.0f)
#define PEER_DEC_B() __builtin_amdgcn_cvt_scalef32_pk32_f32_fp6((u32x6){_w1.z, _w1.w, _w2.x, _w2.y, _w2.z, _w2.w}, 1.0f)
#define PEER_PIN_B() asm volatile("" : "+v"(_w1.z), "+v"(_w1.w), "+v"(_w2.x), "+v"(_w2.y), "+v"(_w2.z), "+v"(_w2.w))
    for (int t = F.vcu * NWAVES + F.wave; t < TT; t += F.G * NWAVES) {
        int i0 = IDX[(size_t)t * NSEL + lane], i1 = IDX[(size_t)t * NSEL + 64 + lane];
        float g0 = GATE[(size_t)t * NSEL + lane], g1 = GATE[(size_t)t * NSEL + 64 + lane];
        sort128_by_id(i0, g0, i1, g1, lane);
        const float su0 = SCU[i0], su1 = SCU[i1], sv0 = SCV[i0], sv1 = SCV[i1];
        float a0, a1;
        {
            float hv[64];
#pragma unroll
            for (int grp = 0; grp < 2; ++grp) { const GAS u32x2* hp = (const GAS u32x2*)(H + (size_t)t * DM + grp * 2048 + 4 * lane);
#pragma unroll
                for (int q = 0; q < 8; ++q) { const u32x2 w = hp[64 * q]; const int o = 32 * grp + 4 * q;
                    hv[o + 0] = bf_lo(w.x); hv[o + 1] = bf_hi(w.x); hv[o + 2] = bf_lo(w.y); hv[o + 3] = bf_hi(w.y); } }
            asm volatile("s_waitcnt vmcnt(0)" ::: "memory");
            P10_FENCE();
            float z0 = 0.f, z1 = 0.f;
#pragma unroll
            for (int k = 0; k < RING; ++k) PEER_ISSUE(U8, k, k);
            P10_FENCE();
            for (int e0 = 0; e0 < NSEL + RING - 1; e0 += RING) {
#pragma unroll
                for (int k = 0; k < RING; ++k) {
                    const int e = e0 + k; float p0 = 0.f, p1 = 0.f, p2 = 0.f, p3 = 0.f;
                    PEER_WAIT();
                    PEER_RAW(k);
                    { const f32x32 d = PEER_DEC_A();
#pragma unroll
                      for (int i = 0; i < 8; ++i) { p0 = fmaf(hv[i], d[i], p0); p1 = fmaf(hv[8 + i], d[8 + i], p1); p2 = fmaf(hv[16 + i], d[16 + i], p2); p3 = fmaf(hv[24 + i], d[24 + i], p3); } }
                    asm volatile("" : "+v"(p0), "+v"(p1), "+v"(p2), "+v"(p3)); PEER_PIN_B(); __builtin_amdgcn_sched_barrier(0);
                    { const f32x32 d = PEER_DEC_B();
#pragma unroll
                      for (int i = 0; i < 8; ++i) { p0 = fmaf(hv[32 + i], d[i], p0); p1 = fmaf(hv[40 + i], d[8 + i], p1); p2 = fmaf(hv[48 + i], d[16 + i], p2); p3 = fmaf(hv[56 + i], d[24 + i], p3); } }
                    float pz = (p0 + p1) + (p2 + p3);
                    asm volatile("" : "+v"(pz) :: "memory"); __builtin_amdgcn_sched_barrier(0);
                    PEER_ISSUE(U8, k, e + RING);
                    P10_FENCE();
                    const float z = wave_sum_u(pz);
                    z0 = (lane == e) ? z : z0; z1 = (lane == e - 64) ? z : z1;
                }
            }
            asm volatile("s_waitcnt vmcnt(0)" ::: "memory");
            z0 *= su0; z1 *= su1;
            a0 = 0.5f * z0 * (1.f + erff(z0 * 0.70710678118654752f)) * g0 * sv0; a1 = 0.5f * z1 * (1.f + erff(z1 * 0.70710678118654752f)) * g1 * sv1;
        }
        P10_FENCE();
        float ov[64];
#pragma unroll
        for (int i = 0; i < 64; ++i) ov[i] = 0.f;
#pragma unroll
        for (int k = 0; k < RING; ++k) PEER_ISSUE(V8, k, k);
        P10_FENCE();
        for (int e0 = 0; e0 < NSEL + RING - 1; e0 += RING) {
#pragma unroll
            for (int k = 0; k < RING; ++k) {
                const int e = e0 + k;
                float w = __builtin_bit_cast(float, __builtin_amdgcn_readlane(__builtin_bit_cast(int, e < 64 ? a0 : a1), e & 63));
                w = e < NSEL ? w : 0.f;
                PEER_WAIT();
                PEER_RAW(k);
                { const f32x32 d = PEER_DEC_A();
#pragma unroll
                  for (int i = 0; i < 32; ++i) asm("v_fmac_f32_e32 %0, %1, %2" : "+v"(ov[i]) : "v"(w), "v"(d[i])); }
                asm volatile("" : "+v"(ov[31]), "+v"(ov[15])); PEER_PIN_B(); __builtin_amdgcn_sched_barrier(0);
                { const f32x32 d = PEER_DEC_B();
#pragma unroll
                  for (int i = 0; i < 32; ++i) asm("v_fmac_f32_e32 %0, %1, %2" : "+v"(ov[32 + i]) : "v"(w), "v"(d[i])); }
                asm volatile("" : "+v"(ov[31]), "+v"(ov[63]) :: "memory"); __builtin_amdgcn_sched_barrier(0);
                PEER_ISSUE(V8, k, e + RING);
                P10_FENCE();
            }
        }
        asm volatile("s_waitcnt vmcnt(0)" ::: "memory");
        P10_FENCE();
        const int cb = cb_of_row(t);
        float* orow = F.out + (size_t)t * DM + 4 * lane;
        const float* g2 = modf + (size_t)cb * 6 * DM + 5 * DM + 4 * lane; const float* fg = a_fing + 4 * lane;
        float ss = 0.f;
        const bf16_t* x1r = (const bf16_t*)(F.ws + WS_GF) + (size_t)t * DM + 4 * lane;
#pragma unroll
        for (int grp = 0; grp < 2; ++grp) {
            u32x2 xr[8]; f32x4 gv[8];
#pragma unroll
            for (int q = 0; q < 8; ++q) xr[q] = *(const GAS u32x2*)(x1r + 2048 * grp + 256 * q);
#pragma unroll
            for (int q = 0; q < 8; ++q) gv[q] = *(const GAS f32x4*)(g2 + 2048 * grp + 256 * q);
            __builtin_amdgcn_sched_barrier(0);
#pragma unroll
            for (int q = 0; q < 8; ++q) { const f32x4 xa = (f32x4){bf_lo(xr[q].x), bf_hi(xr[q].x), bf_lo(xr[q].y), bf_hi(xr[q].y)};
#pragma unroll
                for (int i = 0; i < 4; ++i) { const float x2 = xa[i] + gv[q][i] * ov[32 * grp + 4 * q + i]; ov[32 * grp + 4 * q + i] = x2; ss = fmaf(x2, x2, ss); } }
        }
        const float rs = __builtin_amdgcn_rsqf(wave_sum_u(ss) * (1.f / DM) + EPS);
        if (dummy) { if (lane == 0) ((float*)(F.ws + WS_MODP))[t] = rs; }
        else {
#pragma unroll
        for (int grp = 0; grp < 2; ++grp) {
            f32x4 fv[8];
#pragma unroll
            for (int q = 0; q < 8; ++q) fv[q] = *(const GAS f32x4*)(fg + 2048 * grp + 256 * q);
            __builtin_amdgcn_sched_barrier(0);
#pragma unroll
            for (int q = 0; q < 8; ++q) { f32x4 y;
#pragma unroll
                for (int i = 0; i < 4; ++i) y[i] = ov[32 * grp + 4 * q + i] * rs * fv[q][i];
                *(GAS f32x4*)(orow + 2048 * grp + 256 * q) = y; }
        }
        }
        asm volatile("s_waitcnt vmcnt(0)" ::: "memory");
        P10_FENCE();
    }
#undef PEER_ISSUE
#undef PEER_WAIT
#undef PEER_RAW
#undef PEER_DEC_A
#undef PEER_DEC_B
#undef PEER_PIN_B
#undef P10_FENCE
}

#ifdef PEER_REF_PROBE
__device__ __forceinline__ void p10_peer_ref(Frame& F) {
    const int lane = F.lane;
    const bf16_t* H = (const bf16_t*)(F.ws + WS_H);
    const int* IDX = (const int*)(F.ws + WS_IDX); const float* GATE = (const float*)(F.ws + WS_GATE);
    const float* modf = (const float*)(F.ws + WS_MODF); const float* const a_fing = karg(A_FING); const float* const a_pu = karg(A_PU); const float* const a_pv = karg(A_PV);
    for (int t = F.vcu * NWAVES + F.wave; t < TT; t += F.G * NWAVES) {
        const int i0 = IDX[(size_t)t * NSEL + lane], i1 = IDX[(size_t)t * NSEL + 64 + lane];
        const float g0 = GATE[(size_t)t * NSEL + lane], g1 = GATE[(size_t)t * NSEL + 64 + lane];
        float hv[64];
#pragma unroll
        for (int grp = 0; grp < 2; ++grp) { const GAS u32x4* hp = (const GAS u32x4*)(H + (size_t)t * DM + grp * 2048 + 32 * lane);
#pragma unroll
            for (int q = 0; q < 4; ++q) { const u32x4 w = hp[q]; f32x4 a, b; unpack8(w, a, b); const int o = 32 * grp + 8 * q;
                hv[o + 0] = a.x; hv[o + 1] = a.y; hv[o + 2] = a.z; hv[o + 3] = a.w; hv[o + 4] = b.x; hv[o + 5] = b.y; hv[o + 6] = b.z; hv[o + 7] = b.w; } }
        float z0 = 0.f, z1 = 0.f;
        for (int e = 0; e < NSEL; ++e) {
            const int row = __builtin_amdgcn_readlane(e < 64 ? i0 : i1, e & 63); const float* up = a_pu + (size_t)row * DM + 32 * lane; float part = 0.f;
#pragma unroll
            for (int grp = 0; grp < 2; ++grp)
#pragma unroll
                for (int q = 0; q < 8; ++q) { const f32x4 u = *(const GAS f32x4*)(up + 2048 * grp + 4 * q);
#pragma unroll
                    for (int i = 0; i < 4; ++i) part = fmaf(hv[32 * grp + 4 * q + i], u[i], part); }
            const float z = wave_sum_u(part);
            z0 = (lane == e) ? z : z0; z1 = (lane == e - 64) ? z : z1;
        }
        const float a0 = 0.5f * z0 * (1.f + erff(z0 * 0.70710678118654752f)) * g0, a1 = 0.5f * z1 * (1.f + erff(z1 * 0.70710678118654752f)) * g1;
        float ov[64];
#pragma unroll
        for (int i = 0; i < 64; ++i) ov[i] = 0.f;
        for (int e = 0; e < NSEL; ++e) {
            const int row = __builtin_amdgcn_readlane(e < 64 ? i0 : i1, e & 63); const float* vp = a_pv + (size_t)row * DM + 32 * lane;
            const float w = __builtin_bit_cast(float, __builtin_amdgcn_readlane(__builtin_bit_cast(int, e < 64 ? a0 : a1), e & 63));
#pragma unroll
            for (int grp = 0; grp < 2; ++grp)
#pragma unroll
                for (int q = 0; q < 8; ++q) { const f32x4 v = *(const GAS f32x4*)(vp + 2048 * grp + 4 * q);
#pragma unroll
                    for (int i = 0; i < 4; ++i) asm("v_fmac_f32_e32 %0, %1, %2" : "+v"(ov[32 * grp + 4 * q + i]) : "v"(w), "v"(v[i])); }
        }
        const int cb = cb_of_row(t);
        float* orow = F.out + (size_t)t * DM + 32 * lane;
        const float* g2 = modf + (size_t)cb * 6 * DM + 5 * DM + 32 * lane; const float* fg = a_fing + 32 * lane;
        float ss = 0.f;
#pragma unroll
        for (int grp = 0; grp < 2; ++grp)
#pragma unroll
            for (int q = 0; q < 8; ++q) { const f32x4 gv = *(const GAS f32x4*)(g2 + 2048 * grp + 4 * q); const bf16_t* xb = (const bf16_t*)(F.ws + WS_GF) + (size_t)t * DM + 32 * lane + 2048 * grp + 4 * q;
#pragma unroll
                for (int i = 0; i < 4; ++i) { const float x2 = __uint_as_float((unsigned)xb[i] << 16) + gv[i] * ov[32 * grp + 4 * q + i]; ov[32 * grp + 4 * q + i] = x2; ss = fmaf(x2, x2, ss); } }
        const float rs = __builtin_amdgcn_rsqf(wave_sum_u(ss) * (1.f / DM) + EPS);
#pragma unroll
        for (int grp = 0; grp < 2; ++grp)
#pragma unroll
            for (int q = 0; q < 8; ++q) { const f32x4 fv = *(const GAS f32x4*)(fg + 2048 * grp + 4 * q); f32x4 y;
#pragma unroll
                for (int i = 0; i < 4; ++i) y[i] = ov[32 * grp + 4 * q + i] * rs * fv[i];
                *(GAS f32x4*)(orow + 2048 * grp + 4 * q) = y; }
    }
}
#endif

#ifndef DUP_PHASE
#define DUP_PHASE -1
#endif
#define DUP(k) for (int _rep = 0; _rep < ((DUP_PHASE == (k)) ? 2 : 1); ++_rep)
#ifndef MK_N_LAUNCHES
#define MK_N_LAUNCHES 1
#endif
constexpr int N_PHASES = 12;
struct Args { const float* in[19]; float* out; unsigned char* ws; int ph_lo, ph_hi; };
__global__ void __launch_bounds__(NWAVES * 64, 2) fwd(Args args) {
    extern __shared__ __attribute__((aligned(16))) unsigned char lds[];
    Frame F;
    F.lds = (LAS unsigned char*)lds;
    F.tid = threadIdx.x; F.lane = F.tid & 63; F.wave = __builtin_amdgcn_readfirstlane(F.tid >> 6);
    F.G = gridDim.x; { const int bx = blockIdx.x; F.vcu = (F.G % 8 == 0) ? (bx % 8) * (F.G / 8) + bx / 8 : bx; }
    F.out = args.out; F.ws = args.ws;
    unsigned char* ws = args.ws;
    volatile LAS unsigned* MISC = (volatile LAS unsigned*)(F.lds + MISC_OFF);
    if (F.tid < 32) MISC[F.tid] = 0u;
    __syncthreads();
    const int lo = args.ph_lo, hi = args.ph_hi;
    XcdBarrier bar; bar.bar = (unsigned*)(ws + WS_CTL) + CW_BAR; bar.x = 0; bar.st = nullptr;
    if (hi - lo > 1) bar = xcd_barrier_post((unsigned*)(ws + WS_CTL) + CW_BAR, MISC + 8, F.tid);
#ifdef ONLY_PHASE
#define IN(k) ((k) == ONLY_PHASE && lo <= (k) && (k) < hi)
#else
#define IN(k) (lo <= (k) && (k) < hi)
#endif
#define SEAM(k) do { if (IN(k) && IN((k) + 1)) { xcd_barrier(bar, opaque_tid(F.wave)); } } while (0)
    bf16_t* const Hb = (bf16_t*)(ws + WS_H); bf16_t* const Qb = (bf16_t*)(ws + WS_Q); bf16_t* const Fb = (bf16_t*)(ws + WS_F);
    bf16_t* const GAb = (bf16_t*)(ws + WS_GA); bf16_t* const GFb = (bf16_t*)(ws + WS_GF);
    bf16_t* const L0P = Hb; bf16_t* const L0S = Hb + (size_t)2 * NFG * FG * (2 * SP);
    unsigned char* const M8 = ws + WS_H + (size_t)96 * MiB;
    bf16_t* const L1P = (bf16_t*)(ws + WS_L1); bf16_t* const L1S = L1P + (size_t)2 * NFG * FG * (2 * SP);

#define REFRESH() do { F.tid = opaque_tid(F.wave); F.lane = F.tid & 63; } while (0)
    if (IN(0)) { REFRESH(); p0_prologue(F); if (DUP_PHASE == 0) { __syncthreads(); REFRESH(); p0_prologue(F); } } SEAM(0);
    if (IN(1)) { DUP(1) { REFRESH(); p_normmod<false>(F); } } SEAM(1);
    if (IN(2)) {
        pg8::GemmPlain g{Hb, (const bf16_t*)(ws + WS_WIN), DM / 2, DM / 2, DM / 2}; pg8::StaticOrder S; S.init(TT, NIN, F.G, (int)blockIdx.x);
        EpiProj E{ws}; DUP(2) pg8::gemm_phase<EpiProj, pg8::GemmPlain, true, true, true>(F.lds, g, S, E, F.wave);
    } SEAM(2);
    if (IN(3)) {
        REFRESH(); p3_qk_rope(F);
#if ATTN_FP8
        REFRESH(); p3_vt(F);
#endif
        if (blockIdx.x == 0 && F.tid < 128) ((unsigned*)(ws + WS_L1 + (size_t)192 * MiB))[F.tid] = 0u;
        int kc_ = FG; asm volatile("" : "+s"(kc_));
        DUP(3) {
        { GemmSt0 g{(const bf16_t*)(ws + WS_CS), Fb, kc_, FG, FW, 32, 5, 4, 0, SP}; pg8::StaticOrder S; S.init(512, NFG * TP, F.G, (int)blockIdx.x);
          EpiSt0 E{L0P, 32, 5, 4}; pg8::gemm_phase<EpiSt0, GemmSt0>(F.lds, g, S, E, F.wave); }
        { GemmSt0 g{(const bf16_t*)(ws + WS_CS), Fb, kc_, FG, FW, 64, 6, 5, TP, SS}; pg8::StaticOrder S; S.init(512, NFG * TS, F.G, (int)blockIdx.x);
          EpiSt0 E{L0S, 64, 6, 5}; pg8::gemm_phase<EpiSt0, GemmSt0>(F.lds, g, S, E, F.wave); }
        }
    } SEAM(3);
    if (IN(4)) {
        int kc_ = 256; asm volatile("" : "+s"(kc_));
        pg8::GemmPlain g{(const bf16_t*)(ws + WS_D128), L0P, kc_, 256, 256}; pg8::StaticOrder S; S.init(256, 2 * NFG * FG * (32 + 64), F.G, (int)blockIdx.x);
        EpiSt1 E{L1P, L1S}; DUP(4) pg8::gemm_phase<EpiSt1, pg8::GemmPlain>(F.lds, g, S, E, F.wave);
    } SEAM(4);
    if (IN(5)) {
        int kc_ = 128; asm volatile("" : "+s"(kc_));
        DUP(51) {
        { pg8::GemmPlain g{(const bf16_t*)(ws + WS_DS32), L1P, kc_, 256, 64}; pg8::StaticOrder S; S.init(256, 2 * NFG * 128 * FG, F.G, (int)blockIdx.x);
          EpiSt2 E{(unsigned char*)Fb, 32, SP, 0.015625f}; pg8::gemm_phase<EpiSt2, pg8::GemmPlain>(F.lds, g, S, E, F.wave); }
        { pg8::GemmPlain g{(const bf16_t*)(ws + WS_DS64), L1S, kc_, 256, 128}; pg8::StaticOrder S; S.init(256, 2 * NFG * 128 * FG, F.G, (int)blockIdx.x);
          EpiSt2 E{(unsigned char*)Fb + (size_t)TP * FW, 64, SS, 0.011048543456039806f}; pg8::gemm_phase<EpiSt2, pg8::GemmPlain>(F.lds, g, S, E, F.wave); }
        }
        if (DUP_PHASE == 50) { REFRESH(); p4_attention(F, (char*)lds, true); }
        REFRESH(); p4_attention(F, (char*)lds, false);
    } SEAM(5);
    if (IN(6)) {
        { pg8::GemmPlain g{Hb, (const bf16_t*)(ws + WS_WATT), DM / 2, DM / 2, DM / 2}; pg8::StaticOrder S; S.init(TT, DM, F.G, (int)blockIdx.x);
          EpiGateA E{GAb, ws + WS_GA8, (const float*)(ws + WS_SCIN) + 1}; pg8::gemm_phase<EpiGateA, pg8::GemmPlain, true, true, true>(F.lds, g, S, E, F.wave); }
        { pg8::GemmPlain g{Fb, (const bf16_t*)(ws + WS_WFOUR), FW / 2, FW / 2, FW / 2}; pg8::StaticOrder S; S.init(TT, DM, F.G, (int)blockIdx.x);
          EpiGateF E{GAb, ws + WS_GF, M8, (const float*)(ws + WS_SCIN) + 3}; pg8::gemm_phase<EpiGateF, pg8::GemmPlain, true, true, true>(F.lds, g, S, E, F.wave); }
    } SEAM(6);
    if (IN(7)) {
        pg8::GemmPlain g{(const bf16_t*)M8, (const bf16_t*)(ws + WS_WOUT), DM / 2, DM / 2, DM / 2}; pg8::StaticOrder S; S.init(TT, DM, F.G, (int)blockIdx.x);
        EpiResid E{karg(A_XP), karg(A_XS), (const float*)(ws + WS_MODF), GFb, (const float*)(ws + WS_SCIN) + 2}; DUP(7) pg8::gemm_phase<EpiResid, pg8::GemmPlain, true, true, true>(F.lds, g, S, E, F.wave);
    } SEAM(7);
    if (IN(8)) { REFRESH(); p_normmod<true>(F); } SEAM(8);
    if (IN(9)) {
        pg8::GemmPlain g{Hb, (const bf16_t*)(ws + WS_WPQ), DM, DM, DM}; pg8::StaticOrder S; S.init(TT, PQW, F.G, (int)blockIdx.x);
        EpiPlain E{Qb, PQW}; DUP(9) pg8::gemm_phase<EpiPlain, pg8::GemmPlain>(F.lds, g, S, E, F.wave);
    } SEAM(9);
    if (IN(10)) { DUP(10) { REFRESH(); p9_route(F); } } SEAM(10);
#ifdef PEER_REF_PROBE
    if (IN(11)) { REFRESH(); p10_peer_ref(F); }
#else
    if (IN(11)) { if (DUP_PHASE == 11) { REFRESH(); p10_peer(F, true); } REFRESH(); p10_peer(F, false); }
#endif
#undef IN
#undef SEAM
}

extern "C" void kernel_launch(void* const* d_in, const int* in_sizes, int n_in, void* d_out, int out_size, void* d_ws, size_t ws_size, hipStream_t stream) {
    static int grid = 0;
    if (grid == 0) {
        if (n_in != 19 || in_sizes[0] != TP * DM || in_sizes[1] != TS * DM || out_size != TT * DM || ws_size < WS_END) {
            fprintf(stderr, "kernel_launch: unexpected shapes: n_in %d in0 %d in1 %d out %d ws %zu (need %zu); nothing launched\n", n_in, n_in > 0 ? in_sizes[0] : -1, n_in > 1 ? in_sizes[1] : -1, out_size, ws_size, (size_t)WS_END); grid = -1; return; }
        int dev = 0, cus = 0, per_cu = 0;
        if (hipGetDevice(&dev) != hipSuccess || hipDeviceGetAttribute(&cus, hipDeviceAttributeMultiprocessorCount, dev) != hipSuccess) { grid = -1; return; }
        if (hipFuncSetAttribute((const void*)fwd, hipFuncAttributeMaxDynamicSharedMemorySize, LDS_BYTES) != hipSuccess) { fprintf(stderr, "kernel_launch: hipFuncSetAttribute failed\n"); grid = -1; return; }
        if (hipOccupancyMaxActiveBlocksPerMultiprocessor(&per_cu, (const void*)fwd, NWAVES * 64, LDS_BYTES) != hipSuccess || per_cu < 1) { fprintf(stderr, "kernel_launch: occupancy query says %d workgroups per CU\n", per_cu); (void)hipGetLastError(); grid = -1; return; }
        grid = cus;
    }
    if (grid < 0) return;
    if (hipMemsetAsync((char*)d_ws + WS_CTL, 0, CTL_ZERO_BYTES, stream) != hipSuccess) return;
    Args a{};
    for (int i = 0; i < 19; ++i) a.in[i] = (const float*)d_in[i];
    a.out = (float*)d_out; a.ws = (unsigned char*)d_ws;
#if MK_N_LAUNCHES == 1
    a.ph_lo = 0; a.ph_hi = N_PHASES;
    hipLaunchKernelGGL(fwd, dim3(grid), dim3(NWAVES * 64), LDS_BYTES, stream, a);
#else
    for (int p = 0; p < N_PHASES; ++p) { a.ph_lo = p; a.ph_hi = p + 1; hipLaunchKernelGGL(fwd, dim3(grid), dim3(NWAVES * 64), LDS_BYTES, stream, a); }
#endif
}
```

```cpp
#include <hip/hip_runtime.h>
#include <hip/hip_bf16.h>
#include <cstdio>
#include <cstdint>

#define GAS __attribute__((address_space(1)))
#define LAS __attribute__((address_space(3)))
typedef unsigned short bf16_t;
typedef short bf16x8 __attribute__((ext_vector_type(8)));
typedef short s16x4 __attribute__((ext_vector_type(4)));
typedef float f32x2 __attribute__((ext_vector_type(2)));
typedef float f32x4 __attribute__((ext_vector_type(4)));
typedef float f32x16 __attribute__((ext_vector_type(16)));
typedef unsigned u32x2 __attribute__((ext_vector_type(2)));
typedef unsigned u32x4 __attribute__((ext_vector_type(4)));
typedef unsigned u32x6 __attribute__((ext_vector_type(6)));
typedef int i32x8 __attribute__((ext_vector_type(8)));
typedef float f32x32 __attribute__((ext_vector_type(32)));

constexpr int DM = 4096;
constexpr int SP = 4096, SS = 8192;
constexpr int TP = 2 * SP, TS = 2 * SS, TT = TP + TS;
constexpr int NIN = 16384;
constexpr int HD = 128, NH = 32, NKV = 8;
constexpr int FW = 2048, FG = 256, NFG = 8;
constexpr int PH = 8, PNK = 128, PHALF = 128, PTOPK = 16, PQW = 2048, NSEL = 128, PN = 16384;
constexpr float EPS = 1e-6f;
constexpr int PROW = 3072;

__device__ __forceinline__ int cb_of_row(int m) { return m < SP ? 0 : (m < TP ? 1 : (m < TP + SS ? 2 : 3)); }

__device__ __forceinline__ unsigned cvt_pk_bf16(float lo, float hi) { unsigned r; asm volatile("v_cvt_pk_bf16_f32 %0, %1, %2" : "=v"(r) : "v"(lo), "v"(hi)); return r; }
__device__ __forceinline__ float bf_lo(unsigned w) { return __uint_as_float(w << 16); }
__device__ __forceinline__ float bf_hi(unsigned w) { return __uint_as_float(w & 0xffff0000u); }
__device__ __forceinline__ u32x4 pack8(f32x4 v0, f32x4 v1) { u32x4 w; w.x = cvt_pk_bf16(v0[0], v0[1]); w.y = cvt_pk_bf16(v0[2], v0[3]); w.z = cvt_pk_bf16(v1[0], v1[1]); w.w = cvt_pk_bf16(v1[2], v1[3]); return w; }
__device__ __forceinline__ void unpack8(u32x4 w, f32x4& v0, f32x4& v1) { v0 = (f32x4){bf_lo(w.x), bf_hi(w.x), bf_lo(w.y), bf_hi(w.y)}; v1 = (f32x4){bf_lo(w.z), bf_hi(w.z), bf_lo(w.w), bf_hi(w.w)}; }
__device__ __forceinline__ void unpack8_fp8(u32x2 w, f32x4& v0, f32x4& v1) {
    const f32x2 a = __builtin_amdgcn_cvt_pk_f32_fp8((int)w.x, false), b = __builtin_amdgcn_cvt_pk_f32_fp8((int)w.x, true);
    const f32x2 c = __builtin_amdgcn_cvt_pk_f32_fp8((int)w.y, false), d = __builtin_amdgcn_cvt_pk_f32_fp8((int)w.y, true);
    v0 = (f32x4){a[0], a[1], b[0], b[1]}; v1 = (f32x4){c[0], c[1], d[0], d[1]}; }
__device__ __forceinline__ void unpack8_u8(u32x2 w, f32x4& v0, f32x4& v1) {
    v0 = (f32x4){(float)(w.x & 0xffu), (float)((w.x >> 8) & 0xffu), (float)((w.x >> 16) & 0xffu), (float)(w.x >> 24)};
    v1 = (f32x4){(float)(w.y & 0xffu), (float)((w.y >> 8) & 0xffu), (float)((w.y >> 16) & 0xffu), (float)(w.y >> 24)}; }
__device__ __forceinline__ u32x2 pack8_u8(f32x4 y0, f32x4 y1) {
    unsigned w0 = 0u, w1 = 0u;
#pragma unroll
    for (int i = 0; i < 4; ++i) { w0 = __builtin_amdgcn_cvt_pk_u8_f32(y0[i], (unsigned)i, w0); w1 = __builtin_amdgcn_cvt_pk_u8_f32(y1[i], (unsigned)i, w1); }
    return (u32x2){w0, w1}; }
__device__ __forceinline__ float sigmoidf_(float v) { return __builtin_amdgcn_rcpf(1.0f + __builtin_amdgcn_exp2f(-1.4426950408889634f * v)); }

__device__ __forceinline__ int opaque_tid(const int wave) { int l = (int)__builtin_amdgcn_mbcnt_hi(~0u, __builtin_amdgcn_mbcnt_lo(~0u, 0u)); asm volatile("" : "+v"(l)); return (wave << 6) | l; }

namespace pg8 {
#define PG8_LAS __attribute__((address_space(3)))
constexpr int BM = 256, BK = 64, HALF = 128, HTB = HALF * BK * 2  , STAGE_BYTES = 8 * HTB, NXCD = 8, WGM = 8;

__host__ __device__ __forceinline__ int lds_byte(int r, int c) { const int st = (r >> 4) * 2 + (c >> 5), rr = r & 15, cc = c & 31, ob = rr * 64 + cc * 2; return st * 1024 + (ob ^ (((ob >> 9) & 1) << 5)); }
__host__ __device__ __forceinline__ void stage_rc(int b, int& R, int& C) { const int st = b / 1024, sb = b % 1024, swz = sb ^ (((sb >> 9) & 1) << 5); R = (st >> 1) * 16 + swz / 64; C = (st & 1) * 32 + (swz % 64) / 2; }
__host__ __device__ __forceinline__ int perm32(int rho) { const int n = rho >> 4, i = rho & 15; return 8 * (i >> 2) + 4 * n + (i & 3); }

struct Unit { int pm, pn; };

struct StaticOrder {
    int nM, nN, nwg, G, c;
    __host__ __device__ void init(int M, int N, int G_, int c_) { nM = M / BM; nN = N / BM; nwg = nM * nN; G = G_; c = c_; }
    __host__ __device__ bool next(int i, Unit& u) const {
        const long L = (long)i * G + c; if (L >= nwg) return false;
        int wgid = (int)L; { const int q = nwg / NXCD, r = nwg % NXCD, xcd = wgid % NXCD, off = wgid / NXCD; wgid = (xcd < r ? xcd * (q + 1) : r * (q + 1) + (xcd - r) * q) + off; }
        const int nig = WGM * nN, gid = wgid / nig, fm = gid * WGM, gsz = (nM - fm) < WGM ? (nM - fm) : WGM;
        u.pm = fm + ((wgid % nig) % gsz); u.pn = (wgid % nig) / gsz; return true;
    }
};

struct GemmPlain {
    const bf16_t* A; const bf16_t* Bt; int K, lda, ldb;
    __device__ __forceinline__ const char* a_ptr(const Unit& u) const { return (const char*)A + (size_t)u.pm * BM * lda * 2; }
    __device__ __forceinline__ const char* b_ptr(const Unit& u) const { return (const char*)Bt + (size_t)u.pn * BM * ldb * 2; }
    __device__ __forceinline__ int b_rowoff(int Rb) const { return Rb; }
    __device__ __forceinline__ size_t b_hstep() const { return (size_t)HALF * ldb * 2; }
};

template <class Epi, class Ops, bool ALIGN_EPI = true, bool SP2 = true, bool FP8 = false>
__device__ __forceinline__ void gemm_phase(PG8_LAS unsigned char* lds, const Ops g, const StaticOrder& S, const Epi& E, const int wave) {
    const int tid = opaque_tid(wave), wid = wave, lane = tid & 63, wr = wid >> 2, wc = wid & 3, fr = lane & 15, fq = lane >> 4;
    const int K = g.K, nt = K / BK;
    unsigned voffA[2], voffB[2];
#pragma unroll
    for (int i = 0; i < 2; ++i) { int R, C; stage_rc(tid * 16 + i * 8192, R, C); const int Rb = ((R & ~31) + perm32(R & 31));
        voffA[i] = (unsigned)(R * g.lda + C) * 2u; voffB[i] = (unsigned)(g.b_rowoff(Rb) * g.ldb + C) * 2u; }
    const size_t kstep = (size_t)(BK * 2);
    const size_t hstepA = (size_t)HALF * g.lda * 2, hstepB = g.b_hstep();
    const unsigned ldsw = (unsigned)wid * 1024u;
    const int aoff = FP8 ? lds_byte(wr * 64 + fr, 16 * fq) : lds_byte(wr * 64 + fr, fq * 8), boff = FP8 ? lds_byte(wc * 32 + fr, 16 * fq) : lds_byte(wc * 32 + fr, fq * 8);
    const int aoff1 = lds_byte(wr * 64 + fr, 16 * fq + 8), boff1 = lds_byte(wc * 32 + fr, 16 * fq + 8);
#define PG8_SA(b, h) (((b) * 2 + (h)) * HTB)
#define PG8_SB(b, h) ((4 + (b) * 2 + (h)) * HTB)
#define PG8_STAGE(bufoff, gbase, voff) do { _Pragma("unroll") for (int _i = 0; _i < 2; ++_i) \
        __builtin_amdgcn_global_load_lds((const unsigned*)((const char*)(gbase) + (voff)[_i]), (PG8_LAS unsigned*)(lds + (bufoff) + ldsw + _i * 8192), 16, 0, 0); } while (0)
#define PG8_LDA(dst, b, h) do { if constexpr (FP8) { _Pragma("unroll") for (int m = 0; m < 4; ++m) { const u32x4 _l = *(const PG8_LAS u32x4*)(lds + PG8_SA(b, h) + aoff + m * 2048), _h = *(const PG8_LAS u32x4*)(lds + PG8_SA(b, h) + aoff1 + m * 2048); \
            dst##8[m] = (i32x8){(int)_l.x, (int)_l.y, (int)_l.z, (int)_l.w, (int)_h.x, (int)_h.y, (int)_h.z, (int)_h.w}; } } \
        else { _Pragma("unroll") for (int m = 0; m < 4; ++m) _Pragma("unroll") for (int k = 0; k < 2; ++k) dst[m][k] = *(const PG8_LAS bf16x8*)(lds + PG8_SA(b, h) + aoff + m * 2048 + k * 1024); } } while (0)
#define PG8_LDB(dst, b, h) do { if constexpr (FP8) { _Pragma("unroll") for (int n = 0; n < 2; ++n) { const u32x4 _l = *(const PG8_LAS u32x4*)(lds + PG8_SB(b, h) + boff + n * 2048), _h = *(const PG8_LAS u32x4*)(lds + PG8_SB(b, h) + boff1 + n * 2048); \
            dst##8[n] = (i32x8){(int)_l.x, (int)_l.y, (int)_l.z, (int)_l.w, (int)_h.x, (int)_h.y, (int)_h.z, (int)_h.w}; } } \
        else { _Pragma("unroll") for (int n = 0; n < 2; ++n) _Pragma("unroll") for (int k = 0; k < 2; ++k) dst[n][k] = *(const PG8_LAS bf16x8*)(lds + PG8_SB(b, h) + boff + n * 2048 + k * 1024); } } while (0)
#define PG8_MMA(ai, bj, At, Bt) do { __builtin_amdgcn_s_setprio(1); if constexpr (FP8) { _Pragma("unroll") for (int m = 0; m < 4; ++m) _Pragma("unroll") for (int n = 0; n < 2; ++n) \
            asm volatile("v_mfma_scale_f32_16x16x128_f8f6f4 %0, %1, %2, %0, %3, %3 op_sel_hi:[0,0,0]" : "+v"(acc[ai][bj][m][n]) : "v"(Bt##8[n]), "v"(At##8[m]), "v"(one_scale)); } \
        else { _Pragma("unroll") for (int m = 0; m < 4; ++m) _Pragma("unroll") for (int n = 0; n < 2; ++n) _Pragma("unroll") for (int k = 0; k < 2; ++k) \
            acc[ai][bj][m][n] = __builtin_amdgcn_mfma_f32_16x16x32_bf16(Bt[n][k], At[m][k], acc[ai][bj][m][n], 0, 0, 0); } __builtin_amdgcn_s_setprio(0); } while (0)
#define PG8_WAIT_V(n) asm volatile("s_waitcnt vmcnt(" #n ")" ::: "memory")
#define PG8_WAIT_L(n) asm volatile("s_waitcnt lgkmcnt(" #n ")" ::: "memory")
#define PG8_BAR __builtin_amdgcn_s_barrier()
#define PG8_SCHED __builtin_amdgcn_sched_barrier(0)
    Unit cur, nxt; int ui = 0;
    if (!S.next(0, cur)) return;
    f32x4 acc[2][2][4][2];
#pragma unroll
    for (int a = 0; a < 2; ++a)
#pragma unroll
        for (int b = 0; b < 2; ++b)
#pragma unroll
            for (int m = 0; m < 4; ++m)
#pragma unroll
                for (int n = 0; n < 2; ++n) acc[a][b][m][n] = (f32x4){0.f, 0.f, 0.f, 0.f};
    bf16x8 At[4][2], B0[2][2], B1[2][2]; i32x8 At8[4], B08[2], B18[2];
    const int one_scale = 0x7F7F7F7F;
    const char* cA = g.a_ptr(cur); const char* cB = g.b_ptr(cur);
    if constexpr (SP2) {
        PG8_STAGE(PG8_SB(0, 0), cB, voffB); PG8_STAGE(PG8_SB(0, 1), cB + hstepB, voffB); PG8_STAGE(PG8_SA(0, 0), cA, voffA); PG8_STAGE(PG8_SA(0, 1), cA + hstepA, voffA);
        if (wr == 1) PG8_BAR;
        PG8_WAIT_V(2); PG8_BAR;
        PG8_STAGE(PG8_SB(1, 0), cB + kstep, voffB); PG8_STAGE(PG8_SA(1, 0), cA + kstep, voffA); PG8_STAGE(PG8_SB(1, 1), cB + hstepB + kstep, voffB);
        PG8_WAIT_V(6); PG8_BAR;
    } else {
        PG8_STAGE(PG8_SB(0, 0), cB, voffB); PG8_STAGE(PG8_SA(0, 0), cA, voffA); PG8_STAGE(PG8_SB(0, 1), cB + hstepB, voffB); PG8_STAGE(PG8_SA(0, 1), cA + hstepA, voffA);
        if (wr == 1) PG8_BAR;
        PG8_WAIT_V(4); PG8_BAR;
        PG8_STAGE(PG8_SB(1, 0), cB + kstep, voffB); PG8_STAGE(PG8_SA(1, 0), cA + kstep, voffA); PG8_STAGE(PG8_SB(1, 1), cB + hstepB + kstep, voffB);
        PG8_WAIT_V(6); PG8_BAR;
    }
    for (;;) {
        const bool has_next = S.next(ui + 1, nxt);
        const char* nA = has_next ? g.a_ptr(nxt) : cA; const char* nB = has_next ? g.b_ptr(nxt) : cB;
        for (int t = 0; t < nt; t += 2) {
            const bool last = (t == nt - 2);
            const char* a1 = cA + (size_t)(t + 1) * kstep;
            const char* a2 = last ? nA : cA + (size_t)(t + 2) * kstep; const char* b2 = last ? nB : cB + (size_t)(t + 2) * kstep;
            const char* a3 = a2 + kstep; const char* b3 = b2 + kstep;
            if constexpr (SP2) {
            PG8_LDB(B0, 0, 0); PG8_LDB(B1, 0, 1); PG8_SCHED; PG8_LDA(At, 0, 0); PG8_STAGE(PG8_SA(1, 1), a1 + hstepA, voffA);
            PG8_WAIT_V(8); PG8_WAIT_L(0); PG8_BAR; PG8_MMA(0, 0, At, B0); PG8_MMA(0, 1, At, B1); PG8_BAR; PG8_SCHED;
            PG8_LDA(At, 0, 1); PG8_STAGE(PG8_SB(0, 0), b2, voffB); PG8_STAGE(PG8_SB(0, 1), b2 + hstepB, voffB); PG8_STAGE(PG8_SA(0, 0), a2, voffA);
            PG8_WAIT_V(8); PG8_WAIT_L(0); PG8_BAR; PG8_MMA(1, 0, At, B0); PG8_MMA(1, 1, At, B1); PG8_BAR; PG8_SCHED;
            PG8_LDB(B0, 1, 0); PG8_LDB(B1, 1, 1); PG8_SCHED; PG8_LDA(At, 1, 0); PG8_STAGE(PG8_SA(0, 1), a2 + hstepA, voffA);
            PG8_WAIT_V(8); PG8_WAIT_L(0); PG8_BAR; PG8_MMA(0, 0, At, B0); PG8_MMA(0, 1, At, B1); PG8_BAR; PG8_SCHED;
            PG8_LDA(At, 1, 1); PG8_STAGE(PG8_SB(1, 0), b3, voffB); PG8_STAGE(PG8_SB(1, 1), b3 + hstepB, voffB); PG8_STAGE(PG8_SA(1, 0), a3, voffA);
            PG8_WAIT_V(8); PG8_WAIT_L(0); PG8_BAR; PG8_MMA(1, 0, At, B0); PG8_MMA(1, 1, At, B1); PG8_BAR; PG8_SCHED;
            } else {
            PG8_LDB(B0, 0, 0); PG8_SCHED; PG8_LDA(At, 0, 0); PG8_STAGE(PG8_SA(1, 1), a1 + hstepA, voffA);
            PG8_WAIT_L(8); PG8_BAR; PG8_WAIT_L(0); PG8_MMA(0, 0, At, B0); PG8_BAR; PG8_SCHED;
            PG8_LDB(B1, 0, 1); PG8_STAGE(PG8_SB(0, 0), b2, voffB);
            PG8_BAR; PG8_WAIT_L(0); PG8_MMA(0, 1, At, B1); PG8_BAR;
            PG8_LDA(At, 0, 1); PG8_STAGE(PG8_SA(0, 0), a2, voffA);
            PG8_BAR; PG8_WAIT_L(0); PG8_MMA(1, 0, At, B0); PG8_BAR; PG8_SCHED;
            PG8_STAGE(PG8_SB(0, 1), b2 + hstepB, voffB);
            PG8_WAIT_V(6); PG8_BAR; PG8_MMA(1, 1, At, B1); PG8_BAR;
            PG8_LDB(B0, 1, 0); PG8_SCHED; PG8_LDA(At, 1, 0); PG8_STAGE(PG8_SA(0, 1), a2 + hstepA, voffA);
            PG8_WAIT_L(8); PG8_BAR; PG8_WAIT_L(0); PG8_MMA(0, 0, At, B0); PG8_BAR; PG8_SCHED;
            PG8_LDB(B1, 1, 1); PG8_STAGE(PG8_SB(1, 0), b3, voffB);
            PG8_BAR; PG8_WAIT_L(0); PG8_MMA(0, 1, At, B1); PG8_BAR;
            PG8_LDA(At, 1, 1); PG8_STAGE(PG8_SA(1, 0), a3, voffA);
            PG8_BAR; PG8_WAIT_L(0); PG8_MMA(1, 0, At, B0); PG8_BAR; PG8_SCHED;
            PG8_STAGE(PG8_SB(1, 1), b3 + hstepB, voffB);
            PG8_WAIT_V(6); PG8_BAR; PG8_MMA(1, 1, At, B1); PG8_BAR;
            }
        }
        if constexpr (ALIGN_EPI) { if (wr == 0) PG8_BAR; }
        if constexpr (FP8) asm volatile("s_nop 15\n\ts_nop 15" ::: "memory");
        E(acc, cur, wr, wc, fr, fq);
        if (!has_next) break;
#pragma unroll
        for (int a = 0; a < 2; ++a)
#pragma unroll
            for (int b = 0; b < 2; ++b)
#pragma unroll
                for (int m = 0; m < 4; ++m)
#pragma unroll
                    for (int n = 0; n < 2; ++n) acc[a][b][m][n] = (f32x4){0.f, 0.f, 0.f, 0.f};
        cur = nxt; cA = nA; cB = nB; ++ui;
        if constexpr (ALIGN_EPI) { if (wr == 1) PG8_BAR; }
    }
    PG8_WAIT_V(0);
    if constexpr (!ALIGN_EPI) { if (wr == 0) PG8_BAR; }
    PG8_BAR;
#undef PG8_SA
#undef PG8_SB
#undef PG8_STAGE
#undef PG8_LDA
#undef PG8_LDB
#undef PG8_MMA
#undef PG8_WAIT_V
#undef PG8_WAIT_L
#undef PG8_BAR
#undef PG8_SCHED
}
}

namespace attn {
using bf16 = __hip_bfloat16;
constexpr int D = 128, NW = 8, QBLK = 32, KVBLK = 64;
constexpr float SCALE = 0.088388347648318440f;
constexpr float THR = 8.f;
constexpr int SDEPTH = 2;
constexpr int LDQ = NH * HD, LDK = NKV * HD, LDO = LDQ;
constexpr size_t SHM_V = KVBLK * D * 2, SHM_K = KVBLK * D * 2, SHM_ATTN = 2 * SHM_V + 2 * SHM_K + NW * 64 * 4;
using f32x8  = __attribute__((ext_vector_type(8))) float;
#define KSWZ(row, colB) ((row) * 256 + ((colB) ^ (((row) & 7) << 4)))
#define SBAR() __builtin_amdgcn_sched_barrier(0)
__device__ __forceinline__ int crow(int r, int hi) { return (r & 3) + 8 * (r >> 2) + 4 * hi; }
__device__ __forceinline__ unsigned cvtpk(float lo, float hi) {
  unsigned r; asm volatile("v_cvt_pk_bf16_f32 %0, %1, %2" : "=v"(r) : "v"(lo), "v"(hi)); return r;
}
template <typename TIn> struct Stage;
template <> struct Stage<bf16>  { using T = bf16x8;
  __device__ static __forceinline__ T ld8(const bf16* p) { return *reinterpret_cast<const bf16x8*>(p); }
  __device__ static __forceinline__ bf16x8 tobf(T x) { return x; } };
template <> struct Stage<float> { using T = f32x8;
  __device__ static __forceinline__ T ld8(const float* p) { return *reinterpret_cast<const f32x8*>(p); }
  __device__ static __forceinline__ bf16x8 tobf(T x) {
    u32x4 w = {cvtpk(x[0], x[1]), cvtpk(x[2], x[3]), cvtpk(x[4], x[5]), cvtpk(x[6], x[7])}; return *reinterpret_cast<bf16x8*>(&w); } };

__device__ __forceinline__ void partialSM(f32x16& p0, f32x16& p1, float& m_reg, float& mn, float& alpha) {
  constexpr float C = SCALE * 1.4426950408889634f;
  float pmax = p0[0]; for (int r = 1; r < 16; ++r) pmax = fmaxf(pmax, p0[r]); for (int r = 0; r < 16; ++r) pmax = fmaxf(pmax, p1[r]);
  { auto rr = __builtin_amdgcn_permlane32_swap(__float_as_uint(pmax), __float_as_uint(pmax), false, false);
    pmax = fmaxf(__uint_as_float(rr[0]), __uint_as_float(rr[1])); }
  if (__builtin_expect(__all(pmax - m_reg <= THR / SCALE), 1)) { mn = m_reg; alpha = 1.f; }
  else { mn = fmaxf(m_reg, pmax); alpha = __builtin_amdgcn_exp2f((m_reg - mn) * C); m_reg = mn; }
  float mnC = -mn * C;
  for (int r = 0; r < 16; ++r) p0[r] = fmaf(p0[r], C, mnC); for (int r = 0; r < 16; ++r) p1[r] = fmaf(p1[r], C, mnC);
  for (int r = 0; r < 16; ++r) p0[r] = __builtin_amdgcn_exp2f(p0[r]);
}
__device__ __forceinline__ void finishSM(f32x16& p0, f32x16& p1, float alpha, float& l_reg, bf16x8& pa0, bf16x8& pa1, bf16x8& pa2, bf16x8& pa3) {
  for (int r = 0; r < 16; ++r) p1[r] = __builtin_amdgcn_exp2f(p1[r]);
  float ps = 0; for (int r = 0; r < 16; ++r) ps += p0[r]; for (int r = 0; r < 16; ++r) ps += p1[r];
  { auto rr = __builtin_amdgcn_permlane32_swap(__float_as_uint(ps), __float_as_uint(ps), false, false);
    ps = __uint_as_float(rr[0]) + __uint_as_float(rr[1]); }
  l_reg = l_reg * alpha + ps;
#define PK4(P, BASE, OUT) do { unsigned a0 = cvtpk(P[BASE + 0], P[BASE + 1]), a1 = cvtpk(P[BASE + 2], P[BASE + 3]);   \
    unsigned b0 = cvtpk(P[BASE + 4], P[BASE + 5]), b1 = cvtpk(P[BASE + 6], P[BASE + 7]);                              \
    auto r0 = __builtin_amdgcn_permlane32_swap(a0, b0, false, false); auto r1 = __builtin_amdgcn_permlane32_swap(a1, b1, false, false); \
    u32x4 w = {r0[0], r1[0], r0[1], r1[1]}; OUT = *reinterpret_cast<bf16x8*>(&w); } while (0)
  PK4(p0, 0, pa0); PK4(p0, 8, pa1); PK4(p1, 0, pa2); PK4(p1, 8, pa3);
#undef PK4
}
__device__ __forceinline__ void qkt(f32x16& p0, f32x16& p1, const bf16* Ks, const bf16x8* qr, int r32, int hi) {
  p0 = f32x16{}; p1 = f32x16{};
  for (int d0 = 0; d0 < 8; ++d0) { int cb = (d0 * 16 + hi * 8) * 2;
    bf16x8 b0 = *reinterpret_cast<const bf16x8*>((const char*)Ks + KSWZ(r32, cb));
    bf16x8 b1 = *reinterpret_cast<const bf16x8*>((const char*)Ks + KSWZ(32 + r32, cb));
    p0 = __builtin_amdgcn_mfma_f32_32x32x16_bf16(b0, qr[d0], p0, 0, 0, 0);
    p1 = __builtin_amdgcn_mfma_f32_32x32x16_bf16(b1, qr[d0], p1, 0, 0, 0); }
}
__device__ __forceinline__ int v_st(int k, int c) { const int kk = (k & ~0xC) | ((k & 4) << 1) | ((k & 8) >> 1); return ((kk >> 3) * 4 + (c >> 5)) * 512 + ((kk & 7) * 32 + (c & 31)) * 2; }
__device__ __forceinline__ int v_rd_base(int lane) { return ((lane & 3) << 3) | (((lane >> 2) & 3) << 6) | (((lane >> 4) & 1) << 5) | (((lane >> 5) & 1) << 8); }
constexpr int v_rd_off(int d0, int ks, int half) { return d0 * 512 + ks * 4096 + half * 2048; }
template <int OFF> __device__ __forceinline__ s16x4 tr_read(int vb) {
  s16x4 r; asm volatile("ds_read_b64_tr_b16 %0, %1 offset:%2" : "=&v"(r) : "v"(vb), "i"(OFF) : "memory"); return r;
}
template <int D0> __device__ __forceinline__ void pv_one(f32x16& od, int vb, bf16x8 pa0, bf16x8 pa1, bf16x8 pa2, bf16x8 pa3) {
  const s16x4 l0 = tr_read<v_rd_off(D0, 0, 0)>(vb), h0 = tr_read<v_rd_off(D0, 0, 1)>(vb), l1 = tr_read<v_rd_off(D0, 1, 0)>(vb), h1 = tr_read<v_rd_off(D0, 1, 1)>(vb);
  const s16x4 l2 = tr_read<v_rd_off(D0, 2, 0)>(vb), h2 = tr_read<v_rd_off(D0, 2, 1)>(vb), l3 = tr_read<v_rd_off(D0, 3, 0)>(vb), h3 = tr_read<v_rd_off(D0, 3, 1)>(vb);
  asm volatile("s_waitcnt lgkmcnt(0)" ::: "memory"); SBAR();
#define PK(L, H) (bf16x8){L[0], L[1], L[2], L[3], H[0], H[1], H[2], H[3]}
  od = __builtin_amdgcn_mfma_f32_32x32x16_bf16(pa0, PK(l0, h0), od, 0, 0, 0);
  od = __builtin_amdgcn_mfma_f32_32x32x16_bf16(pa1, PK(l1, h1), od, 0, 0, 0);
  od = __builtin_amdgcn_mfma_f32_32x32x16_bf16(pa2, PK(l2, h2), od, 0, 0, 0);
  od = __builtin_amdgcn_mfma_f32_32x32x16_bf16(pa3, PK(l3, h3), od, 0, 0, 0);
#undef PK
}
__device__ __forceinline__ void pv_d0(f32x16* o, int vb, bf16x8 pa0, bf16x8 pa1, bf16x8 pa2, bf16x8 pa3) {
  pv_one<0>(o[0], vb, pa0, pa1, pa2, pa3); pv_one<1>(o[1], vb, pa0, pa1, pa2, pa3); pv_one<2>(o[2], vb, pa0, pa1, pa2, pa3); pv_one<3>(o[3], vb, pa0, pa1, pa2, pa3);
}

template <typename TQ>
__device__ __forceinline__ void attn_dense_body(const TQ* __restrict__ Qb, const bf16* __restrict__ Kh, const bf16* __restrict__ Vh,
                                                float* __restrict__ Ob, int seq, char* lds) {
  using St = Stage<bf16>; using SQ = Stage<TQ>;
  const int tid = threadIdx.x, wid = tid >> 6, lane = tid & 63, r32 = lane & 31, hi = lane >> 5;
  bf16* V_lds = (bf16*)lds; bf16* K_lds = (bf16*)(lds + 2 * SHM_V);
  float* ws = (float*)(lds + 2 * SHM_V + 2 * SHM_K) + wid * 64; float* li_l = ws; float* al_l = ws + 32;
  float m_reg = -1e30f, l_reg = 0; f32x16 o[4] = {}; bf16x8 qr[8];
  const TQ* Qw = Qb + (long)(wid * QBLK + r32) * LDQ + hi * 8;
#pragma unroll
  for (int d0 = 0; d0 < 8; ++d0) qr[d0] = SQ::tobf(SQ::ld8(Qw + d0 * 16));
  const int sr = tid >> 4, sc = (tid & 15) * 8, vst0 = v_st(sr, sc), vst1 = v_st(32 + sr, sc);
  const int vb0 = (int)(uintptr_t)V_lds + v_rd_base(lane);
  struct { typename St::T vs0, vs1, ks0, ks1; } sr_[SDEPTH];
#define SLOAD(i, k0) do { sr_[i].vs0 = St::ld8(&Vh[(long)((k0) + sr) * LDK + sc]); sr_[i].vs1 = St::ld8(&Vh[(long)((k0) + 32 + sr) * LDK + sc]); \
    sr_[i].ks0 = St::ld8(&Kh[(long)((k0) + sr) * LDK + sc]); sr_[i].ks1 = St::ld8(&Kh[(long)((k0) + 32 + sr) * LDK + sc]); } while (0)
#define SWRITE(b, i) do { *(bf16x8*)((char*)V_lds + (b) * SHM_V + vst0) = St::tobf(sr_[i].vs0);          \
    *(bf16x8*)((char*)V_lds + (b) * SHM_V + vst1) = St::tobf(sr_[i].vs1); int kc = sc * 2;               \
    *(bf16x8*)((char*)K_lds + (b) * SHM_K + KSWZ(sr, kc)) = St::tobf(sr_[i].ks0);                       \
    *(bf16x8*)((char*)K_lds + (b) * SHM_K + KSWZ(32 + sr, kc)) = St::tobf(sr_[i].ks1); } while (0)
#define SWAIT() do { if constexpr (SDEPTH == 2) asm volatile("s_waitcnt vmcnt(4)" ::: "memory"); else asm volatile("s_waitcnt vmcnt(0)" ::: "memory"); } while (0)
#define RESC(a) do { if (__any((a) < 1.f)) { if (hi == 0) al_l[r32] = (a); asm volatile("s_waitcnt lgkmcnt(0)" ::: "memory"); \
    for (int d = 0; d < 4; ++d) for (int r = 0; r < 16; ++r) o[d][r] *= al_l[crow(r, hi)]; } } while (0)
  f32x16 pA0, pA1, pB0, pB1; float mnA, mnB, alA, alB; bf16x8 pa0, pa1, pa2, pa3; const int NT = seq / KVBLK;
  constexpr int SE = 0, SO = SDEPTH - 1;
  SLOAD(SE, 0); asm volatile("s_waitcnt vmcnt(0)" ::: "memory"); SWRITE(0, SE); __syncthreads();
  qkt(pA0, pA1, K_lds, qr, r32, hi); partialSM(pA0, pA1, m_reg, mnA, alA);
  SLOAD(SO, KVBLK); if constexpr (SDEPTH == 2) { if (2 < NT) SLOAD(SE, 2 * KVBLK); }
  SWAIT(); SWRITE(1, SO); __syncthreads();
  for (int j = 1; j + 1 < NT; j += 2) {
    SBAR(); qkt(pB0, pB1, (bf16*)((char*)K_lds + SHM_K), qr, r32, hi);
    finishSM(pA0, pA1, alA, l_reg, pa0, pa1, pa2, pa3); SBAR();
    SLOAD(SO, (j + SDEPTH) * KVBLK); SBAR();
    pv_d0(o, vb0, pa0, pa1, pa2, pa3); partialSM(pB0, pB1, m_reg, mnB, alB);
    __syncthreads(); SWAIT(); SWRITE(0, SE);
    RESC(alB); __syncthreads();
    SBAR(); qkt(pA0, pA1, K_lds, qr, r32, hi);
    finishSM(pB0, pB1, alB, l_reg, pa0, pa1, pa2, pa3); SBAR();
    if (SDEPTH == 1 || j + 3 < NT) SLOAD(SE, (j + 1 + SDEPTH) * KVBLK); SBAR();
    pv_d0(o, vb0 + (int)SHM_V, pa0, pa1, pa2, pa3); partialSM(pA0, pA1, m_reg, mnA, alA);
    __syncthreads(); SWAIT(); SWRITE(1, SO);
    RESC(alA); __syncthreads();
  }
  SBAR(); qkt(pB0, pB1, (bf16*)((char*)K_lds + SHM_K), qr, r32, hi);
  finishSM(pA0, pA1, alA, l_reg, pa0, pa1, pa2, pa3); SBAR();
  pv_d0(o, vb0, pa0, pa1, pa2, pa3); partialSM(pB0, pB1, m_reg, mnB, alB);
  __syncthreads(); RESC(alB);
  finishSM(pB0, pB1, alB, l_reg, pa0, pa1, pa2, pa3); SBAR();
  pv_d0(o, vb0 + (int)SHM_V, pa0, pa1, pa2, pa3);
  if (hi == 0) li_l[r32] = l_reg; asm volatile("s_waitcnt lgkmcnt(0)" ::: "memory");
  float rli[16];
#pragma unroll
  for (int r = 0; r < 16; ++r) rli[r] = __builtin_amdgcn_rcpf(li_l[crow(r, hi)]);
  unsigned char* Ow = (unsigned char*)Ob + (long)(wid * QBLK) * LDO;
#pragma unroll
  for (int r = 0; r < 16; ++r) { int orow = crow(r, hi);
    for (int d0 = 0; d0 < 4; ++d0) { const float ov_ = __builtin_amdgcn_fmed3f(o[d0][r] * rli[r] * 8.f, -448.f, 448.f); Ow[(long)orow * LDO + d0 * 32 + r32] = (unsigned char)(__builtin_amdgcn_cvt_pk_fp8_f32(ov_, ov_, 0, false) & 0xff); } }
  __syncthreads();
#undef SLOAD
#undef SWRITE
#undef SWAIT
#undef RESC
}

}

namespace attn8 {
using attn::crow;
using f32x16 = __attribute__((ext_vector_type(16))) float;
using i32x8 = __attribute__((ext_vector_type(8))) int;
using i32x4 = __attribute__((ext_vector_type(4))) int;
#define A8_LAS __attribute__((address_space(3)))
constexpr float SCALE = 0.088388347648318440f, QMUL = SCALE * 1.4426950408889634f, THR2 = 4.32f, PSH = 4.f;
constexpr int TILE = 8192, KRING = 0, VRING = 3 * TILE, WSP = 6 * TILE;
constexpr long TSTRIDE = 8 * TILE;
#define A8_SBAR() __builtin_amdgcn_sched_barrier(0)
#ifndef ATT_PROBE
#define ATT_PROBE 0
#endif
template <int VAR = 0>
__device__ __forceinline__ f32x16 mfma8(const i32x8 a, const i32x8 b, const f32x16 c) {
  if constexpr ((VAR & 1) != 0) { f32x16 r = c; r[0] += __int_as_float(a[0] ^ b[0]); return r; }
  else return __builtin_amdgcn_mfma_scale_f32_32x32x64_f8f6f4(a, b, c, 0, 0, 0, 0x7F7F7F7F, 0, 0x7F7F7F7F);
}
template <int VAR = 0> __device__ __forceinline__ float ex2(float x) { if constexpr ((VAR & 2) != 0) return x; else return __builtin_amdgcn_exp2f(x); }
template <int VAR = 0>
__device__ __forceinline__ i32x8 frag(const A8_LAS char* lds, int a0) {
  if constexpr ((VAR & 4) != 0) { return (i32x8){a0, a0, a0, a0, a0, a0, a0, a0}; }
  const i32x4 x = *(const A8_LAS i32x4*)(lds + a0), y = *(const A8_LAS i32x4*)(lds + (a0 ^ 16));
  return (i32x8){x[0], x[1], x[2], x[3], y[0], y[1], y[2], y[3]};
}
template <int VAR = 0>
__device__ __forceinline__ void partialSM(f32x16& p0, f32x16& p1, f32x16& negm, float& alpha, i32x8& pw, const bool first) {
  float pmax = p0[0]; for (int r = 1; r < 16; ++r) pmax = fmaxf(pmax, p0[r]); for (int r = 0; r < 16; ++r) pmax = fmaxf(pmax, p1[r]);
  { auto rr = __builtin_amdgcn_permlane32_swap(__float_as_uint(pmax), __float_as_uint(pmax), false, false);
    pmax = fmaxf(__uint_as_float(rr[0]), __uint_as_float(rr[1])); }
  if (__builtin_expect(!first && __all(pmax <= PSH + THR2), 1)) { alpha = 1.f; }
  else { const float delta = first ? pmax - PSH : fmaxf(pmax - PSH, 0.f); alpha = __builtin_amdgcn_exp2f(-delta);
    for (int r = 0; r < 16; ++r) { p0[r] -= delta; p1[r] -= delta; }
    const float nm = negm[0] - delta; for (int r = 0; r < 16; ++r) negm[r] = nm; }
  for (int r = 0; r < 16; ++r) p0[r] = ex2<VAR>(p0[r]);
#pragma unroll
  for (int i = 0; i < 4; ++i) { int w = __float_as_int(p0[4 * i]); w = __builtin_amdgcn_cvt_pk_fp8_f32(p0[4 * i], p0[4 * i + 1], w, false); w = __builtin_amdgcn_cvt_pk_fp8_f32(p0[4 * i + 2], p0[4 * i + 3], w, true); pw[i] = w; }
}
template <int VAR = 0>
__device__ __forceinline__ void finishSM(f32x16& p1, i32x8& pw) {
  for (int r = 0; r < 16; ++r) p1[r] = ex2<VAR>(p1[r]);
#pragma unroll
  for (int i = 0; i < 4; ++i) { int w = __float_as_int(p1[4 * i]); w = __builtin_amdgcn_cvt_pk_fp8_f32(p1[4 * i], p1[4 * i + 1], w, false); w = __builtin_amdgcn_cvt_pk_fp8_f32(p1[4 * i + 2], p1[4 * i + 3], w, true); pw[4 + i] = w; }
}
template <int VAR = 0>
__device__ __forceinline__ void body(const unsigned char* __restrict__ Qb, const unsigned char* __restrict__ Kt, const unsigned char* __restrict__ Vt,
                                     unsigned char* __restrict__ Ob, int seq, A8_LAS char* lds, const int wave) {
  const int tid = opaque_tid(wave), wid = wave, lane = tid & 63, r32 = lane & 31, hi = lane >> 5;
  A8_LAS float* al_l = (A8_LAS float*)(lds + WSP) + wid * 64;
  f32x16 o[4], lacc, negm;
  { float z = 0.f, ps = PSH; asm volatile("" : "+v"(z), "+v"(ps));
#pragma unroll
    for (int r = 0; r < 16; ++r) { negm[r] = ps; lacc[r] = z; o[0][r] = z; o[1][r] = z; o[2][r] = z; o[3][r] = z; } }
  const int NT = seq / 64;
  const int ko0 = r32 * 128 + (((2 * hi) ^ ((r32 >> 1) & 7)) << 4), ko1 = r32 * 128 + (((4 + 2 * hi) ^ ((r32 >> 1) & 7)) << 4);
  const int vo = r32 * 64 + (((2 * hi) ^ ((r32 >> 2) & 3)) << 4);
  const unsigned voff = wid * 1024 + lane * 16;
#define A8_DMA(gp, ring, slot) __builtin_amdgcn_global_load_lds((const unsigned*)((gp) + voff), (A8_LAS unsigned*)(lds + (ring) + (slot) * TILE + wid * 1024), 16, 0, 0)
#define A8_TILE(j) ((long)((j) < NT ? (j) : NT - 1) * TSTRIDE)
#define A8_BAR(n) do { asm volatile("s_waitcnt vmcnt(" #n ") lgkmcnt(0)" ::: "memory"); __builtin_amdgcn_s_barrier(); asm volatile("" ::: "memory"); A8_SBAR(); } while (0)
  i32x8 q0, q1;
  { const unsigned char* qp = Qb + (long)(wid * 32 + r32) * 4096 + hi * 32;
    const i32x4 a = *(const i32x4*)qp, b = *(const i32x4*)(qp + 16), c = *(const i32x4*)(qp + 64), d = *(const i32x4*)(qp + 80);
    q0 = (i32x8){a[0], a[1], a[2], a[3], b[0], b[1], b[2], b[3]}; q1 = (i32x8){c[0], c[1], c[2], c[3], d[0], d[1], d[2], d[3]}; }
  asm volatile("" : "+v"(q0), "+v"(q1));
  A8_DMA(Kt, KRING, 0); A8_DMA(Vt, VRING, 0); A8_DMA(Kt + A8_TILE(1), KRING, 1); A8_DMA(Vt + A8_TILE(1), VRING, 1);
  A8_BAR(3);
  const bool late = wid >= 4;
  if (late) A8_BAR(1);
  int sl = 0, sf = 2;
  i32x8 kf0 = frag<VAR>(lds + KRING, ko0), kf1 = frag<VAR>(lds + KRING + 4096, ko0), kf2 = frag<VAR>(lds + KRING, ko1), kf3 = frag<VAR>(lds + KRING + 4096, ko1);
  for (int j = 0; j < NT; ++j) {
    f32x16 p0, p1; i32x8 pw; float al;
    if constexpr ((VAR & 8) == 0) A8_DMA(Kt + A8_TILE(j + 2), KRING, sf);
    __builtin_amdgcn_s_setprio(2);
    p0 = mfma8<VAR>(kf0, q0, negm); p1 = mfma8<VAR>(kf1, q0, negm); p0 = mfma8<VAR>(kf2, q1, p0); p1 = mfma8<VAR>(kf3, q1, p1);
    __builtin_amdgcn_s_setprio(0);
    if constexpr ((VAR & 16) != 0) { al = 1.f; for (int i = 0; i < 4; ++i) { pw[i] = __float_as_int(p0[i]); pw[4 + i] = __float_as_int(p1[i]); } }
    else partialSM<VAR>(p0, p1, negm, al, pw, j == 0);
    if (__any(al < 1.f)) { if (hi == 0) al_l[r32] = al; asm volatile("s_waitcnt lgkmcnt(0)" ::: "memory");
      for (int r = 0; r < 16; ++r) { const float a_ = al_l[crow(r, hi)]; lacc[r] *= a_; for (int d = 0; d < 4; ++d) o[d][r] *= a_; } }
    A8_BAR(2);
    if constexpr ((VAR & 8) == 0) A8_DMA(Vt + A8_TILE(j + 2), VRING, sf);
    { const A8_LAS char* Vs = lds + VRING + sl * TILE;
      const i32x8 b0 = frag<VAR>(Vs, vo), b1 = frag<VAR>(Vs + 2048, vo), b2 = frag<VAR>(Vs + 4096, vo), b3 = frag<VAR>(Vs + 6144, vo);
      A8_SBAR();
      if constexpr ((VAR & 16) == 0) finishSM<VAR>(p1, pw);
      int one = 0x38383838; asm volatile("" : "+v"(one));
      A8_SBAR();
      __builtin_amdgcn_s_setprio(2);
      o[0] = mfma8<VAR>(pw, b0, o[0]); o[1] = mfma8<VAR>(pw, b1, o[1]); o[2] = mfma8<VAR>(pw, b2, o[2]); o[3] = mfma8<VAR>(pw, b3, o[3]);
      lacc = mfma8<VAR>(pw, (i32x8){one, one, one, one, one, one, one, one}, lacc);
      __builtin_amdgcn_s_setprio(0); }
    A8_SBAR();
    sf = sl; sl = sl == 2 ? 0 : sl + 1;
    { const A8_LAS char* Ks = lds + KRING + sl * TILE;
      kf0 = frag<VAR>(Ks, ko0); kf1 = frag<VAR>(Ks + 4096, ko0); kf2 = frag<VAR>(Ks, ko1); kf3 = frag<VAR>(Ks + 4096, ko1); }
    A8_BAR(1);
  }
  if (!late) A8_BAR(2);
  float rli[16];
#pragma unroll
  for (int r = 0; r < 16; ++r) rli[r] = __builtin_amdgcn_rcpf(lacc[r]);
  unsigned char* Ow = Ob + (long)(wid * 32) * 4096;
#pragma unroll
  for (int r = 0; r < 16; ++r) { int orow = crow(r, hi);
    for (int d0 = 0; d0 < 4; ++d0) { const float ov_ = __builtin_amdgcn_fmed3f(o[d0][r] * rli[r] * 8.f, -448.f, 448.f); Ow[(long)orow * 4096 + d0 * 32 + r32] = (unsigned char)(__builtin_amdgcn_cvt_pk_fp8_f32(ov_, ov_, 0, false) & 0xff); } }
  asm volatile("s_waitcnt vmcnt(0)" ::: "memory");
  A8_BAR(0);
#undef A8_DMA
#undef A8_TILE
#undef A8_BAR
}

__device__ __forceinline__ void pack16(const f32x16& p, int* w) {
#pragma unroll
  for (int i = 0; i < 4; ++i) { int x = __float_as_int(p[4 * i]); x = __builtin_amdgcn_cvt_pk_fp8_f32(p[4 * i], p[4 * i + 1], x, false); x = __builtin_amdgcn_cvt_pk_fp8_f32(p[4 * i + 2], p[4 * i + 3], x, true); w[i] = x; }
}
__device__ __forceinline__ void body128(const unsigned char* __restrict__ Qb, const unsigned char* __restrict__ Kt, const unsigned char* __restrict__ Vt,
                                        unsigned char* __restrict__ Ob, int seq, A8_LAS char* lds, const int wave) {
  const int tid = opaque_tid(wave), wid = wave, lane = tid & 63, r32 = lane & 31, hi = lane >> 5;
  constexpr int SLOT = 2 * TILE, KR = 0, VR = 3 * SLOT, WS2 = 6 * SLOT;
  A8_LAS float* al_l = (A8_LAS float*)(lds + WS2) + wid * 64;
  f32x16 o[4], lacc, negm;
  { float z = 0.f, ps = PSH; asm volatile("" : "+v"(z), "+v"(ps));
#pragma unroll
    for (int r = 0; r < 16; ++r) { negm[r] = ps; lacc[r] = z; o[0][r] = z; o[1][r] = z; o[2][r] = z; o[3][r] = z; } }
  const int NS = seq / 128;
  const int ko0 = r32 * 128 + (((2 * hi) ^ ((r32 >> 1) & 7)) << 4), ko1 = r32 * 128 + (((4 + 2 * hi) ^ ((r32 >> 1) & 7)) << 4);
  const int vo = r32 * 64 + (((2 * hi) ^ ((r32 >> 2) & 3)) << 4);
  const unsigned voff = wid * 1024 + lane * 16;
#define B_DMA(gp, ring, slot, sub) __builtin_amdgcn_global_load_lds((const unsigned*)((gp) + voff), (A8_LAS unsigned*)(lds + (ring) + (slot) * SLOT + (sub) * TILE + wid * 1024), 16, 0, 0)
#define B_STEP(j) ((long)((j) < NS ? (j) : NS - 1) * 2 * TSTRIDE)
#define B_DMA2(base, ring, slot, j) do { B_DMA((base) + B_STEP(j), ring, slot, 0); B_DMA((base) + B_STEP(j) + TSTRIDE, ring, slot, 1); } while (0)
#define B_BAR(n) do { asm volatile("s_waitcnt vmcnt(" #n ") lgkmcnt(0)" ::: "memory"); __builtin_amdgcn_s_barrier(); asm volatile("" ::: "memory"); A8_SBAR(); } while (0)
  i32x8 q0, q1;
  { const unsigned char* qp = Qb + (long)(wid * 32 + r32) * 4096 + hi * 32;
    const i32x4 a = *(const i32x4*)qp, b = *(const i32x4*)(qp + 16), c = *(const i32x4*)(qp + 64), d = *(const i32x4*)(qp + 80);
    q0 = (i32x8){a[0], a[1], a[2], a[3], b[0], b[1], b[2], b[3]}; q1 = (i32x8){c[0], c[1], c[2], c[3], d[0], d[1], d[2], d[3]}; }
  asm volatile("" : "+v"(q0), "+v"(q1));
  B_DMA2(Kt, KR, 0, 0); B_DMA2(Vt, VR, 0, 0); B_DMA2(Kt, KR, 1, 1); B_DMA2(Vt, VR, 1, 1);
  B_BAR(6);
  const bool late = wid >= 4;
  if (late) { __builtin_amdgcn_s_setprio(1); B_BAR(4); }
  int sl = 0, sf = 2;
  for (int j = 0; j < NS; ++j) {
    f32x16 p0, p1, p2, p3; int pw[16]; float al;
    B_DMA2(Kt, KR, sf, j + 2);
    { const A8_LAS char* Ks = lds + KR + sl * SLOT;
      { const i32x8 a0 = frag<0>(Ks, ko0), a1 = frag<0>(Ks + 4096, ko0), a2 = frag<0>(Ks, ko1), a3 = frag<0>(Ks + 4096, ko1);
        p0 = mfma8<0>(a0, q0, negm); p1 = mfma8<0>(a1, q0, negm); p0 = mfma8<0>(a2, q1, p0); p1 = mfma8<0>(a3, q1, p1); }
      { const i32x8 a0 = frag<0>(Ks + TILE, ko0), a1 = frag<0>(Ks + TILE + 4096, ko0), a2 = frag<0>(Ks + TILE, ko1), a3 = frag<0>(Ks + TILE + 4096, ko1);
        p2 = mfma8<0>(a0, q0, negm); p3 = mfma8<0>(a1, q0, negm); p2 = mfma8<0>(a2, q1, p2); p3 = mfma8<0>(a3, q1, p3);
        } }
    { float pmax = p0[0];
      for (int r = 1; r < 16; ++r) pmax = fmaxf(pmax, p0[r]);
      for (int r = 0; r < 16; ++r) pmax = fmaxf(pmax, p1[r]);
      for (int r = 0; r < 16; ++r) pmax = fmaxf(pmax, p2[r]);
      for (int r = 0; r < 16; ++r) pmax = fmaxf(pmax, p3[r]);
      { auto rr = __builtin_amdgcn_permlane32_swap(__float_as_uint(pmax), __float_as_uint(pmax), false, false);
        pmax = fmaxf(__uint_as_float(rr[0]), __uint_as_float(rr[1])); }
      const bool first = j == 0;
      if (__builtin_expect(!first && __all(pmax <= PSH + THR2), 1)) { al = 1.f; }
      else { const float delta = first ? pmax - PSH : fmaxf(pmax - PSH, 0.f); al = __builtin_amdgcn_exp2f(-delta);
        for (int r = 0; r < 16; ++r) { p0[r] -= delta; p1[r] -= delta; p2[r] -= delta; p3[r] -= delta; }
        const float nm = negm[0] - delta; for (int r = 0; r < 16; ++r) negm[r] = nm; }
      for (int r = 0; r < 16; ++r) { p0[r] = __builtin_amdgcn_exp2f(p0[r]); p1[r] = __builtin_amdgcn_exp2f(p1[r]); }
      pack16(p0, pw); pack16(p1, pw + 4); }
    if (__any(al < 1.f)) { if (hi == 0) al_l[r32] = al; asm volatile("s_waitcnt lgkmcnt(0)" ::: "memory");
      for (int r = 0; r < 16; ++r) { const float a_ = al_l[crow(r, hi)]; lacc[r] *= a_; for (int d = 0; d < 4; ++d) o[d][r] *= a_; } }
    B_BAR(4);
    B_DMA2(Vt, VR, sf, j + 2);
    { const A8_LAS char* Vs = lds + VR + sl * SLOT;
      int one = 0x38383838; asm volatile("" : "+v"(one));
      const i32x8 ones = (i32x8){one, one, one, one, one, one, one, one};
      { const i32x8 b0 = frag<0>(Vs, vo), b1 = frag<0>(Vs + 2048, vo), b2 = frag<0>(Vs + 4096, vo), b3 = frag<0>(Vs + 6144, vo);
        A8_SBAR();
        for (int r = 0; r < 16; ++r) { p2[r] = __builtin_amdgcn_exp2f(p2[r]); p3[r] = __builtin_amdgcn_exp2f(p3[r]); }
        pack16(p2, pw + 8); pack16(p3, pw + 12);
        A8_SBAR();
        const i32x8 pa = (i32x8){pw[0], pw[1], pw[2], pw[3], pw[4], pw[5], pw[6], pw[7]};
        o[0] = mfma8<0>(pa, b0, o[0]); o[1] = mfma8<0>(pa, b1, o[1]); o[2] = mfma8<0>(pa, b2, o[2]); o[3] = mfma8<0>(pa, b3, o[3]);
        lacc = mfma8<0>(pa, ones, lacc); }
      { const i32x8 b0 = frag<0>(Vs + TILE, vo), b1 = frag<0>(Vs + TILE + 2048, vo), b2 = frag<0>(Vs + TILE + 4096, vo), b3 = frag<0>(Vs + TILE + 6144, vo);
        const i32x8 pb = (i32x8){pw[8], pw[9], pw[10], pw[11], pw[12], pw[13], pw[14], pw[15]};
        o[0] = mfma8<0>(pb, b0, o[0]); o[1] = mfma8<0>(pb, b1, o[1]); o[2] = mfma8<0>(pb, b2, o[2]); o[3] = mfma8<0>(pb, b3, o[3]);
        lacc = mfma8<0>(pb, ones, lacc);
        } }
    B_BAR(4);
    sf = sl; sl = sl == 2 ? 0 : sl + 1;
  }
  if (!late) B_BAR(4); else __builtin_amdgcn_s_setprio(0);
  float rli[16];
#pragma unroll
  for (int r = 0; r < 16; ++r) rli[r] = __builtin_amdgcn_rcpf(lacc[r]);
  { A8_LAS unsigned char* st = (A8_LAS unsigned char*)(lds + WS2 + 2048 + wid * 4096 + (wid == 7 ? 4096 : 0));
#pragma unroll
    for (int r = 0; r < 16; ++r) { const int orow = crow(r, hi);
#pragma unroll
      for (int d0 = 0; d0 < 4; ++d0) { const float ov_ = __builtin_amdgcn_fmed3f(o[d0][r] * rli[r] * 8.f, -448.f, 448.f);
        st[orow * 128 + d0 * 32 + r32] = (unsigned char)(__builtin_amdgcn_cvt_pk_fp8_f32(ov_, ov_, 0, false) & 0xff); } }
    asm volatile("s_waitcnt lgkmcnt(0)" ::: "memory");
    unsigned char* Ow = Ob + (long)(wid * 32) * 4096;
#pragma unroll
    for (int i = 0; i < 4; ++i) { const int c = lane + 64 * i; const i32x4 v = *(const A8_LAS i32x4*)(st + c * 16);
      *(i32x4*)(Ow + (long)(c >> 3) * 4096 + (c & 7) * 16) = v; } }
  asm volatile("s_waitcnt vmcnt(0)" ::: "memory");
  B_BAR(0);
#undef B_DMA
#undef B_STEP
#undef B_DMA2
#undef B_BAR
}
}

constexpr size_t MiB = 1u << 20;
constexpr size_t WS_CTL = 0, CTL_ZERO_BYTES = 64 * 1024;
constexpr size_t WS_SCU = 1 * MiB, WS_SCV = WS_SCU + 64 * 1024;
constexpr size_t WS_CS = WS_SCU + 128 * 1024;
constexpr size_t WS_KEYS = WS_SCU + 384 * 1024;
constexpr size_t WS_SCIN = WS_SCU + 896 * 1024;
constexpr float ACT8 = 8.f;
constexpr size_t WS_MODF = 2 * MiB;
constexpr size_t WS_MODP = 3 * MiB;
constexpr size_t WS_WIN = 6 * MiB, WS_WATT = 134 * MiB, WS_WFOUR = 166 * MiB, WS_WOUT = 182 * MiB, WS_WPQ = 214 * MiB;
constexpr size_t WS_U8 = 230 * MiB, WS_V8 = 294 * MiB;
constexpr size_t WS_D128 = 358 * MiB, WS_DS64 = WS_D128 + 128 * 1024, WS_DS32 = WS_DS64 + 128 * 1024;
constexpr size_t WS_H = 359 * MiB;
constexpr size_t WS_Q = 551 * MiB;
constexpr size_t WS_K = 743 * MiB, WS_V = 791 * MiB;
constexpr size_t WS_F = 839 * MiB;
constexpr size_t WS_GA = 935 * MiB, WS_GF = 1127 * MiB;
constexpr size_t WS_IDX = 1319 * MiB, WS_GATE = 1331 * MiB;
constexpr size_t WS_L1 = 1343 * MiB;
constexpr size_t WS_END = 1535 * MiB + 4096;
#ifndef ATTN_FP8
#define ATTN_FP8 1
#endif
constexpr size_t WS_GA8 = WS_Q + 96 * MiB;
constexpr float GATE8 = 255.f;
constexpr size_t DO_Q8 = 0, DO_K8 = 96 * MiB, DO_V8 = 120 * MiB;
constexpr int CW_BAR = 4096;

constexpr int NWAVES = 8;
constexpr int LDS_BYTES = 147456;
constexpr int MISC_OFF = 131072 + 320;

#define XB_TMO      128
#define XB_XCNT(j)  (256  + 64 * (j))
#define XB_XSUB(j)  (1280 + 64 * (j))
#define XB_XGEN(j)  (2304 + 64 * (j))
#define XB_TOP      3328
#define XB_TOPGEN   3392
#define XCD_BAR_WORDS 3456
#define XB_SPIN_CAP (1u << 18)

__device__ __forceinline__ unsigned xb_ld(unsigned* p)              { return __hip_atomic_load(p, __ATOMIC_RELAXED, __HIP_MEMORY_SCOPE_AGENT); }
__device__ __forceinline__ unsigned xb_add(unsigned* p, unsigned v) { return __hip_atomic_fetch_add(p, v, __ATOMIC_RELAXED, __HIP_MEMORY_SCOPE_AGENT); }
__device__ __forceinline__ unsigned xb_xcc_id() { return (unsigned)__builtin_amdgcn_s_getreg((3 << 11) | 20) & 0xFu; }
#define XB_SPIN(cond, bar) do { unsigned _sp = 0; while (cond) { __builtin_amdgcn_s_sleep(1); \
    if ((++_sp & 255u) == 0u) { if (xb_ld(&(bar)[XB_TMO])) break; if (_sp > XB_SPIN_CAP) { atomicAdd(&(bar)[XB_TMO], 1u); break; } } } } while (0)

struct XcdBarrier {
    unsigned* bar; unsigned x;
    volatile LAS unsigned* st;
};
__device__ __forceinline__ XcdBarrier xcd_barrier_post(unsigned* bar, volatile LAS unsigned* st, const int tid) {
    XcdBarrier b; b.bar = bar; b.x = xb_xcc_id(); b.st = st;
    if (tid == 0) (void)xb_add(&bar[XB_XCNT(b.x)], 1u);
    return b;
}
__device__ __forceinline__ void xcd_barrier_complete(unsigned* bar, unsigned x, unsigned& nloc, unsigned& nx) {
    const unsigned G = gridDim.x * gridDim.y * gridDim.z;
    unsigned sum, cnt, mine, sp = 0u;
    for (;;) {
        sum = 0u; cnt = 0u; mine = 0u;
#pragma unroll
        for (unsigned j = 0; j < 16; ++j) { const unsigned c = xb_ld(&bar[XB_XCNT(j)]); sum += c; cnt += (c > 0u) ? 1u : 0u; mine = (j == x) ? c : mine; }
        if (sum == G) break;
        __builtin_amdgcn_s_sleep(1);
        if ((++sp & 255u) == 0u) { if (xb_ld(&bar[XB_TMO])) break; if (sp > XB_SPIN_CAP) { atomicAdd(&bar[XB_TMO], 1u); break; } }
    }
    nloc = mine > 0u ? mine : 1u; nx = cnt > 0u ? cnt : 1u;
}
__device__ __forceinline__ void xcd_barrier(const XcdBarrier& b, const int tid) {
    asm volatile("s_waitcnt vmcnt(0)" ::: "memory");
    __syncthreads();
    if (tid == 0) {
        unsigned* bar = b.bar;
        __builtin_amdgcn_s_waitcnt(0);
        unsigned nloc = b.st[0], nx = b.st[1];
        if (nloc == 0u) { xcd_barrier_complete(bar, b.x, nloc, nx); b.st[0] = nloc; b.st[1] = nx; }
        const unsigned old = xb_add(&bar[XB_XSUB(b.x)], 1u);
        const unsigned gen = old / nloc;
        if (old + 1u == (gen + 1u) * nloc) {
            __builtin_amdgcn_fence(__ATOMIC_RELEASE, "agent");
            asm volatile("s_waitcnt vmcnt(0)" ::: "memory");
            const unsigned og = xb_add(&bar[XB_TOP], 1u);
            const unsigned tg = og / nx;
            if (og + 1u == (tg + 1u) * nx) xb_add(&bar[XB_TOPGEN], 1u);
            else XB_SPIN(xb_ld(&bar[XB_TOPGEN]) == tg, bar);
            __builtin_amdgcn_fence(__ATOMIC_ACQUIRE, "agent");
            xb_add(&bar[XB_XGEN(b.x)], 1u);
            asm volatile("s_waitcnt vmcnt(0)" ::: "memory");
        } else {
            XB_SPIN(xb_ld(&bar[XB_XGEN(b.x)]) == gen, bar);
            __builtin_amdgcn_fence(__ATOMIC_ACQUIRE, "agent");
            asm volatile("s_waitcnt vmcnt(0)" ::: "memory");
        }
    }
    __syncthreads();
}

struct Frame {
    LAS unsigned char* lds;
    int tid, lane, wave;
    int vcu, G;
    float* out; unsigned char* ws;
};
enum { A_XP = 0, A_XS, A_CP, A_CS, A_WADA, A_BADA, A_N1G, A_N2G, A_WIN, A_QNG, A_KNG, A_WATT, A_WFOUR, A_WOUT, A_WPQ, A_KEYS, A_PU, A_PV, A_FING };
__device__ __forceinline__ const float* karg(int k) {
    unsigned off = (unsigned)k * 8u; asm volatile("" : "+s"(off));
    typedef const float* cfp;
    return *(const __attribute__((address_space(4))) cfp*)((const __attribute__((address_space(4))) char*)__builtin_amdgcn_kernarg_segment_ptr() + off);
}
#define LDS_WAIT() asm volatile("s_waitcnt lgkmcnt(0)" ::: "memory")
#define VM_WAIT() asm volatile("s_waitcnt vmcnt(0)" ::: "memory")
__device__ __forceinline__ unsigned f2bf(float f) { unsigned u = __builtin_bit_cast(unsigned, f); return (u + 0x7fffu + ((u >> 16) & 1u)) >> 16; }
__device__ __forceinline__ unsigned pk2(float lo, float hi) { return f2bf(lo) | (f2bf(hi) << 16); }
__device__ __forceinline__ float wave_sum(float v) {
#pragma unroll
    for (int o = 1; o < 64; o <<= 1) v += __shfl_xor(v, o);
    return v;
}
__device__ __forceinline__ float wave_max(float v) {
#pragma unroll
    for (int o = 1; o < 64; o <<= 1) v = fmaxf(v, __shfl_xor(v, o));
    return v;
}

__device__ __forceinline__ void p0_transpose_item(const float* W, int K, int N, bf16_t* WT, LAS float* scr, int item, int lane) {
    const int nblk = N / 32, kb = item / nblk, nb = item % nblk, k0 = 64 * kb, n0 = 32 * nb;
#pragma unroll 8
    for (int i = 0; i < 32; ++i) { const int kk = 2 * i + (lane >> 5); scr[kk * 33 + (lane & 31)] = W[(size_t)(k0 + kk) * N + n0 + (lane & 31)]; }
    LDS_WAIT(); asm volatile("" ::: "memory");
    const int c = lane & 7;
#pragma unroll
    for (int j = 0; j < 4; ++j) { const int n = (lane >> 3) + 8 * j; const LAS float* s = scr + (8 * c) * 33 + n;
        u32x4 o; o.x = pk2(s[0 * 33], s[1 * 33]); o.y = pk2(s[2 * 33], s[3 * 33]); o.z = pk2(s[4 * 33], s[5 * 33]); o.w = pk2(s[6 * 33], s[7 * 33]);
        *(GAS u32x4*)(WT + (size_t)(n0 + n) * K + k0 + 8 * c) = o; }
    LDS_WAIT(); asm volatile("" ::: "memory");
}
__device__ __forceinline__ void p0_transpose_item_fp8(const float* W, int K, int N, unsigned char* WT, LAS float* scr, int item, int lane, float sc) {
    const int nblk = N / 32, kb = item / nblk, nb = item % nblk, k0 = 64 * kb, n0 = 32 * nb;
#pragma unroll 8
    for (int i = 0; i < 32; ++i) { const int kk = 2 * i + (lane >> 5); scr[kk * 33 + (lane & 31)] = __builtin_amdgcn_fmed3f(W[(size_t)(k0 + kk) * N + n0 + (lane & 31)] * sc, -448.f, 448.f); }
    LDS_WAIT(); asm volatile("" ::: "memory");
    const int c = lane & 3;
#pragma unroll
    for (int j = 0; j < 2; ++j) { const int n = (lane >> 2) + 16 * j; const LAS float* t = scr + (16 * c) * 33 + n; unsigned w[4];
#pragma unroll
        for (int q = 0; q < 4; ++q) { int v = 0; v = __builtin_amdgcn_cvt_pk_fp8_f32(t[(4 * q + 0) * 33], t[(4 * q + 1) * 33], v, false); v = __builtin_amdgcn_cvt_pk_fp8_f32(t[(4 * q + 2) * 33], t[(4 * q + 3) * 33], v, true); w[q] = (unsigned)v; }
        *(GAS u32x4*)(WT + (size_t)(n0 + n) * K + k0 + 16 * c) = (u32x4){w[0], w[1], w[2], w[3]}; }
    LDS_WAIT(); asm volatile("" ::: "memory");
}
__device__ __forceinline__ u32x6 fp6_settle(u32x6 q) { unsigned a = q[0], b = q[1], c = q[2], d = q[3], e = q[4], f = q[5];
    asm volatile("s_nop 15\n\ts_nop 15" : "+v"(a), "+v"(b), "+v"(c), "+v"(d), "+v"(e), "+v"(f)); return (u32x6){a, b, c, d, e, f}; }
constexpr int FP6_INV_OFF = 132096;
__device__ __forceinline__ void fp6_calibrate(Frame& F) {
    f32x16 a, b, a2, b2;
#pragma unroll
    for (int k = 0; k < 16; ++k) { a[k] = (float)(k & 7) * 0.125f; b[k] = (float)((k + 16) & 7) * 0.125f; a2[k] = (float)(k >> 3) * 0.125f; b2[k] = (float)((k + 16) >> 3) * 0.125f; }
    const u32x6 q1 = fp6_settle(__builtin_amdgcn_cvt_scalef32_2xpk16_fp6_f32(a, b, 1.0f)), q2 = fp6_settle(__builtin_amdgcn_cvt_scalef32_2xpk16_fp6_f32(a2, b2, 1.0f));
    const f32x32 d1 = __builtin_amdgcn_cvt_scalef32_pk32_f32_fp6(q1, 1.0f), d2 = __builtin_amdgcn_cvt_scalef32_pk32_f32_fp6(q2, 1.0f);
    LAS int* inv = (LAS int*)(F.lds + FP6_INV_OFF) + 32 * F.wave;
#pragma unroll
    for (int i = 0; i < 32; ++i) { const int k = ((int)(d1[i] * 8.f + 0.5f) & 7) + 8 * ((int)(d2[i] * 8.f + 0.5f) & 3); inv[k] = i; }
    LDS_WAIT(); asm volatile("" ::: "memory");
}
__device__ __forceinline__ void p0_fp6_row(const float* src, unsigned char* dst, float* scale_out, LAS float* stg, const LAS int* inv, int lane) {
    f32x4 v[16]; float mx = 0.f;
#pragma unroll
    for (int j = 0; j < 16; ++j) { v[j] = *(const GAS f32x4*)(src + (j >> 3) * 2048 + 32 * lane + 4 * (j & 7)); mx = fmaxf(mx, fmaxf(fmaxf(fabsf(v[j].x), fabsf(v[j].y)), fmaxf(fabsf(v[j].z), fabsf(v[j].w)))); }
    mx = wave_max(mx);
    const float sc = mx > 0.f ? mx * (1.f / 7.f) : 1.f, isc = 1.f / sc;
#pragma unroll
    for (int j = 0; j < 16; ++j) { stg[(4 * j + 0) * 64 + lane] = v[j].x * isc; stg[(4 * j + 1) * 64 + lane] = v[j].y * isc; stg[(4 * j + 2) * 64 + lane] = v[j].z * isc; stg[(4 * j + 3) * 64 + lane] = v[j].w * isc; }
    LDS_WAIT(); asm volatile("" ::: "memory");
    unsigned w[12];
#pragma unroll
    for (int grp = 0; grp < 2; ++grp) { f32x16 a, b;
#pragma unroll
        for (int k = 0; k < 16; ++k) { a[k] = stg[(32 * grp + inv[k]) * 64 + lane]; b[k] = stg[(32 * grp + inv[16 + k]) * 64 + lane]; }
        const u32x6 q = fp6_settle(__builtin_amdgcn_cvt_scalef32_2xpk16_fp6_f32(a, b, 1.0f));
#pragma unroll
        for (int i = 0; i < 6; ++i) w[6 * grp + i] = q[i]; }
#pragma unroll
    for (int j = 0; j < 3; ++j) *(GAS u32x4*)(dst + 1024 * j + 16 * lane) = (u32x4){w[4 * j], w[4 * j + 1], w[4 * j + 2], w[4 * j + 3]};
    if (lane == 0) *scale_out = sc;
    LDS_WAIT(); asm volatile("" ::: "memory");
}

__device__ __forceinline__ void p0_prologue(Frame& F, const int parts = 31) {
    const int gw = F.vcu * NWAVES + F.wave, NGW = F.G * NWAVES, lane = F.lane;
    const float* const a_cp = karg(A_CP); const float* const a_cs = karg(A_CS); const float* const a_wada = karg(A_WADA);
    if (parts & 1) {
        LAS float* sl = (LAS float*)(F.lds);
        LAS float* red = (LAS float*)(F.lds + 65536);
        for (int i = F.tid; i < 4 * DM; i += NWAVES * 64) { const int cb = i >> 12, k = i & (DM - 1); const float c = (cb < 2 ? a_cp[cb * DM + k] : a_cs[(cb - 2) * DM + k]); sl[i] = c * sigmoidf_(c); }
        __syncthreads();
        float* modp = (float*)(F.ws + WS_MODP);
        for (int it = F.vcu; it < 96 * 8; it += F.G) {
            const int cbk = it % 96, ks = it / 96, kbase = ks * 512 + F.wave * 64;
            const GAS f32x4* wp = (const GAS f32x4*)(a_wada + (size_t)kbase * (6 * DM) + cbk * 256) + lane;
            f32x4 a0 = {0.f, 0.f, 0.f, 0.f}, a1 = a0, a2 = a0, a3 = a0;
#pragma unroll 8
            for (int k = 0; k < 64; ++k) { const f32x4 w = wp[(size_t)k * (6 * DM / 4)];
                const float s0 = sl[kbase + k], s1 = sl[DM + kbase + k], s2 = sl[2 * DM + kbase + k], s3 = sl[3 * DM + kbase + k];
                a0 += w * s0; a1 += w * s1; a2 += w * s2; a3 += w * s3; }
            LAS f32x4* r4 = (LAS f32x4*)red + F.wave * 256 + lane;
            r4[0] = a0; r4[64] = a1; r4[128] = a2; r4[192] = a3;
            __syncthreads();
            for (int o = F.tid; o < 1024; o += NWAVES * 64) { float s = 0.f;
#pragma unroll
                for (int w = 0; w < 8; ++w) s += red[w * 1024 + o];
                const int cb = o >> 8, col = o & 255; modp[((size_t)ks * 4 + cb) * (6 * DM) + cbk * 256 + col] = s; }
            __syncthreads();
        }
    }
    if (parts & 2) {
        LAS float* scr = (LAS float*)(F.lds + F.wave * 16384);
        auto w_scale = [&](const float* wsm, int slot) -> float { float q = 0.f;
#pragma unroll 8
          for (int i = 0; i < 128; ++i) { const f32x4 v = *(const GAS f32x4*)(wsm + (size_t)(i * 64 + lane) * 4); q += (v.x * v.x + v.y * v.y) + (v.z * v.z + v.w * v.w); }
          q = wave_sum(q) * (1.f / 32768.f);
          const float e = q > 0.f ? 3.f - 0.5f * __builtin_amdgcn_logf(q) : 0.f;
          const float sc = __builtin_amdgcn_exp2f(__builtin_rintf(e));
          if (gw == 0 && lane == 0) ((float*)(F.ws + WS_SCIN))[slot] = 1.f / sc;
          return sc; };
        const float sc_win = w_scale(karg(A_WIN), 0), sc_watt = w_scale(karg(A_WATT), 1), sc_wout = w_scale(karg(A_WOUT), 2), sc_wfour = w_scale(karg(A_WFOUR), 3);
        const float* const a_win = karg(A_WIN); const float* const a_watt = karg(A_WATT); const float* const a_wfour = karg(A_WFOUR); const float* const a_wout = karg(A_WOUT); const float* const a_wpq = karg(A_WPQ);
        constexpr int I_IN = (DM / 64) * (NIN / 32), I_ATT = (DM / 64) * (DM / 32), I_FOUR = (FW / 64) * (DM / 32), I_OUT = I_ATT, I_PQ = (DM / 64) * (PQW / 32);
        constexpr int NITEMS = I_IN + I_ATT + I_FOUR + I_OUT + I_PQ;
        for (int it = gw; it < NITEMS; it += NGW) {
            int r = it;
            if (r < I_IN) { p0_transpose_item_fp8(a_win, DM, NIN, F.ws + WS_WIN, scr, r, lane, sc_win); continue; } r -= I_IN;
            if (r < I_ATT) { p0_transpose_item_fp8(a_watt, DM, DM, F.ws + WS_WATT, scr, r, lane, sc_watt); continue; } r -= I_ATT;
            if (r < I_FOUR) { p0_transpose_item_fp8(a_wfour, FW, DM, F.ws + WS_WFOUR, scr, r, lane, sc_wfour); continue; } r -= I_FOUR;
            if (r < I_OUT) { p0_transpose_item_fp8(a_wout, DM, DM, F.ws + WS_WOUT, scr, r, lane, sc_wout); continue; } r -= I_OUT;
            p0_transpose_item(a_wpq, DM, PQW, (bf16_t*)(F.ws + WS_WPQ), scr, r, lane);
        }
    }
    const float* const a_pu = karg(A_PU); const float* const a_pv = karg(A_PV);
    __syncthreads();
    fp6_calibrate(F);
    if (parts & 4) {
        LAS float* stg = (LAS float*)(F.lds + F.wave * 16384); const LAS int* inv = (const LAS int*)(F.lds + FP6_INV_OFF) + 32 * F.wave;
        for (int r = gw; r < 2 * PN; r += NGW) {
            if (r < PN) p0_fp6_row(a_pu + (size_t)r * DM, F.ws + WS_U8 + (size_t)r * PROW, (float*)(F.ws + WS_SCU) + r, stg, inv, lane);
            else { const int q = r - PN; p0_fp6_row(a_pv + (size_t)q * DM, F.ws + WS_V8 + (size_t)q * PROW, (float*)(F.ws + WS_SCV) + q, stg, inv, lane); }
        }
    }
    if (parts & 8) {
        bf16_t* d128 = (bf16_t*)(F.ws + WS_D128); bf16_t* ds64 = (bf16_t*)(F.ws + WS_DS64); bf16_t* ds32 = (bf16_t*)(F.ws + WS_DS32);
        for (int i = F.vcu * (NWAVES * 64) + F.tid; i < 3 * 65536; i += F.G * NWAVES * 64) {
            const int which = i >> 16, r = (i >> 8) & 255, k = i & 255; float v;
            if (which == 0) {
                const int k2 = r & 127, n2 = k & 127; const float rev = (float)((k2 * n2) & 127) * (1.f / 128.f);
                const float cs = __builtin_amdgcn_cosf(rev), sn = __builtin_amdgcn_sinf(rev);
                v = (r < 128) ? (k < 128 ? cs : -sn) : (k < 128 ? -sn : -cs);
            } else {
                const int S1 = which == 1 ? 64 : 32; v = 0.f;
                if (r < S1 && k < 2 * S1) { const int n1 = k & (S1 - 1); const float rev = (float)((r * n1) & (S1 - 1)) / (float)S1; v = (k < S1) ? __builtin_amdgcn_cosf(rev) : __builtin_amdgcn_sinf(rev); }
            }
            (which == 0 ? d128 : (which == 1 ? ds64 : ds32))[i & 65535] = (bf16_t)f2bf(v);
        }
    }
    if (parts & 16) {
        bf16_t* cs = (bf16_t*)(F.ws + WS_CS);
        for (int i = F.vcu * (NWAVES * 64) + F.tid; i < 512 * 256; i += F.G * NWAVES * 64) {
            const int r = i >> 8, k = i & 255, part = r >> 8, c = r & 255;
            const float rev = (float)((c * k) & 255) * (1.f / 256.f) - (part ? 0.25f : 0.f);
            cs[i] = (bf16_t)f2bf(__builtin_amdgcn_cosf(rev) * (1.f / 16.f));
        }
        bf16_t* kb = (bf16_t*)(F.ws + WS_KEYS); const float* const a_keys = karg(A_KEYS);
        for (int i = F.vcu * (NWAVES * 64) + F.tid; i < PH * 2 * PNK * PHALF; i += F.G * NWAVES * 64) kb[i] = (bf16_t)f2bf(a_keys[i]);
    }
}

template <bool SECOND>
__device__ __forceinline__ void p_normmod(Frame& F) {
    LAS float* Av = (LAS float*)(F.lds); LAS float* Bv = Av + DM;
    const float* const g = karg(SECOND ? A_N2G : A_N1G); const float* const a_bada = karg(A_BADA); const float* const a_xp = karg(A_XP); const float* const a_xs = karg(A_XS);
    const float* modp = (const float*)(F.ws + WS_MODP); const float* modf = (const float*)(F.ws + WS_MODF);
    bf16_t* H = (bf16_t*)(F.ws + WS_H);
    for (int cb = 0; cb < 4; ++cb) {
        for (int i = F.tid; i < DM; i += NWAVES * 64) {
            float sh, sc;
            if (SECOND) { sh = modf[cb * 6 * DM + 3 * DM + i]; sc = modf[cb * 6 * DM + 4 * DM + i]; }
            else { sh = a_bada[i]; sc = a_bada[DM + i];
#pragma unroll
                for (int ks = 0; ks < 8; ++ks) { sh += modp[((size_t)ks * 4 + cb) * (6 * DM) + i]; sc += modp[((size_t)ks * 4 + cb) * (6 * DM) + DM + i]; } }
            Av[i] = g[i] * (1.f + sc); Bv[i] = sh;
        }
        __syncthreads();
        const int base = cb == 0 ? 0 : (cb == 1 ? SP : (cb == 2 ? TP : TP + SS)), n = cb < 2 ? SP : SS;
        for (int r = F.vcu * NWAVES + F.wave; r < n; r += F.G * NWAVES) {
            const int m = base + r;
            if constexpr (SECOND) {
                const GAS u32x4* xr = (const GAS u32x4*)((const bf16_t*)(F.ws + WS_GF) + (size_t)m * DM) + F.lane;
                u32x4 raw[8]; float ss = 0.f;
#pragma unroll
                for (int j = 0; j < 8; ++j) raw[j] = xr[64 * j];
                __builtin_amdgcn_sched_barrier(0);
                f32x4 v[8][2];
#pragma unroll
                for (int j = 0; j < 8; ++j) { unpack8(raw[j], v[j][0], v[j][1]);
                    ss += ((v[j][0].x * v[j][0].x + v[j][0].y * v[j][0].y) + (v[j][0].z * v[j][0].z + v[j][0].w * v[j][0].w)) + ((v[j][1].x * v[j][1].x + v[j][1].y * v[j][1].y) + (v[j][1].z * v[j][1].z + v[j][1].w * v[j][1].w)); }
                const float rs = __builtin_amdgcn_rsqf(wave_sum(ss) * (1.f / DM) + EPS);
                GAS u32x4* o16 = (GAS u32x4*)(H + (size_t)m * DM) + F.lane;
#pragma unroll
                for (int j = 0; j < 8; ++j) { const int c4 = 2 * (F.lane + 64 * j);
                    const f32x4 a0 = ((LAS f32x4*)Av)[c4], a1 = ((LAS f32x4*)Av)[c4 + 1], b0 = ((LAS f32x4*)Bv)[c4], b1 = ((LAS f32x4*)Bv)[c4 + 1];
                    o16[64 * j] = pack8(v[j][0] * rs * a0 + b0, v[j][1] * rs * a1 + b1); }
            } else {
            const GAS f32x4* xr = (const GAS f32x4*)(m < TP ? a_xp + (size_t)m * DM : a_xs + (size_t)(m - TP) * DM) + F.lane;
            f32x4 v[16]; float ss = 0.f;
#pragma unroll
            for (int j = 0; j < 16; ++j) v[j] = xr[64 * j];
            __builtin_amdgcn_sched_barrier(0);
#pragma unroll
            for (int j = 0; j < 16; ++j) ss += (v[j].x * v[j].x + v[j].y * v[j].y) + (v[j].z * v[j].z + v[j].w * v[j].w);
            const float rs = __builtin_amdgcn_rsqf(wave_sum(ss) * (1.f / DM) + EPS);
            GAS unsigned* o4 = (GAS unsigned*)((unsigned char*)H + (size_t)m * DM) + F.lane;
#pragma unroll
            for (int j = 0; j < 16; ++j) { const f32x4 a = ((LAS f32x4*)Av)[F.lane + 64 * j], b = ((LAS f32x4*)Bv)[F.lane + 64 * j];
                f32x4 y = v[j] * rs * a + b;
#pragma unroll
                for (int i = 0; i < 4; ++i) y[i] = __builtin_amdgcn_fmed3f(y[i], -448.f, 448.f);
                int w = 0; w = __builtin_amdgcn_cvt_pk_fp8_f32(y.x, y.y, w, false); w = __builtin_amdgcn_cvt_pk_fp8_f32(y.z, y.w, w, true); o4[64 * j] = (unsigned)w; }
            }
        }
        __syncthreads();
    }
    if (!SECOND) {
        float* mf = (float*)(F.ws + WS_MODF);
        for (int i = F.vcu * (NWAVES * 64) + F.tid; i < 4 * 6 * DM; i += F.G * NWAVES * 64) { const int cb = i / (6 * DM), n = i % (6 * DM); float s = a_bada[n];
#pragma unroll
            for (int ks = 0; ks < 8; ++ks) s += modp[((size_t)ks * 4 + cb) * (6 * DM) + n];
            mf[i] = s; }
    }
}

__device__ __forceinline__ u32x2 pack8_fp8(f32x4 y0, f32x4 y1) { int w0 = 0, w1 = 0;
#pragma unroll
    for (int i = 0; i < 4; ++i) { y0[i] = __builtin_amdgcn_fmed3f(y0[i], -448.f, 448.f); y1[i] = __builtin_amdgcn_fmed3f(y1[i], -448.f, 448.f); }
    w0 = __builtin_amdgcn_cvt_pk_fp8_f32(y0[0], y0[1], w0, false); w0 = __builtin_amdgcn_cvt_pk_fp8_f32(y0[2], y0[3], w0, true);
    w1 = __builtin_amdgcn_cvt_pk_fp8_f32(y1[0], y1[1], w1, false); w1 = __builtin_amdgcn_cvt_pk_fp8_f32(y1[2], y1[3], w1, true);
    return (u32x2){(unsigned)w0, (unsigned)w1}; }
typedef f32x4 AccT[2][2][4][2];
#define EPI_LOOP_BEGIN _Pragma("unroll") for (int ai = 0; ai < 2; ++ai) _Pragma("unroll") for (int m = 0; m < 4; ++m) { const int row = u.pm * 256 + wr * 64 + fr + ai * 128 + m * 16; _Pragma("unroll") for (int bj = 0; bj < 2; ++bj) { const int ct = wc * 32 + 8 * fq + bj * 128; f32x4 v0 = acc[ai][bj][m][0], v1 = acc[ai][bj][m][1];
#define EPI_LOOP_END } }

struct EpiProj {
    unsigned char* ws;
    __device__ __forceinline__ void operator()(const AccT& acc, const pg8::Unit& u, int wr, int wc, int fr, int fq) const {
        const float isc = *(const GAS float*)(ws + WS_SCIN + 0 * (size_t)(fr & 0));
        const int colt = u.pn * 256; unsigned char* base; int ld, c0, kind = 1;
        if (colt < 4096) { base = ws + WS_Q; ld = 4096; c0 = colt; }
        else if (colt < 5120) { base = ws + WS_K; ld = 1024; c0 = colt - 4096; }
        else if (colt < 6144) { base = ws + WS_V; ld = 1024; c0 = colt - 5120; }
        else if (colt < 8192) { base = ws + WS_F; ld = 2048; c0 = colt - 6144; kind = 0; }
        else if (colt < 12288) { base = ws + WS_GA8; ld = 4096; c0 = colt - 8192; kind = 2; }
        else { base = ws + WS_GF; ld = 4096; c0 = colt - 12288; kind = 2; }
        if (kind == 0) {
            EPI_LOOP_BEGIN
                v0 = v0 * isc; v1 = v1 * isc;
                *(GAS u32x4*)((bf16_t*)base + (size_t)row * ld + c0 + ct) = pack8(v0, v1);
            EPI_LOOP_END
        } else if (kind == 1) {
            EPI_LOOP_BEGIN
                v0 = v0 * isc; v1 = v1 * isc;
                *(GAS u32x2*)(base + (size_t)row * ld + c0 + ct) = pack8_fp8(v0, v1);
            EPI_LOOP_END
        } else {
            EPI_LOOP_BEGIN
                v0 = v0 * isc; v1 = v1 * isc;
#pragma unroll
                for (int j = 0; j < 4; ++j) { v0[j] = sigmoidf_(v0[j]) * GATE8; v1[j] = sigmoidf_(v1[j]) * GATE8; }
                *(GAS u32x2*)(base + (size_t)row * ld + c0 + ct) = pack8_u8(v0, v1);
            EPI_LOOP_END
        }
    }
};
struct GemmSt0 {
    const bf16_t* A; const bf16_t* Fb; int K, lda, ldb; int S1, lg_tpg, lg_tps; long row_base, S;
    __device__ __forceinline__ const char* a_ptr(const pg8::Unit& u) const { return (const char*)A + (size_t)u.pm * 256 * lda * 2; }
    __device__ __forceinline__ const char* b_ptr(const pg8::Unit& u) const { const long g = u.pn >> lg_tpg, tt = u.pn & ((1 << lg_tpg) - 1), b = tt >> lg_tps, ti = tt & ((1 << lg_tps) - 1);
        return (const char*)Fb + ((row_base + b * S + 2 * ti) * ldb + g * 256) * 2; }
    __device__ __forceinline__ int b_rowoff(int Rb) const { return S1 * Rb; }
    __device__ __forceinline__ size_t b_hstep() const { return (size_t)ldb * 2; }
};
struct EpiSt0 {
    bf16_t* L0; int S1, lg_tpg, lg_tps;
    __device__ __forceinline__ void operator()(const AccT& acc, const pg8::Unit& u, int wr_, int wc_, int, int) const {
        const int tz = opaque_tid(wr_ * 4 + wc_), wid = __builtin_amdgcn_readfirstlane(tz >> 6), lane = tz & 63, wr = wid >> 2, wc = wid & 3, fr = lane & 15, fq = lane >> 4;
        const int g = u.pn >> lg_tpg, tt = u.pn & ((1 << lg_tpg) - 1), b = tt >> lg_tps, ti = tt & ((1 << lg_tps) - 1), bg = b * 8 + g, part = u.pm;
        const unsigned loff = ((unsigned)(64 * wr + fr) * (unsigned)S1 * 256u + (unsigned)(wc * 32 + 8 * fq)) * 2u;
#pragma unroll
        for (int ai = 0; ai < 2; ++ai)
#pragma unroll
            for (int m = 0; m < 4; ++m)
#pragma unroll
                for (int bj = 0; bj < 2; ++bj) {
                    const char* ub = (const char*)(L0 + ((((size_t)(bg * 256 + 128 * ai + 16 * m) * S1 + 2 * ti + bj) * 2 + part) * 128));
                    *(GAS u32x4*)(ub + loff) = pack8(acc[ai][bj][m][0], acc[ai][bj][m][1]);
                }
    }
};
struct EpiSt1 {
    bf16_t* L1p; bf16_t* L1s;
    __device__ __forceinline__ void operator()(const AccT& acc, const pg8::Unit& u, int wr_, int wc_, int, int) const {
        const int tz = opaque_tid(wr_ * 4 + wc_), wid = __builtin_amdgcn_readfirstlane(tz >> 6), lane = tz & 63, wr = wid >> 2, wc = wid & 3, fr = lane & 15, fq = lane >> 4;
        const bool smp = u.pn >= 512; const int lgS1 = smp ? 6 : 5, S1 = 1 << lgS1, nt0 = (smp ? u.pn - 512 : u.pn) * 256;
        const float invS = smp ? (1.f / 8192.f) : (1.f / 4096.f);
        const char* base = (const char*)(smp ? L1s : L1p);
#pragma unroll
        for (int m = 0; m < 4; ++m)
#pragma unroll
            for (int bj = 0; bj < 2; ++bj) {
                const int k2 = 64 * wr + 16 * m + fr, n0 = nt0 + wc * 32 + 8 * fq + bj * 128, bgc = n0 >> lgS1, n10 = n0 & (S1 - 1), bg = bgc >> 8, c = bgc & 255;
                const f32x4 r0 = acc[0][bj][m][0], r1 = acc[0][bj][m][1], i0 = acc[1][bj][m][0], i1 = acc[1][bj][m][1];
                float re[8] = {r0[0], r0[1], r0[2], r0[3], r1[0], r1[1], r1[2], r1[3]}, im[8] = {i0[0], i0[1], i0[2], i0[3], i1[0], i1[1], i1[2], i1[3]}, ore[8], oim[8];
#pragma unroll
                for (int j = 0; j < 8; ++j) { const float rev = (float)((n10 + j) * k2) * invS, cs = __builtin_amdgcn_cosf(rev), sn = __builtin_amdgcn_sinf(rev);
                    ore[j] = re[j] * cs + im[j] * sn; oim[j] = im[j] * cs - re[j] * sn; }
                const unsigned off = (((unsigned)((bg * 128 + k2) * 256 + c) * 2u) * (unsigned)S1 + (unsigned)n10) * 2u;
                *(GAS u32x4*)(base + off) = (u32x4){cvt_pk_bf16(ore[0], ore[1]), cvt_pk_bf16(ore[2], ore[3]), cvt_pk_bf16(ore[4], ore[5]), cvt_pk_bf16(ore[6], ore[7])};
                *(GAS u32x4*)(base + off + 2 * S1) = (u32x4){cvt_pk_bf16(oim[0], oim[1]), cvt_pk_bf16(oim[2], oim[3]), cvt_pk_bf16(oim[4], oim[5]), cvt_pk_bf16(oim[6], oim[7])};
            }
    }
};
struct EpiSt2 {
    unsigned char* out; int S1; long S; float scale;
    __device__ __forceinline__ void operator()(const AccT& acc, const pg8::Unit& u, int wr_, int wc_, int, int) const {
        const int tz = opaque_tid(wr_ * 4 + wc_), wid = __builtin_amdgcn_readfirstlane(tz >> 6), lane = tz & 63, wr = wid >> 2, wc = wid & 3, fr = lane & 15, fq = lane >> 4;
        const long bg = u.pn >> 7, k2 = u.pn & 127, b = bg >> 3, g = bg & 7;
        if (wr == 0) {
#pragma unroll
            for (int m = 0; m < 4; ++m) if (16 * m < S1)
#pragma unroll
                for (int bj = 0; bj < 2; ++bj) {
                    const long k1 = 16 * m + fr, ct = wc * 32 + 8 * fq + bj * 128;
                    *(GAS u32x2*)(out + (b * S + 128 * k1 + k2) * FW + g * 256 + ct) = pack8_fp8(acc[0][bj][m][0] * scale, acc[0][bj][m][1] * scale);
                }
        }
    }
};
#define EPI_ROWCOL(ai, m, bj) const int row = u.pm * 256 + wr * 64 + fr + (ai) * 128 + (m) * 16, ct = wc * 32 + 8 * fq + (bj) * 128
struct EpiGateA {
    bf16_t* ga; const unsigned char* ga8; const float* scp;
    __device__ __forceinline__ void operator()(const AccT& acc, const pg8::Unit& u, int wr, int wc, int fr, int fq) const {
        const float sc = *(const GAS float*)(scp + (fr & 0)) * (1.f / (ACT8 * GATE8));
#pragma unroll
        for (int ai = 0; ai < 2; ++ai) {
            u32x2 gv[4][2];
#pragma unroll
            for (int m = 0; m < 4; ++m)
#pragma unroll
                for (int bj = 0; bj < 2; ++bj) { EPI_ROWCOL(ai, m, bj); gv[m][bj] = *(const GAS u32x2*)(ga8 + (size_t)row * DM + u.pn * 256 + ct); }
            __builtin_amdgcn_sched_barrier(0);
#pragma unroll
            for (int m = 0; m < 4; ++m)
#pragma unroll
                for (int bj = 0; bj < 2; ++bj) { EPI_ROWCOL(ai, m, bj); f32x4 g0, g1; unpack8_u8(gv[m][bj], g0, g1);
                    *(GAS u32x4*)(ga + (size_t)row * DM + u.pn * 256 + ct) = pack8(g0 * (acc[ai][bj][m][0] * sc), g1 * (acc[ai][bj][m][1] * sc)); }
        }
    }
};
struct EpiGateF {
    const bf16_t* ga; const unsigned char* gf; unsigned char* m8; const float* scp;
    __device__ __forceinline__ void operator()(const AccT& acc, const pg8::Unit& u, int wr, int wc, int fr, int fq) const {
        const float sc = *(const GAS float*)(scp + (fr & 0)) * (1.f / GATE8);
#pragma unroll
        for (int ai = 0; ai < 2; ++ai) {
            u32x4 mv[4][2]; u32x2 gv[4][2];
#pragma unroll
            for (int m = 0; m < 4; ++m)
#pragma unroll
                for (int bj = 0; bj < 2; ++bj) { EPI_ROWCOL(ai, m, bj); mv[m][bj] = *(const GAS u32x4*)(ga + (size_t)row * DM + u.pn * 256 + ct); gv[m][bj] = *(const GAS u32x2*)(gf + (size_t)row * DM + u.pn * 256 + ct); }
            __builtin_amdgcn_sched_barrier(0);
#pragma unroll
            for (int m = 0; m < 4; ++m)
#pragma unroll
                for (int bj = 0; bj < 2; ++bj) { EPI_ROWCOL(ai, m, bj); f32x4 m0, m1, g0, g1; unpack8(mv[m][bj], m0, m1); unpack8_u8(gv[m][bj], g0, g1);
                    *(GAS u32x2*)(m8 + (size_t)row * DM + u.pn * 256 + ct) = pack8_fp8(m0 + g0 * (acc[ai][bj][m][0] * sc), m1 + g1 * (acc[ai][bj][m][1] * sc)); }
        }
    }
};
struct EpiResid {
    const float* xp; const float* xs; const float* modf; bf16_t* out; const float* scp;
    __device__ __forceinline__ void operator()(const AccT& acc, const pg8::Unit& u, int wr, int wc, int fr, int fq) const {
        const float sc = *(const GAS float*)(scp + (fr & 0));
        const int cb = cb_of_row(u.pm * 256); const float* g1 = modf + (size_t)cb * 6 * DM + 2 * DM + u.pn * 256;
        f32x4 q[2][2];
#pragma unroll
        for (int bj = 0; bj < 2; ++bj) { const int ct = wc * 32 + 8 * fq + bj * 128; q[bj][0] = *(const GAS f32x4*)(g1 + ct) * sc; q[bj][1] = *(const GAS f32x4*)(g1 + ct + 4) * sc; }
#pragma unroll
        for (int ai = 0; ai < 2; ++ai) {
            f32x4 xv[4][2][2];
#pragma unroll
            for (int m = 0; m < 4; ++m)
#pragma unroll
                for (int bj = 0; bj < 2; ++bj) { EPI_ROWCOL(ai, m, bj);
                    const float* xr = (row < TP ? xp + (size_t)row * DM : xs + (size_t)(row - TP) * DM) + u.pn * 256 + ct;
                    xv[m][bj][0] = *(const GAS f32x4*)xr; xv[m][bj][1] = *(const GAS f32x4*)(xr + 4); }
            __builtin_amdgcn_sched_barrier(0);
#pragma unroll
            for (int m = 0; m < 4; ++m)
#pragma unroll
                for (int bj = 0; bj < 2; ++bj) { EPI_ROWCOL(ai, m, bj);
                    *(GAS u32x4*)(out + (size_t)row * DM + u.pn * 256 + ct) = pack8(xv[m][bj][0] + q[bj][0] * acc[ai][bj][m][0], xv[m][bj][1] + q[bj][1] * acc[ai][bj][m][1]); }
        }
    }
};
struct EpiPlain {
    bf16_t* out; int ld;
    __device__ __forceinline__ void operator()(const AccT& acc, const pg8::Unit& u, int wr, int wc, int fr, int fq) const {
        EPI_LOOP_BEGIN
            *(GAS u32x4*)(out + (size_t)row * ld + u.pn * 256 + ct) = pack8(v0, v1);
        EPI_LOOP_END
    }
};

__device__ __forceinline__ void p3_qk_rope(Frame& F) {
    const int lane = F.lane, li = lane & 15;
    bf16_t* Q = (bf16_t*)(F.ws + WS_Q); bf16_t* K = (bf16_t*)(F.ws + WS_K); unsigned char* const O8 = (unsigned char*)F.out;
    float gq[8], gk[8], ifr[4]; const float* const a_qng = karg(A_QNG); const float* const a_kng = karg(A_KNG);
#pragma unroll
    for (int d = 0; d < 8; ++d) { gq[d] = a_qng[8 * li + d]; gk[d] = a_kng[8 * li + d]; }
#pragma unroll
    for (int t = 0; t < 4; ++t) ifr[t] = __builtin_amdgcn_exp2f(-(float)((4 * li + t) & 31) * (13.287712379549449f / 32.f));
    for (int m = F.vcu * NWAVES + F.wave; m < TT; m += F.G * NWAVES) {
        const int pos = m < TP ? (m & (SP - 1)) : ((m - TP) & (SS - 1));
        const float id = (float)(li < 8 ? (pos >> 6) : (pos & 63));
        float cs[4], sn[4];
#pragma unroll
        for (int t = 0; t < 4; ++t) { const float ang = id * ifr[t]; cs[t] = __cosf(ang); sn[t] = __sinf(ang); }
        u32x2 raw[10];
#pragma unroll
        for (int jj = 0; jj < 10; ++jj) raw[jj] = *(jj < 8 ? (const GAS u32x2*)((const unsigned char*)Q + (size_t)m * 4096 + jj * 512 + lane * 8) : (const GAS u32x2*)((const unsigned char*)K + (size_t)m * 1024 + (jj - 8) * 512 + lane * 8));
        __builtin_amdgcn_sched_barrier(0);
#pragma unroll
        for (int jj = 0; jj < 10; ++jj) {
            GAS u32x4* p = jj < 8 ? (GAS u32x4*)(Q + (size_t)m * 4096 + jj * 512 + lane * 8) : (GAS u32x4*)(K + (size_t)m * 1024 + (jj - 8) * 512 + lane * 8);
            f32x4 v0, v1; unpack8_fp8(raw[jj], v0, v1);
            float ss = (v0.x * v0.x + v0.y * v0.y) + (v0.z * v0.z + v0.w * v0.w) + (v1.x * v1.x + v1.y * v1.y) + (v1.z * v1.z + v1.w * v1.w);
            ss += __shfl_xor(ss, 1); ss += __shfl_xor(ss, 2); ss += __shfl_xor(ss, 4); ss += __shfl_xor(ss, 8);
            const float rs = __builtin_amdgcn_rsqf(ss * (1.f / 128.f) + EPS);
            const float* g = jj < 8 ? gq : gk;
            float y[8] = {v0.x * rs * g[0], v0.y * rs * g[1], v0.z * rs * g[2], v0.w * rs * g[3], v1.x * rs * g[4], v1.y * rs * g[5], v1.z * rs * g[6], v1.w * rs * g[7]};
            float o[8];
#pragma unroll
            for (int t = 0; t < 4; ++t) { o[2 * t] = y[2 * t] * cs[t] - y[2 * t + 1] * sn[t]; o[2 * t + 1] = y[2 * t] * sn[t] + y[2 * t + 1] * cs[t]; }
#if ATTN_FP8
            (void)p;
            const float qm = jj < 8 ? attn8::QMUL : 1.f;
            const u32x2 pk = pack8_fp8((f32x4){o[0], o[1], o[2], o[3]} * qm, (f32x4){o[4], o[5], o[6], o[7]} * qm);
            if (jj < 8) *(GAS u32x2*)(O8 + DO_Q8 + (size_t)m * 4096 + jj * 512 + lane * 8) = pk;
            else { const int kvh = (jj - 8) * 4 + (lane >> 4), key = m & 63;
                *(GAS u32x2*)(O8 + DO_K8 + ((size_t)(m >> 6) * 8 + kvh) * 8192 + key * 128 + (((li >> 1) ^ ((key >> 1) & 7)) << 4) + (li & 1) * 8) = pk; }
#else
            *p = (u32x4){cvt_pk_bf16(o[0], o[1]), cvt_pk_bf16(o[2], o[3]), cvt_pk_bf16(o[4], o[5]), cvt_pk_bf16(o[6], o[7])};
#endif
        }
    }
}

__device__ __forceinline__ void p3_vt(Frame& F) {
    const int lane = F.lane;
    const unsigned char* V = F.ws + WS_V; unsigned char* const O8 = (unsigned char*)F.out + DO_V8;
    for (int item = F.vcu * NWAVES + F.wave; item < (TT / 64) * 16; item += F.G * NWAVES) {
        const int tile = item >> 4, kvh = (item >> 1) & 7, d = (item & 1) * 64 + lane;
        const GAS unsigned char* src = (const GAS unsigned char*)(V + (size_t)tile * 64 * 1024 + kvh * 128 + d);
        unsigned raw[64];
#pragma unroll
        for (int k = 0; k < 64; ++k) raw[k] = src[(size_t)k * 1024];
        unsigned char* row = O8 + ((size_t)tile * 8 + kvh) * 8192 + d * 64; const int sv = (d >> 2) & 3;
#pragma unroll
        for (int c = 0; c < 4; ++c) { u32x4 w;
#pragma unroll
            for (int q = 0; q < 4; ++q) { unsigned x = 0;
#pragma unroll
                for (int b = 0; b < 4; ++b) { const int beta = 16 * c + 4 * q + b, hi = beta >> 5, pp = (beta >> 4) & 1, r = beta & 15, key = 32 * pp + (r & 3) + 8 * (r >> 2) + 4 * hi;
                    x |= raw[key] << (8 * b); }
                w[q] = x; }
            *(GAS u32x4*)(row + ((c ^ sv) << 4)) = w; }
    }
}

__device__ __forceinline__ void p4_attention(Frame& F, char* lds, bool dummy) {
    bf16_t* Q = (bf16_t*)(F.ws + WS_Q); const bf16_t* K = (const bf16_t*)(F.ws + WS_K); const bf16_t* V = (const bf16_t*)(F.ws + WS_V);
    for (int L = blockIdx.x; L < 2048 + 1024; L += F.G) {
        const bool smp = L < 2048; const long Lp = smp ? L : L - 2048;
        const long x = Lp & 7, w = (Lp >> 3) & 31, i = Lp >> 8;
        const long j = smp ? (i >> 2) : (i >> 1), uu = smp ? ((i & 3) * 32 + w) : ((i & 1) * 32 + w);
        const long pair = x + 8 * j, b = pair >> 3, kvh = pair & 7;
        const long h = kvh * 4 + (smp ? (uu >> 5) : (uu >> 4)), qb = smp ? (uu & 31) : (uu & 15), S = smp ? SS : SP;
        const long r0 = (smp ? (long)TP : 0) + b * S;
        bf16_t* qp = Q + (r0 + qb * 256) * 4096 + h * 128;
        unsigned char* op = (dummy ? (unsigned char*)F.out + (size_t)256 * MiB : F.ws + WS_H) + (r0 + qb * 256) * 4096 + h * 128;
#if ATTN_FP8
        (void)qp; (void)K; (void)V; (void)lds;
        const unsigned char* const o8 = (const unsigned char*)F.out;
        if (dummy) attn8::body<ATT_PROBE>(o8 + DO_Q8 + (r0 + qb * 256) * 4096 + h * 128, o8 + DO_K8 + ((r0 >> 6) * 8 + kvh) * 8192, o8 + DO_V8 + ((r0 >> 6) * 8 + kvh) * 8192, op, (int)S, (A8_LAS char*)F.lds, F.wave);
        else attn8::body128(o8 + DO_Q8 + (r0 + qb * 256) * 4096 + h * 128, o8 + DO_K8 + ((r0 >> 6) * 8 + kvh) * 8192, o8 + DO_V8 + ((r0 >> 6) * 8 + kvh) * 8192, op, (int)S, (A8_LAS char*)F.lds, F.wave);
#else
        attn::attn_dense_body<attn::bf16>((const attn::bf16*)qp, (const attn::bf16*)(K + r0 * 1024 + kvh * 128), (const attn::bf16*)(V + r0 * 1024 + kvh * 128), (float*)op, (int)S, lds);
#endif
    }
}

__device__ __forceinline__ unsigned f2ord(float f) { const unsigned u = __float_as_uint(f); return (u & 0x80000000u) ? ~u : (u | 0x80000000u); }
__device__ __forceinline__ float ord2f(unsigned o) { return __uint_as_float((o & 0x80000000u) ? (o & 0x7fffffffu) : ~o); }
__device__ __forceinline__ unsigned umax3(unsigned a, unsigned b, unsigned c) { return max(max(a, b), c); }

#define CE_DESC(x, y) do { const unsigned _hi = max(x, y), _lo = min(x, y); x = _hi; y = _lo; } while (0)
__device__ __forceinline__ void bitonic_merge16(unsigned (&a)[16]) {
#pragma unroll
    for (int j = 8; j >= 1; j >>= 1)
#pragma unroll
        for (int i = 0; i < 16; ++i) { const int l = i ^ j; if (l > i) CE_DESC(a[i], a[l]); }
}
__device__ __forceinline__ void sort16(unsigned (&a)[16]) {
#pragma unroll
    for (int k = 2; k <= 16; k <<= 1)
#pragma unroll
        for (int j = k >> 1; j >= 1; j >>= 1)
#pragma unroll
            for (int i = 0; i < 16; ++i) { const int l = i ^ j; if (l > i) { if ((i & k) == 0) CE_DESC(a[i], a[l]); else CE_DESC(a[l], a[i]); } }
}
__device__ __forceinline__ void top16_merge(unsigned (&a)[16], const unsigned (&b)[16]) {
#pragma unroll
    for (int i = 0; i < 16; ++i) a[i] = max(a[i], b[15 - i]);
    bitonic_merge16(a);
}

__device__ __forceinline__ void p9_route(Frame& F) {
    const int lane = F.lane, r32 = lane & 31, hi = lane >> 5;
    const bf16_t* PQ = (const bf16_t*)(F.ws + WS_Q); const bf16_t* KB = (const bf16_t*)(F.ws + WS_KEYS);
    int* IDX = (int*)(F.ws + WS_IDX); float* GATE = (float*)(F.ws + WS_GATE);
    LAS unsigned* cpt = (LAS unsigned*)(F.lds + F.wave * 8192) + lane * 25;
    for (int task = F.vcu * NWAVES + F.wave; task < (TT / 32) * PH; task += F.G * NWAVES) {
        const int tile = task >> 3, h = task & 7, t0 = tile * 32;
        unsigned key[8][16];
        {
            const bf16_t* qrow = PQ + (size_t)(t0 + r32) * PQW + h * 256 + hi * 8;
            f32x16 acc[2][4];
            unsigned koff = (unsigned)(((h * 256 + r32) * 128 + hi * 8) * 2);
            asm volatile("" : "+v"(koff));
#pragma unroll
            for (int p = 0; p < 2; ++p) {
                bf16x8 bq[8];
#pragma unroll
                for (int ks = 0; ks < 8; ++ks) bq[ks] = *(const GAS bf16x8*)(qrow + p * 128 + ks * 16);
#pragma unroll
                for (int nb = 0; nb < 4; ++nb) {
                    const char* krow = (const char*)KB + (size_t)(p * 128 + nb * 32) * 256;
                    bf16x8 ka[8];
#pragma unroll
                    for (int ks = 0; ks < 8; ++ks) ka[ks] = *(const GAS bf16x8*)(krow + koff + ks * 32);
                    f32x16 a = {};
#pragma unroll
                    for (int ks = 0; ks < 8; ++ks) a = __builtin_amdgcn_mfma_f32_32x32x16_bf16(ka[ks], bq[ks], a, 0, 0, 0);
                    acc[p][nb] = a;
                    __builtin_amdgcn_sched_barrier(0);
                }
            }
#pragma unroll
            for (int nb = 0; nb < 4; ++nb)
#pragma unroll
                for (int r = 0; r < 16; ++r) {
                    auto rr = __builtin_amdgcn_permlane32_swap(__float_as_uint(acc[0][nb][r]), __float_as_uint(acc[1][nb][r]), false, false);
                    unsigned k0 = (f2ord(__uint_as_float(rr[0])) & ~127u) | (unsigned)r, k1 = (f2ord(__uint_as_float(rr[1])) & ~127u) | (unsigned)r;
                    asm volatile("" : "+v"(k0), "+v"(k1));
                    key[2 * nb][r] = k0 | (unsigned)(nb << 5); key[2 * nb + 1][r] = k1 | (unsigned)(16 + (nb << 5));
                }
        }
#pragma unroll
        for (int g = 0; g < 8; ++g) sort16(key[g]);
        top16_merge(key[0], key[1]); top16_merge(key[2], key[3]); top16_merge(key[4], key[5]); top16_merge(key[6], key[7]);
        top16_merge(key[0], key[2]); top16_merge(key[4], key[6]); top16_merge(key[0], key[4]);
        float va[16], vb[16]; int ia[16], ib[16];
#pragma unroll
        for (int i = 0; i < 16; ++i) { auto rr = __builtin_amdgcn_permlane32_swap(key[0][i], key[0][i], false, false);
            const unsigned la = rr[0] & 127u, lb = rr[1] & 127u;
            va[i] = ord2f(rr[0] & ~127u); ia[i] = (int)((la & 96u) + (la & 3u) + ((la & 12u) << 1) + ((la & 16u) >> 2));
            vb[i] = ord2f(rr[1] & ~127u); ib[i] = (int)((lb & 96u) + (lb & 3u) + ((lb & 12u) << 1) + ((lb & 16u) >> 2)); }
        unsigned ck[4][16]; int nc = 0; unsigned pend = 0u;
#pragma unroll
        for (int i = 0; i < 16; ++i)
#pragma unroll
            for (int j = 0; j < 16; ++j) if ((i + 1) * (j + 1) <= 16) {
                ck[nc >> 4][nc & 15] = (f2ord(va[i] + vb[j]) & ~63u) | (unsigned)nc;
                const unsigned id = (unsigned)(ia[i] * 128 + ib[j]);
                if (nc & 1) cpt[nc >> 1] = pend | (id << 16); else pend = id;
                ++nc; }
#pragma unroll
        for (int q = 50; q < 64; ++q) ck[q >> 4][q & 15] = 0u;
        sort16(ck[1]); sort16(ck[2]); sort16(ck[3]);
        top16_merge(ck[0], ck[1]); top16_merge(ck[2], ck[3]); top16_merge(ck[0], ck[2]);
        float bv[16]; int bi[16];
#pragma unroll
        for (int rd = 0; rd < 16; ++rd) { const unsigned mx = ck[0][rd], slot = mx & 63u;
            bv[rd] = ord2f(mx & ~63u); bi[rd] = (int)((cpt[slot >> 1] >> ((slot & 1u) * 16u)) & 0xffffu); }
        float e[16], es = 0.f;
#pragma unroll
        for (int k = 0; k < 16; ++k) { e[k] = __builtin_amdgcn_exp2f((bv[k] - bv[0]) * 1.4426950408889634f); es += e[k]; }
        const float inv = 1.f / es;
        const size_t ob = (size_t)(t0 + r32) * NSEL + h * 16 + hi * 8;
#pragma unroll
        for (int k = 0; k < 8; ++k) { IDX[ob + k] = hi ? bi[8 + k] : bi[k]; GATE[ob + k] = (hi ? e[8 + k] : e[k]) * inv; }
    }
}

__device__ __forceinline__ float dpp_row_sum(float v) {
    v += __builtin_bit_cast(float, __builtin_amdgcn_update_dpp(0, __builtin_bit_cast(int, v), 0xB1, 0xF, 0xF, false));
    v += __builtin_bit_cast(float, __builtin_amdgcn_update_dpp(0, __builtin_bit_cast(int, v), 0x4E, 0xF, 0xF, false));
    v += __builtin_bit_cast(float, __builtin_amdgcn_update_dpp(0, __builtin_bit_cast(int, v), 0x141, 0xF, 0xF, false));
    v += __builtin_bit_cast(float, __builtin_amdgcn_update_dpp(0, __builtin_bit_cast(int, v), 0x140, 0xF, 0xF, false));
    return v;
}
__device__ __forceinline__ float wave_sum_u(float v) {
    v = dpp_row_sum(v);
    return __builtin_bit_cast(float, __builtin_amdgcn_readlane(__builtin_bit_cast(int, v), 0)) + __builtin_bit_cast(float, __builtin_amdgcn_readlane(__builtin_bit_cast(int, v), 16)) +
           __builtin_bit_cast(float, __builtin_amdgcn_readlane(__builtin_bit_cast(int, v), 32)) + __builtin_bit_cast(float, __builtin_amdgcn_readlane(__builtin_bit_cast(int, v), 48));
}
#define FP8_DEC(WV, o) do { const f32x2 _a = __builtin_amdgcn_cvt_pk_f32_fp8((int)(WV)[0], false), _b = __builtin_amdgcn_cvt_pk_f32_fp8((int)(WV)[0], true), _c = __builtin_amdgcn_cvt_pk_f32_fp8((int)(WV)[1], false), _d = __builtin_amdgcn_cvt_pk_f32_fp8((int)(WV)[1], true), \
    _e = __builtin_amdgcn_cvt_pk_f32_fp8((int)(WV)[2], false), _f = __builtin_amdgcn_cvt_pk_f32_fp8((int)(WV)[2], true), _g = __builtin_amdgcn_cvt_pk_f32_fp8((int)(WV)[3], false), _h = __builtin_amdgcn_cvt_pk_f32_fp8((int)(WV)[3], true); \
    o[0] = _a.x; o[1] = _a.y; o[2] = _b.x; o[3] = _b.y; o[4] = _c.x; o[5] = _c.y; o[6] = _d.x; o[7] = _d.y; o[8] = _e.x; o[9] = _e.y; o[10] = _f.x; o[11] = _f.y; o[12] = _g.x; o[13] = _g.y; o[14] = _h.x; o[15] = _h.y; } while (0)

__device__ __forceinline__ void sort128_by_id(int& i0, float& g0, int& i1, float& g1, const int lane) {
#pragma unroll
    for (int k = 2; k <= 128; k <<= 1)
#pragma unroll
        for (int j = k >> 1; j >= 1; j >>= 1) {
            if (j == 64) { if (i0 > i1) { const int ti = i0; i0 = i1; i1 = ti; const float tg = g0; g0 = g1; g1 = tg; } }
            else {
                const bool lower = (lane & j) == 0;
                const bool up0 = (k == 128) ? true : ((lane & k) == 0), up1 = up0;
                const bool upr0 = (k == 64) ? true : up0, upr1 = (k == 64) ? false : up1;
                const int oi0 = __shfl_xor(i0, j), oi1 = __shfl_xor(i1, j); const float og0 = __shfl_xor(g0, j), og1 = __shfl_xor(g1, j);
                { const bool keep_min = (lower == upr0); const bool take = keep_min ? (oi0 < i0) : (oi0 > i0); i0 = take ? oi0 : i0; g0 = take ? og0 : g0; }
                { const bool keep_min = (lower == upr1); const bool take = keep_min ? (oi1 < i1) : (oi1 > i1); i1 = take ? oi1 : i1; g1 = take ? og1 : g1; }
            }
        }
}

__device__ __forceinline__ void p10_peer(Frame& F, const bool dummy) {
    const int lane = F.lane;
    const bf16_t* H = (const bf16_t*)(F.ws + WS_H);
    const unsigned char* U8 = F.ws + WS_U8; const unsigned char* V8 = F.ws + WS_V8;
    const float* SCU = (const float*)(F.ws + WS_SCU); const float* SCV = (const float*)(F.ws + WS_SCV);
    const int* IDX = (const int*)(F.ws + WS_IDX); const float* GATE = (const float*)(F.ws + WS_GATE);
    const float* modf = (const float*)(F.ws + WS_MODF); const float* const a_fing = karg(A_FING);
    constexpr int RING = 5;
    LAS unsigned char* const ring = F.lds + F.wave * 16384;
#define P10_FENCE() do { asm volatile("" ::: "memory"); __builtin_amdgcn_sched_barrier(0); } while (0)
#define PEER_ISSUE(TAB, slot, e) do { const int _e = (e) < NSEL ? (e) : NSEL - 1; const int _row = __builtin_amdgcn_readlane(_e < 64 ? i0 : i1, _e & 63); const char* _p = (const char*)(TAB) + (size_t)_row * PROW + 16 * lane; \
        _Pragma("unroll") for (int _s = 0; _s < 3; ++_s) __builtin_amdgcn_global_load_lds((const unsigned*)(_p + 1024 * _s), (LAS unsigned*)(ring + (slot) * PROW + 1024 * _s), 16, 0, 0); } while (0)
#define PEER_WAIT() asm volatile("s_waitcnt vmcnt(12)" ::: "memory")
#define PEER_RAW(slot) u32x4 _w0 = *(const LAS u32x4*)(ring + (slot) * PROW + 16 * lane), _w1 = *(const LAS u32x4*)(ring + (slot) * PROW + 1024 + 16 * lane), _w2 = *(const LAS u32x4*)(ring + (slot) * PROW + 2048 + 16 * lane)
#define PEER_DEC_A() __builtin_amdgcn_cvt_scalef32_pk32_f32_fp6((u32x6){_w0.x, _w0.y, _w0.z, _w0.w, _w1.x, _w1.y}, 1.0f)
#define PEER_DEC_B() __builtin_amdgcn_cvt_scalef32_pk32_f32_fp6((u32x6){_w1.z, _w1.w, _w2.x, _w2.y, _w2.z, _w2.w}, 1.0f)
#define PEER_PIN_B() asm volatile("" : "+v"(_w1.z), "+v"(_w1.w), "+v"(_w2.x), "+v"(_w2.y), "+v"(_w2.z), "+v"(_w2.w))
    for (int t = F.vcu * NWAVES + F.wave; t < TT; t += F.G * NWAVES) {
        int i0 = IDX[(size_t)t * NSEL + lane], i1 = IDX[(size_t)t * NSEL + 64 + lane];
        float g0 = GATE[(size_t)t * NSEL + lane], g1 = GATE[(size_t)t * NSEL + 64 + lane];
        sort128_by_id(i0, g0, i1, g1, lane);
        const float su0 = SCU[i0], su1 = SCU[i1], sv0 = SCV[i0], sv1 = SCV[i1];
        float a0, a1;
        {
            float hv[64];
#pragma unroll
            for (int grp = 0; grp < 2; ++grp) { const GAS u32x4* hp = (const GAS u32x4*)(H + (size_t)t * DM + grp * 2048 + 32 * lane);
#pragma unroll
                for (int q = 0; q < 4; ++q) { const u32x4 w = hp[q]; f32x4 a, b; unpack8(w, a, b); const int o = 32 * grp + 8 * q;
                    hv[o + 0] = a.x; hv[o + 1] = a.y; hv[o + 2] = a.z; hv[o + 3] = a.w; hv[o + 4] = b.x; hv[o + 5] = b.y; hv[o + 6] = b.z; hv[o + 7] = b.w; } }
            asm volatile("s_waitcnt vmcnt(0)" ::: "memory");
            P10_FENCE();
            float z0 = 0.f, z1 = 0.f;
#pragma unroll
            for (int k = 0; k < RING; ++k) PEER_ISSUE(U8, k, k);
            P10_FENCE();
            for (int e0 = 0; e0 < NSEL + RING - 1; e0 += RING) {
#pragma unroll
                for (int k = 0; k < RING; ++k) {
                    const int e = e0 + k; float p0 = 0.f, p1 = 0.f, p2 = 0.f, p3 = 0.f;
                    PEER_WAIT();
                    PEER_RAW(k);
                    { const f32x32 d = PEER_DEC_A();
#pragma unroll
                      for (int i = 0; i < 8; ++i) { p0 = fmaf(hv[i], d[i], p0); p1 = fmaf(hv[8 + i], d[8 + i], p1); p2 = fmaf(hv[16 + i], d[16 + i], p2); p3 = fmaf(hv[24 + i], d[24 + i], p3); } }
                    asm volatile("" : "+v"(p0), "+v"(p1), "+v"(p2), "+v"(p3)); PEER_PIN_B(); __builtin_amdgcn_sched_barrier(0);
                    { const f32x32 d = PEER_DEC_B();
#pragma unroll
                      for (int i = 0; i < 8; ++i) { p0 = fmaf(hv[32 + i], d[i], p0); p1 = fmaf(hv[40 + i], d[8 + i], p1); p2 = fmaf(hv[48 + i], d[16 + i], p2); p3 = fmaf(hv[56 + i], d[24 + i], p3); } }
                    float pz = (p0 + p1) + (p2 + p3);
                    asm volatile("" : "+v"(pz) :: "memory"); __builtin_amdgcn_sched_barrier(0);
                    PEER_ISSUE(U8, k, e + RING);
                    P10_FENCE();
                    const float z = wave_sum_u(pz);
                    z0 = (lane == e) ? z : z0; z1 = (lane == e - 64) ? z : z1;
                }
            }
            asm volatile("s_waitcnt vmcnt(0)" ::: "memory");
            z0 *= su0; z1 *= su1;
            a0 = 0.5f * z0 * (1.f + erff(z0 * 0.70710678118654752f)) * g0 * sv0; a1 = 0.5f * z1 * (1.f + erff(z1 * 0.70710678118654752f)) * g1 * sv1;
        }
        P10_FENCE();
        float ov[64];
#pragma unroll
        for (int i = 0; i < 64; ++i) ov[i] = 0.f;
#pragma unroll
        for (int k = 0; k < RING; ++k) PEER_ISSUE(V8, k, k);
        P10_FENCE();
        for (int e0 = 0; e0 < NSEL + RING - 1; e0 += RING) {
#pragma unroll
            for (int k = 0; k < RING; ++k) {
                const int e = e0 + k;
                float w = __builtin_bit_cast(float, __builtin_amdgcn_readlane(__builtin_bit_cast(int, e < 64 ? a0 : a1), e & 63));
                w = e < NSEL ? w : 0.f;
                PEER_WAIT();
                PEER_RAW(k);
                { const f32x32 d = PEER_DEC_A();
#pragma unroll
                  for (int i = 0; i < 32; ++i) asm("v_fmac_f32_e32 %0, %1, %2" : "+v"(ov[i]) : "v"(w), "v"(d[i])); }
                asm volatile("" : "+v"(ov[31]), "+v"(ov[15])); PEER_PIN_B(); __builtin_amdgcn_sched_barrier(0);
                { const f32x32 d = PEER_DEC_B();
#pragma unroll
                  for (int i = 0; i < 32; ++i) asm("v_fmac_f32_e32 %0, %1, %2" : "+v"(ov[32 + i]) : "v"(w), "v"(d[i])); }
                asm volatile("" : "+v"(ov[31]), "+v"(ov[63]) :: "memory"); __builtin_amdgcn_sched_barrier(0);
                PEER_ISSUE(V8, k, e + RING);
                P10_FENCE();
            }
        }
        asm volatile("s_waitcnt vmcnt(0)" ::: "memory");
        P10_FENCE();
        const int cb = cb_of_row(t);
        float* orow = F.out + (size_t)t * DM + 32 * lane;
        const float* g2 = modf + (size_t)cb * 6 * DM + 5 * DM + 32 * lane; const float* fg = a_fing + 32 * lane;
        float ss = 0.f;
        const bf16_t* x1r = (const bf16_t*)(F.ws + WS_GF) + (size_t)t * DM + 32 * lane;
#pragma unroll
        for (int grp = 0; grp < 2; ++grp) {
            u32x4 xr[4]; f32x4 gv[8];
#pragma unroll
            for (int q = 0; q < 4; ++q) xr[q] = *(const GAS u32x4*)(x1r + 2048 * grp + 8 * q);
#pragma unroll
            for (int q = 0; q < 8; ++q) gv[q] = *(const GAS f32x4*)(g2 + 2048 * grp + 4 * q);
            __builtin_amdgcn_sched_barrier(0);
#pragma unroll
            for (int q = 0; q < 4; ++q) { f32x4 xa, xb; unpack8(xr[q], xa, xb);
#pragma unroll
                for (int i = 0; i < 4; ++i) { const float x2 = xa[i] + gv[2 * q][i] * ov[32 * grp + 8 * q + i]; ov[32 * grp + 8 * q + i] = x2; ss = fmaf(x2, x2, ss); }
#pragma unroll
                for (int i = 0; i < 4; ++i) { const float x2 = xb[i] + gv[2 * q + 1][i] * ov[32 * grp + 8 * q + 4 + i]; ov[32 * grp + 8 * q + 4 + i] = x2; ss = fmaf(x2, x2, ss); } }
        }
        const float rs = __builtin_amdgcn_rsqf(wave_sum_u(ss) * (1.f / DM) + EPS);
        if (dummy) { if (lane == 0) ((float*)(F.ws + WS_MODP))[t] = rs; }
        else {
#pragma unroll
        for (int grp = 0; grp < 2; ++grp) {
            f32x4 fv[8];
#pragma unroll
            for (int q = 0; q < 8; ++q) fv[q] = *(const GAS f32x4*)(fg + 2048 * grp + 4 * q);
            __builtin_amdgcn_sched_barrier(0);
#pragma unroll
            for (int q = 0; q < 8; ++q) { f32x4 y;
#pragma unroll
                for (int i = 0; i < 4; ++i) y[i] = ov[32 * grp + 4 * q + i] * rs * fv[q][i];
                *(GAS f32x4*)(orow + 2048 * grp + 4 * q) = y; }
        }
        }
        asm volatile("s_waitcnt vmcnt(0)" ::: "memory");
        P10_FENCE();
    }
#undef PEER_ISSUE
#undef PEER_WAIT
#undef PEER_RAW
#undef PEER_DEC_A
#undef PEER_DEC_B
#undef PEER_PIN_B
#undef P10_FENCE
}

#ifndef BM_LGNB
#define BM_LGNB 2
#endif
__device__ __forceinline__ void p10_peer_bm(Frame& F) { const bool dummy = false;
    const int lane = F.lane;
    const bf16_t* H = (const bf16_t*)(F.ws + WS_H);
    const unsigned char* U8 = F.ws + WS_U8; const unsigned char* V8 = F.ws + WS_V8;
    const float* SCU = (const float*)(F.ws + WS_SCU); const float* SCV = (const float*)(F.ws + WS_SCV);
    const int* IDX = (const int*)(F.ws + WS_IDX); const float* GATE = (const float*)(F.ws + WS_GATE);
    const float* modf = (const float*)(F.ws + WS_MODF); const float* const a_fing = karg(A_FING);
    constexpr int RING = 5;
    LAS unsigned char* const ring = F.lds + F.wave * 16384;
#define P10_FENCE() do { asm volatile("" ::: "memory"); __builtin_amdgcn_sched_barrier(0); } while (0)
#define PEER_ISSUE(TAB, slot, e) do { const int _e = (e) < NSEL ? (e) : NSEL - 1; const int _row = __builtin_amdgcn_readlane(_e < 64 ? i0 : i1, _e & 63); const char* _p = (const char*)(TAB) + (size_t)_row * PROW + 16 * lane; \
        _Pragma("unroll") for (int _s = 0; _s < 3; ++_s) __builtin_amdgcn_global_load_lds((const unsigned*)(_p + 1024 * _s), (LAS unsigned*)(ring + (slot) * PROW + 1024 * _s), 16, 0, 0); } while (0)
#define PEER_WAIT() asm volatile("s_waitcnt vmcnt(12)" ::: "memory")
#define PEER_RAW(slot) u32x4 _w0 = *(const LAS u32x4*)(ring + (slot) * PROW + 16 * lane), _w1 = *(const LAS u32x4*)(ring + (slot) * PROW + 1024 + 16 * lane), _w2 = *(const LAS u32x4*)(ring + (slot) * PROW + 2048 + 16 * lane)
#define PEER_DEC_A() __builtin_amdgcn_cvt_scalef32_pk32_f32_fp6((u32x6){_w0.x, _w0.y, _w0.z, _w0.w, _w1.x, _w1.y}, 1.0f)
#define PEER_DEC_B() __builtin_amdgcn_cvt_scalef32_pk32_f32_fp6((u32x6){_w1.z, _w1.w, _w2.x, _w2.y, _w2.z, _w2.w}, 1.0f)
#define PEER_PIN_B() asm volatile("" : "+v"(_w1.z), "+v"(_w1.w), "+v"(_w2.x), "+v"(_w2.y), "+v"(_w2.z), "+v"(_w2.w))
    float* const Zb = (float*)(F.ws + WS_Q + (size_t)96 * MiB);
    {
      const int tbase = F.vcu * NWAVES + F.wave, tstride = F.G * NWAVES, ntk = (TT - tbase + tstride - 1) / tstride;
      LAS float* const zl = (LAS float*)(ring + 3 * PROW);
      const int nunits = (1 << BM_LGNB) * ntk;
      int ci0, ci1; u32x4 craw[8];
#define BM_LOAD(u) do { const int _t = tbase + ((u) % ntk) * tstride; ci0 = IDX[(size_t)_t * NSEL + lane]; ci1 = IDX[(size_t)_t * NSEL + 64 + lane]; \
        _Pragma("unroll") for (int _g = 0; _g < 2; ++_g) { const GAS u32x4* _hp = (const GAS u32x4*)(H + (size_t)_t * DM + _g * 2048 + 32 * lane); \
          _Pragma("unroll") for (int _q = 0; _q < 4; ++_q) craw[4 * _g + _q] = _hp[_q]; } } while (0)
      BM_LOAD(0);
      for (int u = 0; u < nunits; ++u) {
        const int bkt = u / ntk, k = u - bkt * ntk;
        asm volatile("s_waitcnt vmcnt(0)" ::: "memory");
        P10_FENCE();
        const int i0 = ci0, i1 = ci1;
        float hv[64];
#pragma unroll
        for (int q = 0; q < 8; ++q) { f32x4 x, y; unpack8(craw[q], x, y); const int o = 8 * q;
            hv[o + 0] = x.x; hv[o + 1] = x.y; hv[o + 2] = x.z; hv[o + 3] = x.w; hv[o + 4] = y.x; hv[o + 5] = y.y; hv[o + 6] = y.z; hv[o + 7] = y.w; }
        asm volatile("" : "+v"(hv[0]), "+v"(hv[63]));
        P10_FENCE();
        if (u + 1 < nunits) BM_LOAD(u + 1);
        P10_FENCE();
        unsigned long long m0 = __ballot((i0 >> (14 - BM_LGNB)) == bkt), m1 = __ballot((i1 >> (14 - BM_LGNB)) == bkt);
        const int n = __popcll(m0) + __popcll(m1);
        const unsigned long long s0 = m0, s1 = m1;
#define BM_NEXT(M0, M1, E) do { if (M0) { E = (int)__builtin_ctzll(M0); M0 &= M0 - 1ull; } else { E = 64 + (int)__builtin_ctzll(M1); M1 &= M1 - 1ull; } } while (0)
#define BM_ISSUE(sidx) do { int _e; BM_NEXT(m0, m1, _e); const int _row = __builtin_amdgcn_readlane(_e < 64 ? i0 : i1, _e & 63); const char* _p = (const char*)U8 + (size_t)_row * PROW + 16 * lane; \
        LAS unsigned char* _d = ring + (sidx) * PROW; \
        _Pragma("unroll") for (int _s = 0; _s < 3; ++_s) __builtin_amdgcn_global_load_lds((const unsigned*)(_p + 1024 * _s), (LAS unsigned*)(_d + 1024 * _s), 16, 0, 0); } while (0)
        unsigned long long c0 = s0, c1 = s1;
        float z0 = 0.f, z1 = 0.f;
        int issued = 0;
        { const int n0 = n < 3 ? n : 3; for (; issued < n0; ++issued) BM_ISSUE(issued); }
        P10_FENCE();
        int sidx = 0;
        for (int done = 0; done < n; ++done) {
            const int infl = issued - done - 1;
            if (infl >= 2) asm volatile("s_waitcnt vmcnt(6)" ::: "memory"); else if (infl == 1) asm volatile("s_waitcnt vmcnt(3)" ::: "memory"); else asm volatile("s_waitcnt vmcnt(0)" ::: "memory");
            float p0 = 0.f, p1 = 0.f, p2 = 0.f, p3 = 0.f;
            PEER_RAW(sidx);
            { const f32x32 d = PEER_DEC_A();
#pragma unroll
              for (int i = 0; i < 8; ++i) { p0 = fmaf(hv[i], d[i], p0); p1 = fmaf(hv[8 + i], d[8 + i], p1); p2 = fmaf(hv[16 + i], d[16 + i], p2); p3 = fmaf(hv[24 + i], d[24 + i], p3); } }
            asm volatile("" : "+v"(p0), "+v"(p1), "+v"(p2), "+v"(p3)); PEER_PIN_B(); __builtin_amdgcn_sched_barrier(0);
            { const f32x32 d = PEER_DEC_B();
#pragma unroll
              for (int i = 0; i < 8; ++i) { p0 = fmaf(hv[32 + i], d[i], p0); p1 = fmaf(hv[40 + i], d[8 + i], p1); p2 = fmaf(hv[48 + i], d[16 + i], p2); p3 = fmaf(hv[56 + i], d[24 + i], p3); } }
            float pz = (p0 + p1) + (p2 + p3);
            asm volatile("" : "+v"(pz) :: "memory"); __builtin_amdgcn_sched_barrier(0);
            if (issued < n) { BM_ISSUE(sidx); ++issued; }
            P10_FENCE();
            const float z = wave_sum_u(pz);
            int e; BM_NEXT(c0, c1, e);
            z0 = (lane == e) ? z : z0; z1 = (lane == e - 64) ? z : z1;
            sidx = sidx == 2 ? 0 : sidx + 1;
        }
        if ((s0 >> lane) & 1ull) zl[k * 128 + lane] = z0;
        if ((s1 >> lane) & 1ull) zl[k * 128 + 64 + lane] = z1;
        P10_FENCE();
#undef BM_NEXT
#undef BM_ISSUE
      }
#undef BM_LOAD
      asm volatile("s_waitcnt vmcnt(0) lgkmcnt(0)" ::: "memory");
      for (int k = 0; k < ntk; ++k) { const int t = tbase + k * tstride; Zb[(size_t)t * NSEL + lane] = zl[k * 128 + lane]; Zb[(size_t)t * NSEL + 64 + lane] = zl[k * 128 + 64 + lane]; }
      asm volatile("s_waitcnt vmcnt(0)" ::: "memory");
      P10_FENCE();
    }
    for (int t = F.vcu * NWAVES + F.wave; t < TT; t += F.G * NWAVES) {
        int i0 = IDX[(size_t)t * NSEL + lane], i1 = IDX[(size_t)t * NSEL + 64 + lane];
        const float g0 = GATE[(size_t)t * NSEL + lane], g1 = GATE[(size_t)t * NSEL + 64 + lane];
        float z0 = Zb[(size_t)t * NSEL + lane], z1 = Zb[(size_t)t * NSEL + 64 + lane];
        const float su0 = SCU[i0], su1 = SCU[i1], sv0 = SCV[i0], sv1 = SCV[i1];
        z0 *= su0; z1 *= su1;
        float a0 = 0.5f * z0 * (1.f + erff(z0 * 0.70710678118654752f)) * g0 * sv0, a1 = 0.5f * z1 * (1.f + erff(z1 * 0.70710678118654752f)) * g1 * sv1;
        sort128_by_id(i0, a0, i1, a1, lane);
        asm volatile("s_waitcnt vmcnt(0)" ::: "memory");
        P10_FENCE();
        float ov[64];
#pragma unroll
        for (int i = 0; i < 64; ++i) ov[i] = 0.f;
#pragma unroll
        for (int k = 0; k < RING; ++k) PEER_ISSUE(V8, k, k);
        P10_FENCE();
        for (int e0 = 0; e0 < NSEL + RING - 1; e0 += RING) {
#pragma unroll
            for (int k = 0; k < RING; ++k) {
                const int e = e0 + k;
                float w = __builtin_bit_cast(float, __builtin_amdgcn_readlane(__builtin_bit_cast(int, e < 64 ? a0 : a1), e & 63));
                w = e < NSEL ? w : 0.f;
                PEER_WAIT();
                PEER_RAW(k);
                { const f32x32 d = PEER_DEC_A();
#pragma unroll
                  for (int i = 0; i < 32; ++i) asm("v_fmac_f32_e32 %0, %1, %2" : "+v"(ov[i]) : "v"(w), "v"(d[i])); }
                asm volatile("" : "+v"(ov[31]), "+v"(ov[15])); PEER_PIN_B(); __builtin_amdgcn_sched_barrier(0);
                { const f32x32 d = PEER_DEC_B();
#pragma unroll
                  for (int i = 0; i < 32; ++i) asm("v_fmac_f32_e32 %0, %1, %2" : "+v"(ov[32 + i]) : "v"(w), "v"(d[i])); }
                asm volatile("" : "+v"(ov[31]), "+v"(ov[63]) :: "memory"); __builtin_amdgcn_sched_barrier(0);
                PEER_ISSUE(V8, k, e + RING);
                P10_FENCE();
            }
        }
        asm volatile("s_waitcnt vmcnt(0)" ::: "memory");
        P10_FENCE();
        const int cb = cb_of_row(t);
        float* orow = F.out + (size_t)t * DM + 32 * lane;
        const float* g2 = modf + (size_t)cb * 6 * DM + 5 * DM + 32 * lane; const float* fg = a_fing + 32 * lane;
        float ss = 0.f;
        const bf16_t* x1r = (const bf16_t*)(F.ws + WS_GF) + (size_t)t * DM + 32 * lane;
#pragma unroll
        for (int grp = 0; grp < 2; ++grp) {
            u32x4 xr[4]; f32x4 gv[8];
#pragma unroll
            for (int q = 0; q < 4; ++q) xr[q] = *(const GAS u32x4*)(x1r + 2048 * grp + 8 * q);
#pragma unroll
            for (int q = 0; q < 8; ++q) gv[q] = *(const GAS f32x4*)(g2 + 2048 * grp + 4 * q);
            __builtin_amdgcn_sched_barrier(0);
#pragma unroll
            for (int q = 0; q < 4; ++q) { f32x4 xa, xb; unpack8(xr[q], xa, xb);
#pragma unroll
                for (int i = 0; i < 4; ++i) { const float x2 = xa[i] + gv[2 * q][i] * ov[32 * grp + 8 * q + i]; ov[32 * grp + 8 * q + i] = x2; ss = fmaf(x2, x2, ss); }
#pragma unroll
                for (int i = 0; i < 4; ++i) { const float x2 = xb[i] + gv[2 * q + 1][i] * ov[32 * grp + 8 * q + 4 + i]; ov[32 * grp + 8 * q + 4 + i] = x2; ss = fmaf(x2, x2, ss); } }
        }
        const float rs = __builtin_amdgcn_rsqf(wave_sum_u(ss) * (1.f / DM) + EPS);
        if (dummy) { if (lane == 0) ((float*)(F.ws + WS_MODP))[t] = rs; }
        else {
#pragma unroll
        for (int grp = 0; grp < 2; ++grp) {
            f32x4 fv[8];
#pragma unroll
            for (int q = 0; q < 8; ++q) fv[q] = *(const GAS f32x4*)(fg + 2048 * grp + 4 * q);
            __builtin_amdgcn_sched_barrier(0);
#pragma unroll
            for (int q = 0; q < 8; ++q) { f32x4 y;
#pragma unroll
                for (int i = 0; i < 4; ++i) y[i] = ov[32 * grp + 4 * q + i] * rs * fv[q][i];
                *(GAS f32x4*)(orow + 2048 * grp + 4 * q) = y; }
        }
        }
        asm volatile("s_waitcnt vmcnt(0)" ::: "memory");
        P10_FENCE();
    }
#undef PEER_ISSUE
#undef PEER_WAIT
#undef PEER_RAW
#undef PEER_DEC_A
#undef PEER_DEC_B
#undef PEER_PIN_B
#undef P10_FENCE
}

#ifdef PEER_REF_PROBE
__device__ __forceinline__ void p10_peer_ref(Frame& F) {
    const int lane = F.lane;
    const bf16_t* H = (const bf16_t*)(F.ws + WS_H);
    const int* IDX = (const int*)(F.ws + WS_IDX); const float* GATE = (const float*)(F.ws + WS_GATE);
    const float* modf = (const float*)(F.ws + WS_MODF); const float* const a_fing = karg(A_FING); const float* const a_pu = karg(A_PU); const float* const a_pv = karg(A_PV);
    for (int t = F.vcu * NWAVES + F.wave; t < TT; t += F.G * NWAVES) {
        const int i0 = IDX[(size_t)t * NSEL + lane], i1 = IDX[(size_t)t * NSEL + 64 + lane];
        const float g0 = GATE[(size_t)t * NSEL + lane], g1 = GATE[(size_t)t * NSEL + 64 + lane];
        float hv[64];
#pragma unroll
        for (int grp = 0; grp < 2; ++grp) { const GAS u32x4* hp = (const GAS u32x4*)(H + (size_t)t * DM + grp * 2048 + 32 * lane);
#pragma unroll
            for (int q = 0; q < 4; ++q) { const u32x4 w = hp[q]; f32x4 a, b; unpack8(w, a, b); const int o = 32 * grp + 8 * q;
                hv[o + 0] = a.x; hv[o + 1] = a.y; hv[o + 2] = a.z; hv[o + 3] = a.w; hv[o + 4] = b.x; hv[o + 5] = b.y; hv[o + 6] = b.z; hv[o + 7] = b.w; } }
        float z0 = 0.f, z1 = 0.f;
        for (int e = 0; e < NSEL; ++e) {
            const int row = __builtin_amdgcn_readlane(e < 64 ? i0 : i1, e & 63); const float* up = a_pu + (size_t)row * DM + 32 * lane; float part = 0.f;
#pragma unroll
            for (int grp = 0; grp < 2; ++grp)
#pragma unroll
                for (int q = 0; q < 8; ++q) { const f32x4 u = *(const GAS f32x4*)(up + 2048 * grp + 4 * q);
#pragma unroll
                    for (int i = 0; i < 4; ++i) part = fmaf(hv[32 * grp + 4 * q + i], u[i], part); }
            const float z = wave_sum_u(part);
            z0 = (lane == e) ? z : z0; z1 = (lane == e - 64) ? z : z1;
        }
        const float a0 = 0.5f * z0 * (1.f + erff(z0 * 0.70710678118654752f)) * g0, a1 = 0.5f * z1 * (1.f + erff(z1 * 0.70710678118654752f)) * g1;
        float ov[64];
#pragma unroll
        for (int i = 0; i < 64; ++i) ov[i] = 0.f;
        for (int e = 0; e < NSEL; ++e) {
            const int row = __builtin_amdgcn_readlane(e < 64 ? i0 : i1, e & 63); const float* vp = a_pv + (size_t)row * DM + 32 * lane;
            const float w = __builtin_bit_cast(float, __builtin_amdgcn_readlane(__builtin_bit_cast(int, e < 64 ? a0 : a1), e & 63));
#pragma unroll
            for (int grp = 0; grp < 2; ++grp)
#pragma unroll
                for (int q = 0; q < 8; ++q) { const f32x4 v = *(const GAS f32x4*)(vp + 2048 * grp + 4 * q);
#pragma unroll
                    for (int i = 0; i < 4; ++i) asm("v_fmac_f32_e32 %0, %1, %2" : "+v"(ov[32 * grp + 4 * q + i]) : "v"(w), "v"(v[i])); }
        }
        const int cb = cb_of_row(t);
        float* orow = F.out + (size_t)t * DM + 32 * lane;
        const float* g2 = modf + (size_t)cb * 6 * DM + 5 * DM + 32 * lane; const float* fg = a_fing + 32 * lane;
        float ss = 0.f;
#pragma unroll
        for (int grp = 0; grp < 2; ++grp)
#pragma unroll
            for (int q = 0; q < 8; ++q) { const f32x4 gv = *(const GAS f32x4*)(g2 + 2048 * grp + 4 * q); const bf16_t* xb = (const bf16_t*)(F.ws + WS_GF) + (size_t)t * DM + 32 * lane + 2048 * grp + 4 * q;
#pragma unroll
                for (int i = 0; i < 4; ++i) { const float x2 = __uint_as_float((unsigned)xb[i] << 16) + gv[i] * ov[32 * grp + 4 * q + i]; ov[32 * grp + 4 * q + i] = x2; ss = fmaf(x2, x2, ss); } }
        const float rs = __builtin_amdgcn_rsqf(wave_sum_u(ss) * (1.f / DM) + EPS);
#pragma unroll
        for (int grp = 0; grp < 2; ++grp)
#pragma unroll
            for (int q = 0; q < 8; ++q) { const f32x4 fv = *(const GAS f32x4*)(fg + 2048 * grp + 4 * q); f32x4 y;
#pragma unroll
                for (int i = 0; i < 4; ++i) y[i] = ov[32 * grp + 4 * q + i] * rs * fv[i];
                *(GAS f32x4*)(orow + 2048 * grp + 4 * q) = y; }
    }
}
#endif

#ifndef DUP_PHASE
#define DUP_PHASE -1
#endif
#define DUP(k) for (int _rep = 0; _rep < ((DUP_PHASE == (k)) ? 2 : 1); ++_rep)
#ifndef MK_N_LAUNCHES
#define MK_N_LAUNCHES 1
#endif
constexpr int N_PHASES = 12;
struct Args { const float* in[19]; float* out; unsigned char* ws; int ph_lo, ph_hi; };
__global__ void __launch_bounds__(NWAVES * 64, 2) fwd(Args args) {
    extern __shared__ __attribute__((aligned(16))) unsigned char lds[];
    Frame F;
    F.lds = (LAS unsigned char*)lds;
    F.tid = threadIdx.x; F.lane = F.tid & 63; F.wave = __builtin_amdgcn_readfirstlane(F.tid >> 6);
    F.G = gridDim.x; { const int bx = blockIdx.x; F.vcu = (F.G % 8 == 0) ? (bx % 8) * (F.G / 8) + bx / 8 : bx; }
    F.out = args.out; F.ws = args.ws;
    unsigned char* ws = args.ws;
    volatile LAS unsigned* MISC = (volatile LAS unsigned*)(F.lds + MISC_OFF);
    if (F.tid < 32) MISC[F.tid] = 0u;
    __syncthreads();
    const int lo = args.ph_lo, hi = args.ph_hi;
    XcdBarrier bar; bar.bar = (unsigned*)(ws + WS_CTL) + CW_BAR; bar.x = 0; bar.st = nullptr;
    if (hi - lo > 1) bar = xcd_barrier_post((unsigned*)(ws + WS_CTL) + CW_BAR, MISC + 8, F.tid);
#ifdef ONLY_PHASE
#define IN(k) ((k) == ONLY_PHASE && lo <= (k) && (k) < hi)
#else
#define IN(k) (lo <= (k) && (k) < hi)
#endif
#define SEAM(k) do { if (IN(k) && IN((k) + 1)) { xcd_barrier(bar, opaque_tid(F.wave)); } } while (0)
    bf16_t* const Hb = (bf16_t*)(ws + WS_H); bf16_t* const Qb = (bf16_t*)(ws + WS_Q); bf16_t* const Fb = (bf16_t*)(ws + WS_F);
    bf16_t* const GAb = (bf16_t*)(ws + WS_GA); bf16_t* const GFb = (bf16_t*)(ws + WS_GF);
    bf16_t* const L0P = Hb; bf16_t* const L0S = Hb + (size_t)2 * NFG * FG * (2 * SP);
    unsigned char* const M8 = ws + WS_H + (size_t)96 * MiB;
    bf16_t* const L1P = (bf16_t*)(ws + WS_L1); bf16_t* const L1S = L1P + (size_t)2 * NFG * FG * (2 * SP);

#define REFRESH() do { F.tid = opaque_tid(F.wave); F.lane = F.tid & 63; } while (0)
    if (IN(0)) { REFRESH(); p0_prologue(F); if (DUP_PHASE == 0) { __syncthreads(); REFRESH(); p0_prologue(F); } } SEAM(0);
    if (IN(1)) { DUP(1) { REFRESH(); p_normmod<false>(F); } } SEAM(1);
    if (IN(2)) {
        pg8::GemmPlain g{Hb, (const bf16_t*)(ws + WS_WIN), DM / 2, DM / 2, DM / 2}; pg8::StaticOrder S; S.init(TT, NIN, F.G, (int)blockIdx.x);
        EpiProj E{ws}; DUP(2) pg8::gemm_phase<EpiProj, pg8::GemmPlain, true, true, true>(F.lds, g, S, E, F.wave);
    } SEAM(2);
    if (IN(3)) {
        REFRESH(); p3_qk_rope(F);
#if ATTN_FP8
        REFRESH(); p3_vt(F);
#endif
        if (blockIdx.x == 0 && F.tid < 128) ((unsigned*)(ws + WS_L1 + (size_t)192 * MiB))[F.tid] = 0u;
        int kc_ = FG; asm volatile("" : "+s"(kc_));
        DUP(3) {
        { GemmSt0 g{(const bf16_t*)(ws + WS_CS), Fb, kc_, FG, FW, 32, 5, 4, 0, SP}; pg8::StaticOrder S; S.init(512, NFG * TP, F.G, (int)blockIdx.x);
          EpiSt0 E{L0P, 32, 5, 4}; pg8::gemm_phase<EpiSt0, GemmSt0>(F.lds, g, S, E, F.wave); }
        { GemmSt0 g{(const bf16_t*)(ws + WS_CS), Fb, kc_, FG, FW, 64, 6, 5, TP, SS}; pg8::StaticOrder S; S.init(512, NFG * TS, F.G, (int)blockIdx.x);
          EpiSt0 E{L0S, 64, 6, 5}; pg8::gemm_phase<EpiSt0, GemmSt0>(F.lds, g, S, E, F.wave); }
        }
    } SEAM(3);
    if (IN(4)) {
        int kc_ = 256; asm volatile("" : "+s"(kc_));
        pg8::GemmPlain g{(const bf16_t*)(ws + WS_D128), L0P, kc_, 256, 256}; pg8::StaticOrder S; S.init(256, 2 * NFG * FG * (32 + 64), F.G, (int)blockIdx.x);
        EpiSt1 E{L1P, L1S}; DUP(4) pg8::gemm_phase<EpiSt1, pg8::GemmPlain>(F.lds, g, S, E, F.wave);
    } SEAM(4);
    if (IN(5)) {
        int kc_ = 128; asm volatile("" : "+s"(kc_));
        DUP(51) {
        { pg8::GemmPlain g{(const bf16_t*)(ws + WS_DS32), L1P, kc_, 256, 64}; pg8::StaticOrder S; S.init(256, 2 * NFG * 128 * FG, F.G, (int)blockIdx.x);
          EpiSt2 E{(unsigned char*)Fb, 32, SP, 0.015625f}; pg8::gemm_phase<EpiSt2, pg8::GemmPlain>(F.lds, g, S, E, F.wave); }
        { pg8::GemmPlain g{(const bf16_t*)(ws + WS_DS64), L1S, kc_, 256, 128}; pg8::StaticOrder S; S.init(256, 2 * NFG * 128 * FG, F.G, (int)blockIdx.x);
          EpiSt2 E{(unsigned char*)Fb + (size_t)TP * FW, 64, SS, 0.011048543456039806f}; pg8::gemm_phase<EpiSt2, pg8::GemmPlain>(F.lds, g, S, E, F.wave); }
        }
        if (DUP_PHASE == 50) { REFRESH(); p4_attention(F, (char*)lds, true); }
        REFRESH(); p4_attention(F, (char*)lds, false);
    } SEAM(5);
    if (IN(6)) {
        { pg8::GemmPlain g{Hb, (const bf16_t*)(ws + WS_WATT), DM / 2, DM / 2, DM / 2}; pg8::StaticOrder S; S.init(TT, DM, F.G, (int)blockIdx.x);
          EpiGateA E{GAb, ws + WS_GA8, (const float*)(ws + WS_SCIN) + 1}; pg8::gemm_phase<EpiGateA, pg8::GemmPlain, true, true, true>(F.lds, g, S, E, F.wave); }
        { pg8::GemmPlain g{Fb, (const bf16_t*)(ws + WS_WFOUR), FW / 2, FW / 2, FW / 2}; pg8::StaticOrder S; S.init(TT, DM, F.G, (int)blockIdx.x);
          EpiGateF E{GAb, ws + WS_GF, M8, (const float*)(ws + WS_SCIN) + 3}; pg8::gemm_phase<EpiGateF, pg8::GemmPlain, true, true, true>(F.lds, g, S, E, F.wave); }
    } SEAM(6);
    if (IN(7)) {
        pg8::GemmPlain g{(const bf16_t*)M8, (const bf16_t*)(ws + WS_WOUT), DM / 2, DM / 2, DM / 2}; pg8::StaticOrder S; S.init(TT, DM, F.G, (int)blockIdx.x);
        EpiResid E{karg(A_XP), karg(A_XS), (const float*)(ws + WS_MODF), GFb, (const float*)(ws + WS_SCIN) + 2}; DUP(7) pg8::gemm_phase<EpiResid, pg8::GemmPlain, true, true, true>(F.lds, g, S, E, F.wave);
    } SEAM(7);
    if (IN(8)) { REFRESH(); p_normmod<true>(F); } SEAM(8);
    if (IN(9)) {
        pg8::GemmPlain g{Hb, (const bf16_t*)(ws + WS_WPQ), DM, DM, DM}; pg8::StaticOrder S; S.init(TT, PQW, F.G, (int)blockIdx.x);
        EpiPlain E{Qb, PQW}; DUP(9) pg8::gemm_phase<EpiPlain, pg8::GemmPlain>(F.lds, g, S, E, F.wave);
    } SEAM(9);
    if (IN(10)) { DUP(10) { REFRESH(); p9_route(F); } } SEAM(10);
#ifdef PEER_REF_PROBE
    if (IN(11)) { REFRESH(); p10_peer_ref(F); }
#else
    if (IN(11)) { if (DUP_PHASE == 11) { REFRESH(); p10_peer(F, true); } REFRESH(); p10_peer_bm(F); }
#endif
#undef IN
#undef SEAM
}

extern "C" void kernel_launch(void* const* d_in, const int* in_sizes, int n_in, void* d_out, int out_size, void* d_ws, size_t ws_size, hipStream_t stream) {
    static int grid = 0;
    if (grid == 0) {
        if (n_in != 19 || in_sizes[0] != TP * DM || in_sizes[1] != TS * DM || out_size != TT * DM || ws_size < WS_END) {
            fprintf(stderr, "kernel_launch: unexpected shapes: n_in %d in0 %d in1 %d out %d ws %zu (need %zu); nothing launched\n", n_in, n_in > 0 ? in_sizes[0] : -1, n_in > 1 ? in_sizes[1] : -1, out_size, ws_size, (size_t)WS_END); grid = -1; return; }
        int dev = 0, cus = 0, per_cu = 0;
        if (hipGetDevice(&dev) != hipSuccess || hipDeviceGetAttribute(&cus, hipDeviceAttributeMultiprocessorCount, dev) != hipSuccess) { grid = -1; return; }
        if (hipFuncSetAttribute((const void*)fwd, hipFuncAttributeMaxDynamicSharedMemorySize, LDS_BYTES) != hipSuccess) { fprintf(stderr, "kernel_launch: hipFuncSetAttribute failed\n"); grid = -1; return; }
        if (hipOccupancyMaxActiveBlocksPerMultiprocessor(&per_cu, (const void*)fwd, NWAVES * 64, LDS_BYTES) != hipSuccess || per_cu < 1) { fprintf(stderr, "kernel_launch: occupancy query says %d workgroups per CU\n", per_cu); (void)hipGetLastError(); grid = -1; return; }
        grid = cus;
    }
    if (grid < 0) return;
    if (hipMemsetAsync((char*)d_ws + WS_CTL, 0, CTL_ZERO_BYTES, stream) != hipSuccess) return;
    Args a{};
    for (int i = 0; i < 19; ++i) a.in[i] = (const float*)d_in[i];
    a.out = (float*)d_out; a.ws = (unsigned char*)d_ws;
#if MK_N_LAUNCHES == 1
    a.ph_lo = 0; a.ph_hi = N_PHASES;
    hipLaunchKernelGGL(fwd, dim3(grid), dim3(NWAVES * 64), LDS_BYTES, stream, a);
#else
    for (int p = 0; p < N_PHASES; ++p) { a.ph_lo = p; a.ph_hi = p + 1; hipLaunchKernelGGL(fwd, dim3(grid), dim3(NWAVES * 64), LDS_BYTES, stream, a); }
#endif
}
```

```cpp
#include <hip/hip_runtime.h>
#include <hip/hip_bf16.h>
#include <cstdio>
#include <cstdint>

#define GAS __attribute__((address_space(1)))
#define LAS __attribute__((address_space(3)))
typedef unsigned short bf16_t;
typedef short bf16x8 __attribute__((ext_vector_type(8)));
typedef short s16x4 __attribute__((ext_vector_type(4)));
typedef float f32x2 __attribute__((ext_vector_type(2)));
typedef float f32x4 __attribute__((ext_vector_type(4)));
typedef float f32x16 __attribute__((ext_vector_type(16)));
typedef unsigned u32x2 __attribute__((ext_vector_type(2)));
typedef unsigned u32x4 __attribute__((ext_vector_type(4)));
typedef unsigned u32x6 __attribute__((ext_vector_type(6)));
typedef int i32x8 __attribute__((ext_vector_type(8)));
typedef float f32x32 __attribute__((ext_vector_type(32)));

constexpr int DM = 4096;
constexpr int SP = 4096, SS = 8192;
constexpr int TP = 2 * SP, TS = 2 * SS, TT = TP + TS;
constexpr int NIN = 16384;
constexpr int HD = 128, NH = 32, NKV = 8;
constexpr int FW = 2048, FG = 256, NFG = 8;
constexpr int PH = 8, PNK = 128, PHALF = 128, PTOPK = 16, PQW = 2048, NSEL = 128, PN = 16384;
constexpr float EPS = 1e-6f;
constexpr int PROW = 3072;

__device__ __forceinline__ int cb_of_row(int m) { return m < SP ? 0 : (m < TP ? 1 : (m < TP + SS ? 2 : 3)); }

__device__ __forceinline__ unsigned cvt_pk_bf16(float lo, float hi) { unsigned r; asm volatile("v_cvt_pk_bf16_f32 %0, %1, %2" : "=v"(r) : "v"(lo), "v"(hi)); return r; }
__device__ __forceinline__ float bf_lo(unsigned w) { return __uint_as_float(w << 16); }
__device__ __forceinline__ float bf_hi(unsigned w) { return __uint_as_float(w & 0xffff0000u); }
__device__ __forceinline__ u32x4 pack8(f32x4 v0, f32x4 v1) { u32x4 w; w.x = cvt_pk_bf16(v0[0], v0[1]); w.y = cvt_pk_bf16(v0[2], v0[3]); w.z = cvt_pk_bf16(v1[0], v1[1]); w.w = cvt_pk_bf16(v1[2], v1[3]); return w; }
__device__ __forceinline__ void unpack8(u32x4 w, f32x4& v0, f32x4& v1) { v0 = (f32x4){bf_lo(w.x), bf_hi(w.x), bf_lo(w.y), bf_hi(w.y)}; v1 = (f32x4){bf_lo(w.z), bf_hi(w.z), bf_lo(w.w), bf_hi(w.w)}; }
__device__ __forceinline__ void unpack8_fp8(u32x2 w, f32x4& v0, f32x4& v1) {
    const f32x2 a = __builtin_amdgcn_cvt_pk_f32_fp8((int)w.x, false), b = __builtin_amdgcn_cvt_pk_f32_fp8((int)w.x, true);
    const f32x2 c = __builtin_amdgcn_cvt_pk_f32_fp8((int)w.y, false), d = __builtin_amdgcn_cvt_pk_f32_fp8((int)w.y, true);
    v0 = (f32x4){a[0], a[1], b[0], b[1]}; v1 = (f32x4){c[0], c[1], d[0], d[1]}; }
__device__ __forceinline__ void unpack8_u8(u32x2 w, f32x4& v0, f32x4& v1) {
    v0 = (f32x4){(float)(w.x & 0xffu), (float)((w.x >> 8) & 0xffu), (float)((w.x >> 16) & 0xffu), (float)(w.x >> 24)};
    v1 = (f32x4){(float)(w.y & 0xffu), (float)((w.y >> 8) & 0xffu), (float)((w.y >> 16) & 0xffu), (float)(w.y >> 24)}; }
__device__ __forceinline__ u32x2 pack8_u8(f32x4 y0, f32x4 y1) {
    unsigned w0 = 0u, w1 = 0u;
#pragma unroll
    for (int i = 0; i < 4; ++i) { w0 = __builtin_amdgcn_cvt_pk_u8_f32(y0[i], (unsigned)i, w0); w1 = __builtin_amdgcn_cvt_pk_u8_f32(y1[i], (unsigned)i, w1); }
    return (u32x2){w0, w1}; }
__device__ __forceinline__ float sigmoidf_(float v) { return __builtin_amdgcn_rcpf(1.0f + __builtin_amdgcn_exp2f(-1.4426950408889634f * v)); }

__device__ __forceinline__ int opaque_tid(const int wave) { int l = (int)__builtin_amdgcn_mbcnt_hi(~0u, __builtin_amdgcn_mbcnt_lo(~0u, 0u)); asm volatile("" : "+v"(l)); return (wave << 6) | l; }

namespace pg8 {
#define PG8_LAS __attribute__((address_space(3)))
constexpr int BM = 256, BK = 64, HALF = 128, HTB = HALF * BK * 2  , STAGE_BYTES = 8 * HTB, NXCD = 8, WGM = 8;

__host__ __device__ __forceinline__ int lds_byte(int r, int c) { const int st = (r >> 4) * 2 + (c >> 5), rr = r & 15, cc = c & 31, ob = rr * 64 + cc * 2; return st * 1024 + (ob ^ (((ob >> 9) & 1) << 5)); }
__host__ __device__ __forceinline__ void stage_rc(int b, int& R, int& C) { const int st = b / 1024, sb = b % 1024, swz = sb ^ (((sb >> 9) & 1) << 5); R = (st >> 1) * 16 + swz / 64; C = (st & 1) * 32 + (swz % 64) / 2; }
__host__ __device__ __forceinline__ int perm32(int rho) { const int n = rho >> 4, i = rho & 15; return 8 * (i >> 2) + 4 * n + (i & 3); }

struct Unit { int pm, pn; };

struct StaticOrder {
    int nM, nN, nwg, G, c;
    __host__ __device__ void init(int M, int N, int G_, int c_) { nM = M / BM; nN = N / BM; nwg = nM * nN; G = G_; c = c_; }
    __host__ __device__ bool next(int i, Unit& u) const {
        const long L = (long)i * G + c; if (L >= nwg) return false;
        int wgid = (int)L; { const int q = nwg / NXCD, r = nwg % NXCD, xcd = wgid % NXCD, off = wgid / NXCD; wgid = (xcd < r ? xcd * (q + 1) : r * (q + 1) + (xcd - r) * q) + off; }
        const int nig = WGM * nN, gid = wgid / nig, fm = gid * WGM, gsz = (nM - fm) < WGM ? (nM - fm) : WGM;
        u.pm = fm + ((wgid % nig) % gsz); u.pn = (wgid % nig) / gsz; return true;
    }
};

struct GemmPlain {
    const bf16_t* A; const bf16_t* Bt; int K, lda, ldb;
    __device__ __forceinline__ const char* a_ptr(const Unit& u) const { return (const char*)A + (size_t)u.pm * BM * lda * 2; }
    __device__ __forceinline__ const char* b_ptr(const Unit& u) const { return (const char*)Bt + (size_t)u.pn * BM * ldb * 2; }
    __device__ __forceinline__ int b_rowoff(int Rb) const { return Rb; }
    __device__ __forceinline__ size_t b_hstep() const { return (size_t)HALF * ldb * 2; }
};

template <class Epi, class Ops, bool ALIGN_EPI = true, bool SP2 = true, bool FP8 = false>
__device__ __forceinline__ void gemm_phase(PG8_LAS unsigned char* lds, const Ops g, const StaticOrder& S, const Epi& E, const int wave) {
    const int tid = opaque_tid(wave), wid = wave, lane = tid & 63, wr = wid >> 2, wc = wid & 3, fr = lane & 15, fq = lane >> 4;
    const int K = g.K, nt = K / BK;
    unsigned voffA[2], voffB[2];
#pragma unroll
    for (int i = 0; i < 2; ++i) { int R, C; stage_rc(tid * 16 + i * 8192, R, C); const int Rb = ((R & ~31) + perm32(R & 31));
        voffA[i] = (unsigned)(R * g.lda + C) * 2u; voffB[i] = (unsigned)(g.b_rowoff(Rb) * g.ldb + C) * 2u; }
    const size_t kstep = (size_t)(BK * 2);
    const size_t hstepA = (size_t)HALF * g.lda * 2, hstepB = g.b_hstep();
    const unsigned ldsw = (unsigned)wid * 1024u;
    const int aoff = FP8 ? lds_byte(wr * 64 + fr, 16 * fq) : lds_byte(wr * 64 + fr, fq * 8), boff = FP8 ? lds_byte(wc * 32 + fr, 16 * fq) : lds_byte(wc * 32 + fr, fq * 8);
    const int aoff1 = lds_byte(wr * 64 + fr, 16 * fq + 8), boff1 = lds_byte(wc * 32 + fr, 16 * fq + 8);
#define PG8_SA(b, h) (((b) * 2 + (h)) * HTB)
#define PG8_SB(b, h) ((4 + (b) * 2 + (h)) * HTB)
#define PG8_STAGE(bufoff, gbase, voff) do { _Pragma("unroll") for (int _i = 0; _i < 2; ++_i) \
        __builtin_amdgcn_global_load_lds((const unsigned*)((const char*)(gbase) + (voff)[_i]), (PG8_LAS unsigned*)(lds + (bufoff) + ldsw + _i * 8192), 16, 0, 0); } while (0)
#define PG8_LDA(dst, b, h) do { if constexpr (FP8) { _Pragma("unroll") for (int m = 0; m < 4; ++m) { const u32x4 _l = *(const PG8_LAS u32x4*)(lds + PG8_SA(b, h) + aoff + m * 2048), _h = *(const PG8_LAS u32x4*)(lds + PG8_SA(b, h) + aoff1 + m * 2048); \
            dst##8[m] = (i32x8){(int)_l.x, (int)_l.y, (int)_l.z, (int)_l.w, (int)_h.x, (int)_h.y, (int)_h.z, (int)_h.w}; } } \
        else { _Pragma("unroll") for (int m = 0; m < 4; ++m) _Pragma("unroll") for (int k = 0; k < 2; ++k) dst[m][k] = *(const PG8_LAS bf16x8*)(lds + PG8_SA(b, h) + aoff + m * 2048 + k * 1024); } } while (0)
#define PG8_LDB(dst, b, h) do { if constexpr (FP8) { _Pragma("unroll") for (int n = 0; n < 2; ++n) { const u32x4 _l = *(const PG8_LAS u32x4*)(lds + PG8_SB(b, h) + boff + n * 2048), _h = *(const PG8_LAS u32x4*)(lds + PG8_SB(b, h) + boff1 + n * 2048); \
            dst##8[n] = (i32x8){(int)_l.x, (int)_l.y, (int)_l.z, (int)_l.w, (int)_h.x, (int)_h.y, (int)_h.z, (int)_h.w}; } } \
        else { _Pragma("unroll") for (int n = 0; n < 2; ++n) _Pragma("unroll") for (int k = 0; k < 2; ++k) dst[n][k] = *(const PG8_LAS bf16x8*)(lds + PG8_SB(b, h) + boff + n * 2048 + k * 1024); } } while (0)
#define PG8_MMA(ai, bj, At, Bt) do { __builtin_amdgcn_s_setprio(1); if constexpr (FP8) { _Pragma("unroll") for (int m = 0; m < 4; ++m) _Pragma("unroll") for (int n = 0; n < 2; ++n) \
            asm volatile("v_mfma_scale_f32_16x16x128_f8f6f4 %0, %1, %2, %0, %3, %3 op_sel_hi:[0,0,0]" : "+v"(acc[ai][bj][m][n]) : "v"(Bt##8[n]), "v"(At##8[m]), "v"(one_scale)); } \
        else { _Pragma("unroll") for (int m = 0; m < 4; ++m) _Pragma("unroll") for (int n = 0; n < 2; ++n) _Pragma("unroll") for (int k = 0; k < 2; ++k) \
            acc[ai][bj][m][n] = __builtin_amdgcn_mfma_f32_16x16x32_bf16(Bt[n][k], At[m][k], acc[ai][bj][m][n], 0, 0, 0); } __builtin_amdgcn_s_setprio(0); } while (0)
#define PG8_WAIT_V(n) asm volatile("s_waitcnt vmcnt(" #n ")" ::: "memory")
#define PG8_WAIT_L(n) asm volatile("s_waitcnt lgkmcnt(" #n ")" ::: "memory")
#define PG8_BAR __builtin_amdgcn_s_barrier()
#define PG8_SCHED __builtin_amdgcn_sched_barrier(0)
    Unit cur, nxt; int ui = 0;
    if (!S.next(0, cur)) return;
    f32x4 acc[2][2][4][2];
#pragma unroll
    for (int a = 0; a < 2; ++a)
#pragma unroll
        for (int b = 0; b < 2; ++b)
#pragma unroll
            for (int m = 0; m < 4; ++m)
#pragma unroll
                for (int n = 0; n < 2; ++n) acc[a][b][m][n] = (f32x4){0.f, 0.f, 0.f, 0.f};
    bf16x8 At[4][2], B0[2][2], B1[2][2]; i32x8 At8[4], B08[2], B18[2];
    const int one_scale = 0x7F7F7F7F;
    const char* cA = g.a_ptr(cur); const char* cB = g.b_ptr(cur);
    if constexpr (SP2) {
        PG8_STAGE(PG8_SB(0, 0), cB, voffB); PG8_STAGE(PG8_SB(0, 1), cB + hstepB, voffB); PG8_STAGE(PG8_SA(0, 0), cA, voffA); PG8_STAGE(PG8_SA(0, 1), cA + hstepA, voffA);
        if (wr == 1) PG8_BAR;
        PG8_WAIT_V(2); PG8_BAR;
        PG8_STAGE(PG8_SB(1, 0), cB + kstep, voffB); PG8_STAGE(PG8_SA(1, 0), cA + kstep, voffA); PG8_STAGE(PG8_SB(1, 1), cB + hstepB + kstep, voffB);
        PG8_WAIT_V(6); PG8_BAR;
    } else {
        PG8_STAGE(PG8_SB(0, 0), cB, voffB); PG8_STAGE(PG8_SA(0, 0), cA, voffA); PG8_STAGE(PG8_SB(0, 1), cB + hstepB, voffB); PG8_STAGE(PG8_SA(0, 1), cA + hstepA, voffA);
        if (wr == 1) PG8_BAR;
        PG8_WAIT_V(4); PG8_BAR;
        PG8_STAGE(PG8_SB(1, 0), cB + kstep, voffB); PG8_STAGE(PG8_SA(1, 0), cA + kstep, voffA); PG8_STAGE(PG8_SB(1, 1), cB + hstepB + kstep, voffB);
        PG8_WAIT_V(6); PG8_BAR;
    }
    for (;;) {
        const bool has_next = S.next(ui + 1, nxt);
        const char* nA = has_next ? g.a_ptr(nxt) : cA; const char* nB = has_next ? g.b_ptr(nxt) : cB;
        for (int t = 0; t < nt; t += 2) {
            const bool last = (t == nt - 2);
            const char* a1 = cA + (size_t)(t + 1) * kstep;
            const char* a2 = last ? nA : cA + (size_t)(t + 2) * kstep; const char* b2 = last ? nB : cB + (size_t)(t + 2) * kstep;
            const char* a3 = a2 + kstep; const char* b3 = b2 + kstep;
            if constexpr (SP2) {
            PG8_LDB(B0, 0, 0); PG8_LDB(B1, 0, 1); PG8_SCHED; PG8_LDA(At, 0, 0); PG8_STAGE(PG8_SA(1, 1), a1 + hstepA, voffA);
            PG8_WAIT_V(8); PG8_WAIT_L(0); PG8_BAR; PG8_MMA(0, 0, At, B0); PG8_MMA(0, 1, At, B1); PG8_BAR; PG8_SCHED;
            PG8_LDA(At, 0, 1); PG8_STAGE(PG8_SB(0, 0), b2, voffB); PG8_STAGE(PG8_SB(0, 1), b2 + hstepB, voffB); PG8_STAGE(PG8_SA(0, 0), a2, voffA);
            PG8_WAIT_V(8); PG8_WAIT_L(0); PG8_BAR; PG8_MMA(1, 0, At, B0); PG8_MMA(1, 1, At, B1); PG8_BAR; PG8_SCHED;
            PG8_LDB(B0, 1, 0); PG8_LDB(B1, 1, 1); PG8_SCHED; PG8_LDA(At, 1, 0); PG8_STAGE(PG8_SA(0, 1), a2 + hstepA, voffA);
            PG8_WAIT_V(8); PG8_WAIT_L(0); PG8_BAR; PG8_MMA(0, 0, At, B0); PG8_MMA(0, 1, At, B1); PG8_BAR; PG8_SCHED;
            PG8_LDA(At, 1, 1); PG8_STAGE(PG8_SB(1, 0), b3, voffB); PG8_STAGE(PG8_SB(1, 1), b3 + hstepB, voffB); PG8_STAGE(PG8_SA(1, 0), a3, voffA);
            PG8_WAIT_V(8); PG8_WAIT_L(0); PG8_BAR; PG8_MMA(1, 0, At, B0); PG8_MMA(1, 1, At, B1); PG8_BAR; PG8_SCHED;
            } else {
            PG8_LDB(B0, 0, 0); PG8_SCHED; PG8_LDA(At, 0, 0); PG8_STAGE(PG8_SA(1, 1), a1 + hstepA, voffA);
            PG8_WAIT_L(8); PG8_BAR; PG8_WAIT_L(0); PG8_MMA(0, 0, At, B0); PG8_BAR; PG8_SCHED;
            PG8_LDB(B1, 0, 1); PG8_STAGE(PG8_SB(0, 0), b2, voffB);
            PG8_BAR; PG8_WAIT_L(0); PG8_MMA(0, 1, At, B1); PG8_BAR;
            PG8_LDA(At, 0, 1); PG8_STAGE(PG8_SA(0, 0), a2, voffA);
            PG8_BAR; PG8_WAIT_L(0); PG8_MMA(1, 0, At, B0); PG8_BAR; PG8_SCHED;
            PG8_STAGE(PG8_SB(0, 1), b2 + hstepB, voffB);
            PG8_WAIT_V(6); PG8_BAR; PG8_MMA(1, 1, At, B1); PG8_BAR;
            PG8_LDB(B0, 1, 0); PG8_SCHED; PG8_LDA(At, 1, 0); PG8_STAGE(PG8_SA(0, 1), a2 + hstepA, voffA);
            PG8_WAIT_L(8); PG8_BAR; PG8_WAIT_L(0); PG8_MMA(0, 0, At, B0); PG8_BAR; PG8_SCHED;
            PG8_LDB(B1, 1, 1); PG8_STAGE(PG8_SB(1, 0), b3, voffB);
            PG8_BAR; PG8_WAIT_L(0); PG8_MMA(0, 1, At, B1); PG8_BAR;
            PG8_LDA(At, 1, 1); PG8_STAGE(PG8_SA(1, 0), a3, voffA);
            PG8_BAR; PG8_WAIT_L(0); PG8_MMA(1, 0, At, B0); PG8_BAR; PG8_SCHED;
            PG8_STAGE(PG8_SB(1, 1), b3 + hstepB, voffB);
            PG8_WAIT_V(6); PG8_BAR; PG8_MMA(1, 1, At, B1); PG8_BAR;
            }
        }
        if constexpr (ALIGN_EPI) { if (wr == 0) PG8_BAR; }
        if constexpr (FP8) asm volatile("s_nop 15\n\ts_nop 15" ::: "memory");
        E(acc, cur, wr, wc, fr, fq);
        if (!has_next) break;
#pragma unroll
        for (int a = 0; a < 2; ++a)
#pragma unroll
            for (int b = 0; b < 2; ++b)
#pragma unroll
                for (int m = 0; m < 4; ++m)
#pragma unroll
                    for (int n = 0; n < 2; ++n) acc[a][b][m][n] = (f32x4){0.f, 0.f, 0.f, 0.f};
        cur = nxt; cA = nA; cB = nB; ++ui;
        if constexpr (ALIGN_EPI) { if (wr == 1) PG8_BAR; }
    }
    PG8_WAIT_V(0);
    if constexpr (!ALIGN_EPI) { if (wr == 0) PG8_BAR; }
    PG8_BAR;
#undef PG8_SA
#undef PG8_SB
#undef PG8_STAGE
#undef PG8_LDA
#undef PG8_LDB
#undef PG8_MMA
#undef PG8_WAIT_V
#undef PG8_WAIT_L
#undef PG8_BAR
#undef PG8_SCHED
}
}

namespace attn {
using bf16 = __hip_bfloat16;
constexpr int D = 128, NW = 8, QBLK = 32, KVBLK = 64;
constexpr float SCALE = 0.088388347648318440f;
constexpr float THR = 8.f;
constexpr int SDEPTH = 2;
constexpr int LDQ = NH * HD, LDK = NKV * HD, LDO = LDQ;
constexpr size_t SHM_V = KVBLK * D * 2, SHM_K = KVBLK * D * 2, SHM_ATTN = 2 * SHM_V + 2 * SHM_K + NW * 64 * 4;
using f32x8  = __attribute__((ext_vector_type(8))) float;
#define KSWZ(row, colB) ((row) * 256 + ((colB) ^ (((row) & 7) << 4)))
#define SBAR() __builtin_amdgcn_sched_barrier(0)
__device__ __forceinline__ int crow(int r, int hi) { return (r & 3) + 8 * (r >> 2) + 4 * hi; }
__device__ __forceinline__ unsigned cvtpk(float lo, float hi) {
  unsigned r; asm volatile("v_cvt_pk_bf16_f32 %0, %1, %2" : "=v"(r) : "v"(lo), "v"(hi)); return r;
}
template <typename TIn> struct Stage;
template <> struct Stage<bf16>  { using T = bf16x8;
  __device__ static __forceinline__ T ld8(const bf16* p) { return *reinterpret_cast<const bf16x8*>(p); }
  __device__ static __forceinline__ bf16x8 tobf(T x) { return x; } };
template <> struct Stage<float> { using T = f32x8;
  __device__ static __forceinline__ T ld8(const float* p) { return *reinterpret_cast<const f32x8*>(p); }
  __device__ static __forceinline__ bf16x8 tobf(T x) {
    u32x4 w = {cvtpk(x[0], x[1]), cvtpk(x[2], x[3]), cvtpk(x[4], x[5]), cvtpk(x[6], x[7])}; return *reinterpret_cast<bf16x8*>(&w); } };

__device__ __forceinline__ void partialSM(f32x16& p0, f32x16& p1, float& m_reg, float& mn, float& alpha) {
  constexpr float C = SCALE * 1.4426950408889634f;
  float pmax = p0[0]; for (int r = 1; r < 16; ++r) pmax = fmaxf(pmax, p0[r]); for (int r = 0; r < 16; ++r) pmax = fmaxf(pmax, p1[r]);
  { auto rr = __builtin_amdgcn_permlane32_swap(__float_as_uint(pmax), __float_as_uint(pmax), false, false);
    pmax = fmaxf(__uint_as_float(rr[0]), __uint_as_float(rr[1])); }
  if (__builtin_expect(__all(pmax - m_reg <= THR / SCALE), 1)) { mn = m_reg; alpha = 1.f; }
  else { mn = fmaxf(m_reg, pmax); alpha = __builtin_amdgcn_exp2f((m_reg - mn) * C); m_reg = mn; }
  float mnC = -mn * C;
  for (int r = 0; r < 16; ++r) p0[r] = fmaf(p0[r], C, mnC); for (int r = 0; r < 16; ++r) p1[r] = fmaf(p1[r], C, mnC);
  for (int r = 0; r < 16; ++r) p0[r] = __builtin_amdgcn_exp2f(p0[r]);
}
__device__ __forceinline__ void finishSM(f32x16& p0, f32x16& p1, float alpha, float& l_reg, bf16x8& pa0, bf16x8& pa1, bf16x8& pa2, bf16x8& pa3) {
  for (int r = 0; r < 16; ++r) p1[r] = __builtin_amdgcn_exp2f(p1[r]);
  float ps = 0; for (int r = 0; r < 16; ++r) ps += p0[r]; for (int r = 0; r < 16; ++r) ps += p1[r];
  { auto rr = __builtin_amdgcn_permlane32_swap(__float_as_uint(ps), __float_as_uint(ps), false, false);
    ps = __uint_as_float(rr[0]) + __uint_as_float(rr[1]); }
  l_reg = l_reg * alpha + ps;
#define PK4(P, BASE, OUT) do { unsigned a0 = cvtpk(P[BASE + 0], P[BASE + 1]), a1 = cvtpk(P[BASE + 2], P[BASE + 3]);   \
    unsigned b0 = cvtpk(P[BASE + 4], P[BASE + 5]), b1 = cvtpk(P[BASE + 6], P[BASE + 7]);                              \
    auto r0 = __builtin_amdgcn_permlane32_swap(a0, b0, false, false); auto r1 = __builtin_amdgcn_permlane32_swap(a1, b1, false, false); \
    u32x4 w = {r0[0], r1[0], r0[1], r1[1]}; OUT = *reinterpret_cast<bf16x8*>(&w); } while (0)
  PK4(p0, 0, pa0); PK4(p0, 8, pa1); PK4(p1, 0, pa2); PK4(p1, 8, pa3);
#undef PK4
}
__device__ __forceinline__ void qkt(f32x16& p0, f32x16& p1, const bf16* Ks, const bf16x8* qr, int r32, int hi) {
  p0 = f32x16{}; p1 = f32x16{};
  for (int d0 = 0; d0 < 8; ++d0) { int cb = (d0 * 16 + hi * 8) * 2;
    bf16x8 b0 = *reinterpret_cast<const bf16x8*>((const char*)Ks + KSWZ(r32, cb));
    bf16x8 b1 = *reinterpret_cast<const bf16x8*>((const char*)Ks + KSWZ(32 + r32, cb));
    p0 = __builtin_amdgcn_mfma_f32_32x32x16_bf16(b0, qr[d0], p0, 0, 0, 0);
    p1 = __builtin_amdgcn_mfma_f32_32x32x16_bf16(b1, qr[d0], p1, 0, 0, 0); }
}
__device__ __forceinline__ int v_st(int k, int c) { const int kk = (k & ~0xC) | ((k & 4) << 1) | ((k & 8) >> 1); return ((kk >> 3) * 4 + (c >> 5)) * 512 + ((kk & 7) * 32 + (c & 31)) * 2; }
__device__ __forceinline__ int v_rd_base(int lane) { return ((lane & 3) << 3) | (((lane >> 2) & 3) << 6) | (((lane >> 4) & 1) << 5) | (((lane >> 5) & 1) << 8); }
constexpr int v_rd_off(int d0, int ks, int half) { return d0 * 512 + ks * 4096 + half * 2048; }
template <int OFF> __device__ __forceinline__ s16x4 tr_read(int vb) {
  s16x4 r; asm volatile("ds_read_b64_tr_b16 %0, %1 offset:%2" : "=&v"(r) : "v"(vb), "i"(OFF) : "memory"); return r;
}
template <int D0> __device__ __forceinline__ void pv_one(f32x16& od, int vb, bf16x8 pa0, bf16x8 pa1, bf16x8 pa2, bf16x8 pa3) {
  const s16x4 l0 = tr_read<v_rd_off(D0, 0, 0)>(vb), h0 = tr_read<v_rd_off(D0, 0, 1)>(vb), l1 = tr_read<v_rd_off(D0, 1, 0)>(vb), h1 = tr_read<v_rd_off(D0, 1, 1)>(vb);
  const s16x4 l2 = tr_read<v_rd_off(D0, 2, 0)>(vb), h2 = tr_read<v_rd_off(D0, 2, 1)>(vb), l3 = tr_read<v_rd_off(D0, 3, 0)>(vb), h3 = tr_read<v_rd_off(D0, 3, 1)>(vb);
  asm volatile("s_waitcnt lgkmcnt(0)" ::: "memory"); SBAR();
#define PK(L, H) (bf16x8){L[0], L[1], L[2], L[3], H[0], H[1], H[2], H[3]}
  od = __builtin_amdgcn_mfma_f32_32x32x16_bf16(pa0, PK(l0, h0), od, 0, 0, 0);
  od = __builtin_amdgcn_mfma_f32_32x32x16_bf16(pa1, PK(l1, h1), od, 0, 0, 0);
  od = __builtin_amdgcn_mfma_f32_32x32x16_bf16(pa2, PK(l2, h2), od, 0, 0, 0);
  od = __builtin_amdgcn_mfma_f32_32x32x16_bf16(pa3, PK(l3, h3), od, 0, 0, 0);
#undef PK
}
__device__ __forceinline__ void pv_d0(f32x16* o, int vb, bf16x8 pa0, bf16x8 pa1, bf16x8 pa2, bf16x8 pa3) {
  pv_one<0>(o[0], vb, pa0, pa1, pa2, pa3); pv_one<1>(o[1], vb, pa0, pa1, pa2, pa3); pv_one<2>(o[2], vb, pa0, pa1, pa2, pa3); pv_one<3>(o[3], vb, pa0, pa1, pa2, pa3);
}

template <typename TQ>
__device__ __forceinline__ void attn_dense_body(const TQ* __restrict__ Qb, const bf16* __restrict__ Kh, const bf16* __restrict__ Vh,
                                                float* __restrict__ Ob, int seq, char* lds) {
  using St = Stage<bf16>; using SQ = Stage<TQ>;
  const int tid = threadIdx.x, wid = tid >> 6, lane = tid & 63, r32 = lane & 31, hi = lane >> 5;
  bf16* V_lds = (bf16*)lds; bf16* K_lds = (bf16*)(lds + 2 * SHM_V);
  float* ws = (float*)(lds + 2 * SHM_V + 2 * SHM_K) + wid * 64; float* li_l = ws; float* al_l = ws + 32;
  float m_reg = -1e30f, l_reg = 0; f32x16 o[4] = {}; bf16x8 qr[8];
  const TQ* Qw = Qb + (long)(wid * QBLK + r32) * LDQ + hi * 8;
#pragma unroll
  for (int d0 = 0; d0 < 8; ++d0) qr[d0] = SQ::tobf(SQ::ld8(Qw + d0 * 16));
  const int sr = tid >> 4, sc = (tid & 15) * 8, vst0 = v_st(sr, sc), vst1 = v_st(32 + sr, sc);
  const int vb0 = (int)(uintptr_t)V_lds + v_rd_base(lane);
  struct { typename St::T vs0, vs1, ks0, ks1; } sr_[SDEPTH];
#define SLOAD(i, k0) do { sr_[i].vs0 = St::ld8(&Vh[(long)((k0) + sr) * LDK + sc]); sr_[i].vs1 = St::ld8(&Vh[(long)((k0) + 32 + sr) * LDK + sc]); \
    sr_[i].ks0 = St::ld8(&Kh[(long)((k0) + sr) * LDK + sc]); sr_[i].ks1 = St::ld8(&Kh[(long)((k0) + 32 + sr) * LDK + sc]); } while (0)
#define SWRITE(b, i) do { *(bf16x8*)((char*)V_lds + (b) * SHM_V + vst0) = St::tobf(sr_[i].vs0);          \
    *(bf16x8*)((char*)V_lds + (b) * SHM_V + vst1) = St::tobf(sr_[i].vs1); int kc = sc * 2;               \
    *(bf16x8*)((char*)K_lds + (b) * SHM_K + KSWZ(sr, kc)) = St::tobf(sr_[i].ks0);                       \
    *(bf16x8*)((char*)K_lds + (b) * SHM_K + KSWZ(32 + sr, kc)) = St::tobf(sr_[i].ks1); } while (0)
#define SWAIT() do { if constexpr (SDEPTH == 2) asm volatile("s_waitcnt vmcnt(4)" ::: "memory"); else asm volatile("s_waitcnt vmcnt(0)" ::: "memory"); } while (0)
#define RESC(a) do { if (__any((a) < 1.f)) { if (hi == 0) al_l[r32] = (a); asm volatile("s_waitcnt lgkmcnt(0)" ::: "memory"); \
    for (int d = 0; d < 4; ++d) for (int r = 0; r < 16; ++r) o[d][r] *= al_l[crow(r, hi)]; } } while (0)
  f32x16 pA0, pA1, pB0, pB1; float mnA, mnB, alA, alB; bf16x8 pa0, pa1, pa2, pa3; const int NT = seq / KVBLK;
  constexpr int SE = 0, SO = SDEPTH - 1;
  SLOAD(SE, 0); asm volatile("s_waitcnt vmcnt(0)" ::: "memory"); SWRITE(0, SE); __syncthreads();
  qkt(pA0, pA1, K_lds, qr, r32, hi); partialSM(pA0, pA1, m_reg, mnA, alA);
  SLOAD(SO, KVBLK); if constexpr (SDEPTH == 2) { if (2 < NT) SLOAD(SE, 2 * KVBLK); }
  SWAIT(); SWRITE(1, SO); __syncthreads();
  for (int j = 1; j + 1 < NT; j += 2) {
    SBAR(); qkt(pB0, pB1, (bf16*)((char*)K_lds + SHM_K), qr, r32, hi);
    finishSM(pA0, pA1, alA, l_reg, pa0, pa1, pa2, pa3); SBAR();
    SLOAD(SO, (j + SDEPTH) * KVBLK); SBAR();
    pv_d0(o, vb0, pa0, pa1, pa2, pa3); partialSM(pB0, pB1, m_reg, mnB, alB);
    __syncthreads(); SWAIT(); SWRITE(0, SE);
    RESC(alB); __syncthreads();
    SBAR(); qkt(pA0, pA1, K_lds, qr, r32, hi);
    finishSM(pB0, pB1, alB, l_reg, pa0, pa1, pa2, pa3); SBAR();
    if (SDEPTH == 1 || j + 3 < NT) SLOAD(SE, (j + 1 + SDEPTH) * KVBLK); SBAR();
    pv_d0(o, vb0 + (int)SHM_V, pa0, pa1, pa2, pa3); partialSM(pA0, pA1, m_reg, mnA, alA);
    __syncthreads(); SWAIT(); SWRITE(1, SO);
    RESC(alA); __syncthreads();
  }
  SBAR(); qkt(pB0, pB1, (bf16*)((char*)K_lds + SHM_K), qr, r32, hi);
  finishSM(pA0, pA1, alA, l_reg, pa0, pa1, pa2, pa3); SBAR();
  pv_d0(o, vb0, pa0, pa1, pa2, pa3); partialSM(pB0, pB1, m_reg, mnB, alB);
  __syncthreads(); RESC(alB);
  finishSM(pB0, pB1, alB, l_reg, pa0, pa1, pa2, pa3); SBAR();
  pv_d0(o, vb0 + (int)SHM_V, pa0, pa1, pa2, pa3);
  if (hi == 0) li_l[r32] = l_reg; asm volatile("s_waitcnt lgkmcnt(0)" ::: "memory");
  float rli[16];
#pragma unroll
  for (int r = 0; r < 16; ++r) rli[r] = __builtin_amdgcn_rcpf(li_l[crow(r, hi)]);
  unsigned char* Ow = (unsigned char*)Ob + (long)(wid * QBLK) * LDO;
#pragma unroll
  for (int r = 0; r < 16; ++r) { int orow = crow(r, hi);
    for (int d0 = 0; d0 < 4; ++d0) { const float ov_ = __builtin_amdgcn_fmed3f(o[d0][r] * rli[r] * 8.f, -448.f, 448.f); Ow[(long)orow * LDO + d0 * 32 + r32] = (unsigned char)(__builtin_amdgcn_cvt_pk_fp8_f32(ov_, ov_, 0, false) & 0xff); } }
  __syncthreads();
#undef SLOAD
#undef SWRITE
#undef SWAIT
#undef RESC
}

}

namespace attn8 {
using attn::crow;
using f32x16 = __attribute__((ext_vector_type(16))) float;
using i32x8 = __attribute__((ext_vector_type(8))) int;
using i32x4 = __attribute__((ext_vector_type(4))) int;
#define A8_LAS __attribute__((address_space(3)))
constexpr float SCALE = 0.088388347648318440f, QMUL = SCALE * 1.4426950408889634f, THR2 = 4.32f, PSH = 4.f;
constexpr int TILE = 8192, KRING = 0, VRING = 3 * TILE, WSP = 6 * TILE;
constexpr long TSTRIDE = 8 * TILE;
#define A8_SBAR() __builtin_amdgcn_sched_barrier(0)
#ifndef ATT_PROBE
#define ATT_PROBE 0
#endif
template <int VAR = 0>
__device__ __forceinline__ f32x16 mfma8(const i32x8 a, const i32x8 b, const f32x16 c) {
  if constexpr ((VAR & 1) != 0) { f32x16 r = c; r[0] += __int_as_float(a[0] ^ b[0]); return r; }
  else return __builtin_amdgcn_mfma_scale_f32_32x32x64_f8f6f4(a, b, c, 0, 0, 0, 0x7F7F7F7F, 0, 0x7F7F7F7F);
}
template <int VAR = 0> __device__ __forceinline__ float ex2(float x) { if constexpr ((VAR & 2) != 0) return x; else return __builtin_amdgcn_exp2f(x); }
template <int VAR = 0>
__device__ __forceinline__ i32x8 frag(const A8_LAS char* lds, int a0) {
  if constexpr ((VAR & 4) != 0) { return (i32x8){a0, a0, a0, a0, a0, a0, a0, a0}; }
  const i32x4 x = *(const A8_LAS i32x4*)(lds + a0), y = *(const A8_LAS i32x4*)(lds + (a0 ^ 16));
  return (i32x8){x[0], x[1], x[2], x[3], y[0], y[1], y[2], y[3]};
}
template <int VAR = 0>
__device__ __forceinline__ void partialSM(f32x16& p0, f32x16& p1, f32x16& negm, float& alpha, i32x8& pw, const bool first) {
  float pmax = p0[0]; for (int r = 1; r < 16; ++r) pmax = fmaxf(pmax, p0[r]); for (int r = 0; r < 16; ++r) pmax = fmaxf(pmax, p1[r]);
  { auto rr = __builtin_amdgcn_permlane32_swap(__float_as_uint(pmax), __float_as_uint(pmax), false, false);
    pmax = fmaxf(__uint_as_float(rr[0]), __uint_as_float(rr[1])); }
  if (__builtin_expect(!first && __all(pmax <= PSH + THR2), 1)) { alpha = 1.f; }
  else { const float delta = first ? pmax - PSH : fmaxf(pmax - PSH, 0.f); alpha = __builtin_amdgcn_exp2f(-delta);
    for (int r = 0; r < 16; ++r) { p0[r] -= delta; p1[r] -= delta; }
    const float nm = negm[0] - delta; for (int r = 0; r < 16; ++r) negm[r] = nm; }
  for (int r = 0; r < 16; ++r) p0[r] = ex2<VAR>(p0[r]);
#pragma unroll
  for (int i = 0; i < 4; ++i) { int w = __float_as_int(p0[4 * i]); w = __builtin_amdgcn_cvt_pk_fp8_f32(p0[4 * i], p0[4 * i + 1], w, false); w = __builtin_amdgcn_cvt_pk_fp8_f32(p0[4 * i + 2], p0[4 * i + 3], w, true); pw[i] = w; }
}
template <int VAR = 0>
__device__ __forceinline__ void finishSM(f32x16& p1, i32x8& pw) {
  for (int r = 0; r < 16; ++r) p1[r] = ex2<VAR>(p1[r]);
#pragma unroll
  for (int i = 0; i < 4; ++i) { int w = __float_as_int(p1[4 * i]); w = __builtin_amdgcn_cvt_pk_fp8_f32(p1[4 * i], p1[4 * i + 1], w, false); w = __builtin_amdgcn_cvt_pk_fp8_f32(p1[4 * i + 2], p1[4 * i + 3], w, true); pw[4 + i] = w; }
}
template <int VAR = 0>
__device__ __forceinline__ void body(const unsigned char* __restrict__ Qb, const unsigned char* __restrict__ Kt, const unsigned char* __restrict__ Vt,
                                     unsigned char* __restrict__ Ob, int seq, A8_LAS char* lds, const int wave) {
  const int tid = opaque_tid(wave), wid = wave, lane = tid & 63, r32 = lane & 31, hi = lane >> 5;
  A8_LAS float* al_l = (A8_LAS float*)(lds + WSP) + wid * 64;
  f32x16 o[4], lacc, negm;
  { float z = 0.f, ps = PSH; asm volatile("" : "+v"(z), "+v"(ps));
#pragma unroll
    for (int r = 0; r < 16; ++r) { negm[r] = ps; lacc[r] = z; o[0][r] = z; o[1][r] = z; o[2][r] = z; o[3][r] = z; } }
  const int NT = seq / 64;
  const int ko0 = r32 * 128 + (((2 * hi) ^ ((r32 >> 1) & 7)) << 4), ko1 = r32 * 128 + (((4 + 2 * hi) ^ ((r32 >> 1) & 7)) << 4);
  const int vo = r32 * 64 + (((2 * hi) ^ ((r32 >> 2) & 3)) << 4);
  const unsigned voff = wid * 1024 + lane * 16;
#define A8_DMA(gp, ring, slot) __builtin_amdgcn_global_load_lds((const unsigned*)((gp) + voff), (A8_LAS unsigned*)(lds + (ring) + (slot) * TILE + wid * 1024), 16, 0, 0)
#define A8_TILE(j) ((long)((j) < NT ? (j) : NT - 1) * TSTRIDE)
#define A8_BAR(n) do { asm volatile("s_waitcnt vmcnt(" #n ") lgkmcnt(0)" ::: "memory"); __builtin_amdgcn_s_barrier(); asm volatile("" ::: "memory"); A8_SBAR(); } while (0)
  i32x8 q0, q1;
  { const unsigned char* qp = Qb + (long)(wid * 32 + r32) * 4096 + hi * 32;
    const i32x4 a = *(const i32x4*)qp, b = *(const i32x4*)(qp + 16), c = *(const i32x4*)(qp + 64), d = *(const i32x4*)(qp + 80);
    q0 = (i32x8){a[0], a[1], a[2], a[3], b[0], b[1], b[2], b[3]}; q1 = (i32x8){c[0], c[1], c[2], c[3], d[0], d[1], d[2], d[3]}; }
  asm volatile("" : "+v"(q0), "+v"(q1));
  A8_DMA(Kt, KRING, 0); A8_DMA(Vt, VRING, 0); A8_DMA(Kt + A8_TILE(1), KRING, 1); A8_DMA(Vt + A8_TILE(1), VRING, 1);
  A8_BAR(3);
  const bool late = wid >= 4;
  if (late) A8_BAR(1);
  int sl = 0, sf = 2;
  i32x8 kf0 = frag<VAR>(lds + KRING, ko0), kf1 = frag<VAR>(lds + KRING + 4096, ko0), kf2 = frag<VAR>(lds + KRING, ko1), kf3 = frag<VAR>(lds + KRING + 4096, ko1);
  for (int j = 0; j < NT; ++j) {
    f32x16 p0, p1; i32x8 pw; float al;
    if constexpr ((VAR & 8) == 0) A8_DMA(Kt + A8_TILE(j + 2), KRING, sf);
    __builtin_amdgcn_s_setprio(2);
    p0 = mfma8<VAR>(kf0, q0, negm); p1 = mfma8<VAR>(kf1, q0, negm); p0 = mfma8<VAR>(kf2, q1, p0); p1 = mfma8<VAR>(kf3, q1, p1);
    __builtin_amdgcn_s_setprio(0);
    if constexpr ((VAR & 16) != 0) { al = 1.f; for (int i = 0; i < 4; ++i) { pw[i] = __float_as_int(p0[i]); pw[4 + i] = __float_as_int(p1[i]); } }
    else partialSM<VAR>(p0, p1, negm, al, pw, j == 0);
    if (__any(al < 1.f)) { if (hi == 0) al_l[r32] = al; asm volatile("s_waitcnt lgkmcnt(0)" ::: "memory");
      for (int r = 0; r < 16; ++r) { const float a_ = al_l[crow(r, hi)]; lacc[r] *= a_; for (int d = 0; d < 4; ++d) o[d][r] *= a_; } }
    A8_BAR(2);
    if constexpr ((VAR & 8) == 0) A8_DMA(Vt + A8_TILE(j + 2), VRING, sf);
    { const A8_LAS char* Vs = lds + VRING + sl * TILE;
      const i32x8 b0 = frag<VAR>(Vs, vo), b1 = frag<VAR>(Vs + 2048, vo), b2 = frag<VAR>(Vs + 4096, vo), b3 = frag<VAR>(Vs + 6144, vo);
      A8_SBAR();
      if constexpr ((VAR & 16) == 0) finishSM<VAR>(p1, pw);
      int one = 0x38383838; asm volatile("" : "+v"(one));
      A8_SBAR();
      __builtin_amdgcn_s_setprio(2);
      o[0] = mfma8<VAR>(pw, b0, o[0]); o[1] = mfma8<VAR>(pw, b1, o[1]); o[2] = mfma8<VAR>(pw, b2, o[2]); o[3] = mfma8<VAR>(pw, b3, o[3]);
      lacc = mfma8<VAR>(pw, (i32x8){one, one, one, one, one, one, one, one}, lacc);
      __builtin_amdgcn_s_setprio(0); }
    A8_SBAR();
    sf = sl; sl = sl == 2 ? 0 : sl + 1;
    { const A8_LAS char* Ks = lds + KRING + sl * TILE;
      kf0 = frag<VAR>(Ks, ko0); kf1 = frag<VAR>(Ks + 4096, ko0); kf2 = frag<VAR>(Ks, ko1); kf3 = frag<VAR>(Ks + 4096, ko1); }
    A8_BAR(1);
  }
  if (!late) A8_BAR(2);
  float rli[16];
#pragma unroll
  for (int r = 0; r < 16; ++r) rli[r] = __builtin_amdgcn_rcpf(lacc[r]);
  unsigned char* Ow = Ob + (long)(wid * 32) * 4096;
#pragma unroll
  for (int r = 0; r < 16; ++r) { int orow = crow(r, hi);
    for (int d0 = 0; d0 < 4; ++d0) { const float ov_ = __builtin_amdgcn_fmed3f(o[d0][r] * rli[r] * 8.f, -448.f, 448.f); Ow[(long)orow * 4096 + d0 * 32 + r32] = (unsigned char)(__builtin_amdgcn_cvt_pk_fp8_f32(ov_, ov_, 0, false) & 0xff); } }
  asm volatile("s_waitcnt vmcnt(0)" ::: "memory");
  A8_BAR(0);
#undef A8_DMA
#undef A8_TILE
#undef A8_BAR
}

__device__ __forceinline__ void pack16(const f32x16& p, int* w) {
#pragma unroll
  for (int i = 0; i < 4; ++i) { int x = __float_as_int(p[4 * i]); x = __builtin_amdgcn_cvt_pk_fp8_f32(p[4 * i], p[4 * i + 1], x, false); x = __builtin_amdgcn_cvt_pk_fp8_f32(p[4 * i + 2], p[4 * i + 3], x, true); w[i] = x; }
}
__device__ __forceinline__ void body128(const unsigned char* __restrict__ Qb, const unsigned char* __restrict__ Kt, const unsigned char* __restrict__ Vt,
                                        unsigned char* __restrict__ Ob, int seq, A8_LAS char* lds, const int wave) {
  const int tid = opaque_tid(wave), wid = wave, lane = tid & 63, r32 = lane & 31, hi = lane >> 5;
  constexpr int SLOT = 2 * TILE, KR = 0, VR = 3 * SLOT, WS2 = 6 * SLOT;
  A8_LAS float* al_l = (A8_LAS float*)(lds + WS2) + wid * 64;
  f32x16 o[4], lacc, negm;
  { float z = 0.f, ps = PSH; asm volatile("" : "+v"(z), "+v"(ps));
#pragma unroll
    for (int r = 0; r < 16; ++r) { negm[r] = ps; lacc[r] = z; o[0][r] = z; o[1][r] = z; o[2][r] = z; o[3][r] = z; } }
  const int NS = seq / 128;
  const int ko0 = r32 * 128 + (((2 * hi) ^ ((r32 >> 1) & 7)) << 4), ko1 = r32 * 128 + (((4 + 2 * hi) ^ ((r32 >> 1) & 7)) << 4);
  const int vo = r32 * 64 + (((2 * hi) ^ ((r32 >> 2) & 3)) << 4);
  const unsigned voff = wid * 1024 + lane * 16;
#define B_DMA(gp, ring, slot, sub) __builtin_amdgcn_global_load_lds((const unsigned*)((gp) + voff), (A8_LAS unsigned*)(lds + (ring) + (slot) * SLOT + (sub) * TILE + wid * 1024), 16, 0, 0)
#define B_STEP(j) ((long)((j) < NS ? (j) : NS - 1) * 2 * TSTRIDE)
#define B_DMA2(base, ring, slot, j) do { B_DMA((base) + B_STEP(j), ring, slot, 0); B_DMA((base) + B_STEP(j) + TSTRIDE, ring, slot, 1); } while (0)
#define B_BAR(n) do { asm volatile("s_waitcnt vmcnt(" #n ") lgkmcnt(0)" ::: "memory"); __builtin_amdgcn_s_barrier(); asm volatile("" ::: "memory"); A8_SBAR(); } while (0)
  i32x8 q0, q1;
  { const unsigned char* qp = Qb + (long)(wid * 32 + r32) * 4096 + hi * 32;
    const i32x4 a = *(const i32x4*)qp, b = *(const i32x4*)(qp + 16), c = *(const i32x4*)(qp + 64), d = *(const i32x4*)(qp + 80);
    q0 = (i32x8){a[0], a[1], a[2], a[3], b[0], b[1], b[2], b[3]}; q1 = (i32x8){c[0], c[1], c[2], c[3], d[0], d[1], d[2], d[3]}; }
  asm volatile("" : "+v"(q0), "+v"(q1));
  B_DMA2(Kt, KR, 0, 0); B_DMA2(Vt, VR, 0, 0); B_DMA2(Kt, KR, 1, 1); B_DMA2(Vt, VR, 1, 1);
  B_BAR(6);
  const bool late = wid >= 4;
  if (late) { __builtin_amdgcn_s_setprio(1); B_BAR(4); }
  int sl = 0, sf = 2;
  for (int j = 0; j < NS; ++j) {
    f32x16 p0, p1, p2, p3; int pw[16]; float al;
    B_DMA2(Kt, KR, sf, j + 2);
    { const A8_LAS char* Ks = lds + KR + sl * SLOT;
      { const i32x8 a0 = frag<0>(Ks, ko0), a1 = frag<0>(Ks + 4096, ko0), a2 = frag<0>(Ks, ko1), a3 = frag<0>(Ks + 4096, ko1);
        p0 = mfma8<0>(a0, q0, negm); p1 = mfma8<0>(a1, q0, negm); p0 = mfma8<0>(a2, q1, p0); p1 = mfma8<0>(a3, q1, p1); }
      { const i32x8 a0 = frag<0>(Ks + TILE, ko0), a1 = frag<0>(Ks + TILE + 4096, ko0), a2 = frag<0>(Ks + TILE, ko1), a3 = frag<0>(Ks + TILE + 4096, ko1);
        p2 = mfma8<0>(a0, q0, negm); p3 = mfma8<0>(a1, q0, negm); p2 = mfma8<0>(a2, q1, p2); p3 = mfma8<0>(a3, q1, p3);
        } }
    { float pmax = p0[0];
      for (int r = 1; r < 16; ++r) pmax = fmaxf(pmax, p0[r]);
      for (int r = 0; r < 16; ++r) pmax = fmaxf(pmax, p1[r]);
      for (int r = 0; r < 16; ++r) pmax = fmaxf(pmax, p2[r]);
      for (int r = 0; r < 16; ++r) pmax = fmaxf(pmax, p3[r]);
      { auto rr = __builtin_amdgcn_permlane32_swap(__float_as_uint(pmax), __float_as_uint(pmax), false, false);
        pmax = fmaxf(__uint_as_float(rr[0]), __uint_as_float(rr[1])); }
      const bool first = j == 0;
      if (__builtin_expect(!first && __all(pmax <= PSH + THR2), 1)) { al = 1.f; }
      else { const float delta = first ? pmax - PSH : fmaxf(pmax - PSH, 0.f); al = __builtin_amdgcn_exp2f(-delta);
        for (int r = 0; r < 16; ++r) { p0[r] -= delta; p1[r] -= delta; p2[r] -= delta; p3[r] -= delta; }
        const float nm = negm[0] - delta; for (int r = 0; r < 16; ++r) negm[r] = nm; }
      for (int r = 0; r < 16; ++r) { p0[r] = __builtin_amdgcn_exp2f(p0[r]); p1[r] = __builtin_amdgcn_exp2f(p1[r]); }
      pack16(p0, pw); pack16(p1, pw + 4); }
    if (__any(al < 1.f)) { if (hi == 0) al_l[r32] = al; asm volatile("s_waitcnt lgkmcnt(0)" ::: "memory");
      for (int r = 0; r < 16; ++r) { const float a_ = al_l[crow(r, hi)]; lacc[r] *= a_; for (int d = 0; d < 4; ++d) o[d][r] *= a_; } }
    B_BAR(4);
    B_DMA2(Vt, VR, sf, j + 2);
    { const A8_LAS char* Vs = lds + VR + sl * SLOT;
      int one = 0x38383838; asm volatile("" : "+v"(one));
      const i32x8 ones = (i32x8){one, one, one, one, one, one, one, one};
      { const i32x8 b0 = frag<0>(Vs, vo), b1 = frag<0>(Vs + 2048, vo), b2 = frag<0>(Vs + 4096, vo), b3 = frag<0>(Vs + 6144, vo);
        A8_SBAR();
        for (int r = 0; r < 16; ++r) { p2[r] = __builtin_amdgcn_exp2f(p2[r]); p3[r] = __builtin_amdgcn_exp2f(p3[r]); }
        pack16(p2, pw + 8); pack16(p3, pw + 12);
        A8_SBAR();
        const i32x8 pa = (i32x8){pw[0], pw[1], pw[2], pw[3], pw[4], pw[5], pw[6], pw[7]};
        o[0] = mfma8<0>(pa, b0, o[0]); o[1] = mfma8<0>(pa, b1, o[1]); o[2] = mfma8<0>(pa, b2, o[2]); o[3] = mfma8<0>(pa, b3, o[3]);
        lacc = mfma8<0>(pa, ones, lacc); }
      { const i32x8 b0 = frag<0>(Vs + TILE, vo), b1 = frag<0>(Vs + TILE + 2048, vo), b2 = frag<0>(Vs + TILE + 4096, vo), b3 = frag<0>(Vs + TILE + 6144, vo);
        const i32x8 pb = (i32x8){pw[8], pw[9], pw[10], pw[11], pw[12], pw[13], pw[14], pw[15]};
        o[0] = mfma8<0>(pb, b0, o[0]); o[1] = mfma8<0>(pb, b1, o[1]); o[2] = mfma8<0>(pb, b2, o[2]); o[3] = mfma8<0>(pb, b3, o[3]);
        lacc = mfma8<0>(pb, ones, lacc);
        } }
    B_BAR(4);
    sf = sl; sl = sl == 2 ? 0 : sl + 1;
  }
  if (!late) B_BAR(4); else __builtin_amdgcn_s_setprio(0);
  float rli[16];
#pragma unroll
  for (int r = 0; r < 16; ++r) rli[r] = __builtin_amdgcn_rcpf(lacc[r]);
  { A8_LAS unsigned char* st = (A8_LAS unsigned char*)(lds + WS2 + 2048 + wid * 4096 + (wid == 7 ? 4096 : 0));
#pragma unroll
    for (int r = 0; r < 16; ++r) { const int orow = crow(r, hi);
#pragma unroll
      for (int d0 = 0; d0 < 4; ++d0) { const float ov_ = __builtin_amdgcn_fmed3f(o[d0][r] * rli[r] * 8.f, -448.f, 448.f);
        st[orow * 128 + d0 * 32 + r32] = (unsigned char)(__builtin_amdgcn_cvt_pk_fp8_f32(ov_, ov_, 0, false) & 0xff); } }
    asm volatile("s_waitcnt lgkmcnt(0)" ::: "memory");
    unsigned char* Ow = Ob + (long)(wid * 32) * 4096;
#pragma unroll
    for (int i = 0; i < 4; ++i) { const int c = lane + 64 * i; const i32x4 v = *(const A8_LAS i32x4*)(st + c * 16);
      *(i32x4*)(Ow + (long)(c >> 3) * 4096 + (c & 7) * 16) = v; } }
  asm volatile("s_waitcnt vmcnt(0)" ::: "memory");
  B_BAR(0);
#undef B_DMA
#undef B_STEP
#undef B_DMA2
#undef B_BAR
}
}

constexpr size_t MiB = 1u << 20;
constexpr size_t WS_CTL = 0, CTL_ZERO_BYTES = 64 * 1024;
constexpr size_t WS_SCU = 1 * MiB, WS_SCV = WS_SCU + 64 * 1024;
constexpr size_t WS_CS = WS_SCU + 128 * 1024;
constexpr size_t WS_KEYS = WS_SCU + 384 * 1024;
constexpr size_t WS_SCIN = WS_SCU + 896 * 1024;
constexpr float ACT8 = 8.f;
constexpr size_t WS_MODF = 2 * MiB;
constexpr size_t WS_MODP = 3 * MiB;
constexpr size_t WS_WIN = 6 * MiB, WS_WATT = 134 * MiB, WS_WFOUR = 166 * MiB, WS_WOUT = 182 * MiB, WS_WPQ = 214 * MiB;
constexpr size_t WS_U8 = 230 * MiB, WS_V8 = 294 * MiB;
constexpr size_t WS_D128 = 358 * MiB, WS_DS64 = WS_D128 + 128 * 1024, WS_DS32 = WS_DS64 + 128 * 1024;
constexpr size_t WS_H = 359 * MiB;
constexpr size_t WS_Q = 551 * MiB;
constexpr size_t WS_K = 743 * MiB, WS_V = 791 * MiB;
constexpr size_t WS_F = 839 * MiB;
constexpr size_t WS_GA = 935 * MiB, WS_GF = 1127 * MiB;
constexpr size_t WS_IDX = 1319 * MiB, WS_GATE = 1331 * MiB;
constexpr size_t WS_L1 = 1343 * MiB;
constexpr size_t WS_END = 1535 * MiB + 4096;
#ifndef ATTN_FP8
#define ATTN_FP8 1
#endif
constexpr size_t WS_GA8 = WS_Q + 96 * MiB;
constexpr float GATE8 = 255.f;
constexpr size_t DO_Q8 = 0, DO_K8 = 96 * MiB, DO_V8 = 120 * MiB;
constexpr int CW_BAR = 4096;

constexpr int NWAVES = 8;
constexpr int LDS_BYTES = 147456;
constexpr int MISC_OFF = 131072 + 320;

#define XB_TMO      128
#define XB_XCNT(j)  (256  + 64 * (j))
#define XB_XSUB(j)  (1280 + 64 * (j))
#define XB_XGEN(j)  (2304 + 64 * (j))
#define XB_TOP      3328
#define XB_TOPGEN   3392
#define XCD_BAR_WORDS 3456
#define XB_SPIN_CAP (1u << 18)

__device__ __forceinline__ unsigned xb_ld(unsigned* p)              { return __hip_atomic_load(p, __ATOMIC_RELAXED, __HIP_MEMORY_SCOPE_AGENT); }
__device__ __forceinline__ unsigned xb_add(unsigned* p, unsigned v) { return __hip_atomic_fetch_add(p, v, __ATOMIC_RELAXED, __HIP_MEMORY_SCOPE_AGENT); }
__device__ __forceinline__ unsigned xb_xcc_id() { return (unsigned)__builtin_amdgcn_s_getreg((3 << 11) | 20) & 0xFu; }
#define XB_SPIN(cond, bar) do { unsigned _sp = 0; while (cond) { __builtin_amdgcn_s_sleep(1); \
    if ((++_sp & 255u) == 0u) { if (xb_ld(&(bar)[XB_TMO])) break; if (_sp > XB_SPIN_CAP) { atomicAdd(&(bar)[XB_TMO], 1u); break; } } } } while (0)

struct XcdBarrier {
    unsigned* bar; unsigned x;
    volatile LAS unsigned* st;
};
__device__ __forceinline__ XcdBarrier xcd_barrier_post(unsigned* bar, volatile LAS unsigned* st, const int tid) {
    XcdBarrier b; b.bar = bar; b.x = xb_xcc_id(); b.st = st;
    if (tid == 0) (void)xb_add(&bar[XB_XCNT(b.x)], 1u);
    return b;
}
__device__ __forceinline__ void xcd_barrier_complete(unsigned* bar, unsigned x, unsigned& nloc, unsigned& nx) {
    const unsigned G = gridDim.x * gridDim.y * gridDim.z;
    unsigned sum, cnt, mine, sp = 0u;
    for (;;) {
        sum = 0u; cnt = 0u; mine = 0u;
#pragma unroll
        for (unsigned j = 0; j < 16; ++j) { const unsigned c = xb_ld(&bar[XB_XCNT(j)]); sum += c; cnt += (c > 0u) ? 1u : 0u; mine = (j == x) ? c : mine; }
        if (sum == G) break;
        __builtin_amdgcn_s_sleep(1);
        if ((++sp & 255u) == 0u) { if (xb_ld(&bar[XB_TMO])) break; if (sp > XB_SPIN_CAP) { atomicAdd(&bar[XB_TMO], 1u); break; } }
    }
    nloc = mine > 0u ? mine : 1u; nx = cnt > 0u ? cnt : 1u;
}
__device__ __forceinline__ void xcd_barrier(const XcdBarrier& b, const int tid) {
    asm volatile("s_waitcnt vmcnt(0)" ::: "memory");
    __syncthreads();
    if (tid == 0) {
        unsigned* bar = b.bar;
        __builtin_amdgcn_s_waitcnt(0);
        unsigned nloc = b.st[0], nx = b.st[1];
        if (nloc == 0u) { xcd_barrier_complete(bar, b.x, nloc, nx); b.st[0] = nloc; b.st[1] = nx; }
        const unsigned old = xb_add(&bar[XB_XSUB(b.x)], 1u);
        const unsigned gen = old / nloc;
        if (old + 1u == (gen + 1u) * nloc) {
            __builtin_amdgcn_fence(__ATOMIC_RELEASE, "agent");
            asm volatile("s_waitcnt vmcnt(0)" ::: "memory");
            const unsigned og = xb_add(&bar[XB_TOP], 1u);
            const unsigned tg = og / nx;
            if (og + 1u == (tg + 1u) * nx) xb_add(&bar[XB_TOPGEN], 1u);
            else XB_SPIN(xb_ld(&bar[XB_TOPGEN]) == tg, bar);
            __builtin_amdgcn_fence(__ATOMIC_ACQUIRE, "agent");
            xb_add(&bar[XB_XGEN(b.x)], 1u);
            asm volatile("s_waitcnt vmcnt(0)" ::: "memory");
        } else {
            XB_SPIN(xb_ld(&bar[XB_XGEN(b.x)]) == gen, bar);
            __builtin_amdgcn_fence(__ATOMIC_ACQUIRE, "agent");
            asm volatile("s_waitcnt vmcnt(0)" ::: "memory");
        }
    }
    __syncthreads();
}

struct Frame {
    LAS unsigned char* lds;
    int tid, lane, wave;
    int vcu, G;
    float* out; unsigned char* ws;
};
enum { A_XP = 0, A_XS, A_CP, A_CS, A_WADA, A_BADA, A_N1G, A_N2G, A_WIN, A_QNG, A_KNG, A_WATT, A_WFOUR, A_WOUT, A_WPQ, A_KEYS, A_PU, A_PV, A_FING };
__device__ __forceinline__ const float* karg(int k) {
    unsigned off = (unsigned)k * 8u; asm volatile("" : "+s"(off));
    typedef const float* cfp;
    return *(const __attribute__((address_space(4))) cfp*)((const __attribute__((address_space(4))) char*)__builtin_amdgcn_kernarg_segment_ptr() + off);
}
#define LDS_WAIT() asm volatile("s_waitcnt lgkmcnt(0)" ::: "memory")
#define VM_WAIT() asm volatile("s_waitcnt vmcnt(0)" ::: "memory")
__device__ __forceinline__ unsigned f2bf(float f) { unsigned u = __builtin_bit_cast(unsigned, f); return (u + 0x7fffu + ((u >> 16) & 1u)) >> 16; }
__device__ __forceinline__ unsigned pk2(float lo, float hi) { return f2bf(lo) | (f2bf(hi) << 16); }
__device__ __forceinline__ float wave_sum(float v) {
#pragma unroll
    for (int o = 1; o < 64; o <<= 1) v += __shfl_xor(v, o);
    return v;
}
__device__ __forceinline__ float wave_max(float v) {
#pragma unroll
    for (int o = 1; o < 64; o <<= 1) v = fmaxf(v, __shfl_xor(v, o));
    return v;
}

__device__ __forceinline__ void p0_transpose_item(const float* W, int K, int N, bf16_t* WT, LAS float* scr, int item, int lane) {
    const int nblk = N / 32, kb = item / nblk, nb = item % nblk, k0 = 64 * kb, n0 = 32 * nb;
#pragma unroll 8
    for (int i = 0; i < 32; ++i) { const int kk = 2 * i + (lane >> 5); scr[kk * 33 + (lane & 31)] = W[(size_t)(k0 + kk) * N + n0 + (lane & 31)]; }
    LDS_WAIT(); asm volatile("" ::: "memory");
    const int c = lane & 7;
#pragma unroll
    for (int j = 0; j < 4; ++j) { const int n = (lane >> 3) + 8 * j; const LAS float* s = scr + (8 * c) * 33 + n;
        u32x4 o; o.x = pk2(s[0 * 33], s[1 * 33]); o.y = pk2(s[2 * 33], s[3 * 33]); o.z = pk2(s[4 * 33], s[5 * 33]); o.w = pk2(s[6 * 33], s[7 * 33]);
        *(GAS u32x4*)(WT + (size_t)(n0 + n) * K + k0 + 8 * c) = o; }
    LDS_WAIT(); asm volatile("" ::: "memory");
}
__device__ __forceinline__ void p0_transpose_item_fp8(const float* W, int K, int N, unsigned char* WT, LAS float* scr, int item, int lane, float sc) {
    const int nblk = N / 32, kb = item / nblk, nb = item % nblk, k0 = 64 * kb, n0 = 32 * nb;
#pragma unroll 8
    for (int i = 0; i < 32; ++i) { const int kk = 2 * i + (lane >> 5); scr[kk * 33 + (lane & 31)] = __builtin_amdgcn_fmed3f(W[(size_t)(k0 + kk) * N + n0 + (lane & 31)] * sc, -448.f, 448.f); }
    LDS_WAIT(); asm volatile("" ::: "memory");
    const int c = lane & 3;
#pragma unroll
    for (int j = 0; j < 2; ++j) { const int n = (lane >> 2) + 16 * j; const LAS float* t = scr + (16 * c) * 33 + n; unsigned w[4];
#pragma unroll
        for (int q = 0; q < 4; ++q) { int v = 0; v = __builtin_amdgcn_cvt_pk_fp8_f32(t[(4 * q + 0) * 33], t[(4 * q + 1) * 33], v, false); v = __builtin_amdgcn_cvt_pk_fp8_f32(t[(4 * q + 2) * 33], t[(4 * q + 3) * 33], v, true); w[q] = (unsigned)v; }
        *(GAS u32x4*)(WT + (size_t)(n0 + n) * K + k0 + 16 * c) = (u32x4){w[0], w[1], w[2], w[3]}; }
    LDS_WAIT(); asm volatile("" ::: "memory");
}
__device__ __forceinline__ u32x6 fp6_settle(u32x6 q) { unsigned a = q[0], b = q[1], c = q[2], d = q[3], e = q[4], f = q[5];
    asm volatile("s_nop 15\n\ts_nop 15" : "+v"(a), "+v"(b), "+v"(c), "+v"(d), "+v"(e), "+v"(f)); return (u32x6){a, b, c, d, e, f}; }
constexpr int FP6_INV_OFF = 132096;
__device__ __forceinline__ void fp6_calibrate(Frame& F) {
    f32x16 a, b, a2, b2;
#pragma unroll
    for (int k = 0; k < 16; ++k) { a[k] = (float)(k & 7) * 0.125f; b[k] = (float)((k + 16) & 7) * 0.125f; a2[k] = (float)(k >> 3) * 0.125f; b2[k] = (float)((k + 16) >> 3) * 0.125f; }
    const u32x6 q1 = fp6_settle(__builtin_amdgcn_cvt_scalef32_2xpk16_fp6_f32(a, b, 1.0f)), q2 = fp6_settle(__builtin_amdgcn_cvt_scalef32_2xpk16_fp6_f32(a2, b2, 1.0f));
    const f32x32 d1 = __builtin_amdgcn_cvt_scalef32_pk32_f32_fp6(q1, 1.0f), d2 = __builtin_amdgcn_cvt_scalef32_pk32_f32_fp6(q2, 1.0f);
    LAS int* inv = (LAS int*)(F.lds + FP6_INV_OFF) + 32 * F.wave;
#pragma unroll
    for (int i = 0; i < 32; ++i) { const int k = ((int)(d1[i] * 8.f + 0.5f) & 7) + 8 * ((int)(d2[i] * 8.f + 0.5f) & 3); inv[k] = i; }
    LDS_WAIT(); asm volatile("" ::: "memory");
}
__device__ __forceinline__ void p0_fp6_row(const float* src, unsigned char* dst, float* scale_out, LAS float* stg, const LAS int* inv, int lane) {
    f32x4 v[16]; float mx = 0.f;
#pragma unroll
    for (int j = 0; j < 16; ++j) { v[j] = *(const GAS f32x4*)(src + (j >> 3) * 2048 + 32 * lane + 4 * (j & 7)); mx = fmaxf(mx, fmaxf(fmaxf(fabsf(v[j].x), fabsf(v[j].y)), fmaxf(fabsf(v[j].z), fabsf(v[j].w)))); }
    mx = wave_max(mx);
    const float sc = mx > 0.f ? mx * (1.f / 7.f) : 1.f, isc = 1.f / sc;
#pragma unroll
    for (int j = 0; j < 16; ++j) { stg[(4 * j + 0) * 64 + lane] = v[j].x * isc; stg[(4 * j + 1) * 64 + lane] = v[j].y * isc; stg[(4 * j + 2) * 64 + lane] = v[j].z * isc; stg[(4 * j + 3) * 64 + lane] = v[j].w * isc; }
    LDS_WAIT(); asm volatile("" ::: "memory");
    unsigned w[12];
#pragma unroll
    for (int grp = 0; grp < 2; ++grp) { f32x16 a, b;
#pragma unroll
        for (int k = 0; k < 16; ++k) { a[k] = stg[(32 * grp + inv[k]) * 64 + lane]; b[k] = stg[(32 * grp + inv[16 + k]) * 64 + lane]; }
        const u32x6 q = fp6_settle(__builtin_amdgcn_cvt_scalef32_2xpk16_fp6_f32(a, b, 1.0f));
#pragma unroll
        for (int i = 0; i < 6; ++i) w[6 * grp + i] = q[i]; }
#pragma unroll
    for (int j = 0; j < 3; ++j) *(GAS u32x4*)(dst + 1024 * j + 16 * lane) = (u32x4){w[4 * j], w[4 * j + 1], w[4 * j + 2], w[4 * j + 3]};
    if (lane == 0) *scale_out = sc;
    LDS_WAIT(); asm volatile("" ::: "memory");
}

__device__ __forceinline__ void p0_prologue(Frame& F, const int parts = 31) {
    const int gw = F.vcu * NWAVES + F.wave, NGW = F.G * NWAVES, lane = F.lane;
    const float* const a_cp = karg(A_CP); const float* const a_cs = karg(A_CS); const float* const a_wada = karg(A_WADA);
    if (parts & 1) {
        LAS float* sl = (LAS float*)(F.lds);
        LAS float* red = (LAS float*)(F.lds + 65536);
        for (int i = F.tid; i < 4 * DM; i += NWAVES * 64) { const int cb = i >> 12, k = i & (DM - 1); const float c = (cb < 2 ? a_cp[cb * DM + k] : a_cs[(cb - 2) * DM + k]); sl[i] = c * sigmoidf_(c); }
        __syncthreads();
        float* modp = (float*)(F.ws + WS_MODP);
        for (int it = F.vcu; it < 96 * 8; it += F.G) {
            const int cbk = it % 96, ks = it / 96, kbase = ks * 512 + F.wave * 64;
            const GAS f32x4* wp = (const GAS f32x4*)(a_wada + (size_t)kbase * (6 * DM) + cbk * 256) + lane;
            f32x4 a0 = {0.f, 0.f, 0.f, 0.f}, a1 = a0, a2 = a0, a3 = a0;
#pragma unroll 8
            for (int k = 0; k < 64; ++k) { const f32x4 w = wp[(size_t)k * (6 * DM / 4)];
                const float s0 = sl[kbase + k], s1 = sl[DM + kbase + k], s2 = sl[2 * DM + kbase + k], s3 = sl[3 * DM + kbase + k];
                a0 += w * s0; a1 += w * s1; a2 += w * s2; a3 += w * s3; }
            LAS f32x4* r4 = (LAS f32x4*)red + F.wave * 256 + lane;
            r4[0] = a0; r4[64] = a1; r4[128] = a2; r4[192] = a3;
            __syncthreads();
            for (int o = F.tid; o < 1024; o += NWAVES * 64) { float s = 0.f;
#pragma unroll
                for (int w = 0; w < 8; ++w) s += red[w * 1024 + o];
                const int cb = o >> 8, col = o & 255; modp[((size_t)ks * 4 + cb) * (6 * DM) + cbk * 256 + col] = s; }
            __syncthreads();
        }
    }
    if (parts & 2) {
        LAS float* scr = (LAS float*)(F.lds + F.wave * 16384);
        auto w_scale = [&](const float* wsm, int slot) -> float { float q = 0.f;
#pragma unroll 8
          for (int i = 0; i < 128; ++i) { const f32x4 v = *(const GAS f32x4*)(wsm + (size_t)(i * 64 + lane) * 4); q += (v.x * v.x + v.y * v.y) + (v.z * v.z + v.w * v.w); }
          q = wave_sum(q) * (1.f / 32768.f);
          const float e = q > 0.f ? 3.f - 0.5f * __builtin_amdgcn_logf(q) : 0.f;
          const float sc = __builtin_amdgcn_exp2f(__builtin_rintf(e));
          if (gw == 0 && lane == 0) ((float*)(F.ws + WS_SCIN))[slot] = 1.f / sc;
          return sc; };
        const float sc_win = w_scale(karg(A_WIN), 0), sc_watt = w_scale(karg(A_WATT), 1), sc_wout = w_scale(karg(A_WOUT), 2), sc_wfour = w_scale(karg(A_WFOUR), 3);
        const float* const a_win = karg(A_WIN); const float* const a_watt = karg(A_WATT); const float* const a_wfour = karg(A_WFOUR); const float* const a_wout = karg(A_WOUT); const float* const a_wpq = karg(A_WPQ);
        constexpr int I_IN = (DM / 64) * (NIN / 32), I_ATT = (DM / 64) * (DM / 32), I_FOUR = (FW / 64) * (DM / 32), I_OUT = I_ATT, I_PQ = (DM / 64) * (PQW / 32);
        constexpr int NITEMS = I_IN + I_ATT + I_FOUR + I_OUT + I_PQ;
        for (int it = gw; it < NITEMS; it += NGW) {
            int r = it;
            if (r < I_IN) { p0_transpose_item_fp8(a_win, DM, NIN, F.ws + WS_WIN, scr, r, lane, sc_win); continue; } r -= I_IN;
            if (r < I_ATT) { p0_transpose_item_fp8(a_watt, DM, DM, F.ws + WS_WATT, scr, r, lane, sc_watt); continue; } r -= I_ATT;
            if (r < I_FOUR) { p0_transpose_item_fp8(a_wfour, FW, DM, F.ws + WS_WFOUR, scr, r, lane, sc_wfour); continue; } r -= I_FOUR;
            if (r < I_OUT) { p0_transpose_item_fp8(a_wout, DM, DM, F.ws + WS_WOUT, scr, r, lane, sc_wout); continue; } r -= I_OUT;
            p0_transpose_item(a_wpq, DM, PQW, (bf16_t*)(F.ws + WS_WPQ), scr, r, lane);
        }
    }
    const float* const a_pu = karg(A_PU); const float* const a_pv = karg(A_PV);
    __syncthreads();
    fp6_calibrate(F);
    if (parts & 4) {
        LAS float* stg = (LAS float*)(F.lds + F.wave * 16384); const LAS int* inv = (const LAS int*)(F.lds + FP6_INV_OFF) + 32 * F.wave;
        for (int r = gw; r < 2 * PN; r += NGW) {
            if (r < PN) p0_fp6_row(a_pu + (size_t)r * DM, F.ws + WS_U8 + (size_t)r * PROW, (float*)(F.ws + WS_SCU) + r, stg, inv, lane);
            else { const int q = r - PN; p0_fp6_row(a_pv + (size_t)q * DM, F.ws + WS_V8 + (size_t)q * PROW, (float*)(F.ws + WS_SCV) + q, stg, inv, lane); }
        }
    }
    if (parts & 8) {
        bf16_t* d128 = (bf16_t*)(F.ws + WS_D128); bf16_t* ds64 = (bf16_t*)(F.ws + WS_DS64); bf16_t* ds32 = (bf16_t*)(F.ws + WS_DS32);
        for (int i = F.vcu * (NWAVES * 64) + F.tid; i < 3 * 65536; i += F.G * NWAVES * 64) {
            const int which = i >> 16, r = (i >> 8) & 255, k = i & 255; float v;
            if (which == 0) {
                const int k2 = r & 127, n2 = k & 127; const float rev = (float)((k2 * n2) & 127) * (1.f / 128.f);
                const float cs = __builtin_amdgcn_cosf(rev), sn = __builtin_amdgcn_sinf(rev);
                v = (r < 128) ? (k < 128 ? cs : -sn) : (k < 128 ? -sn : -cs);
            } else {
                const int S1 = which == 1 ? 64 : 32; v = 0.f;
                if (r < S1 && k < 2 * S1) { const int n1 = k & (S1 - 1); const float rev = (float)((r * n1) & (S1 - 1)) / (float)S1; v = (k < S1) ? __builtin_amdgcn_cosf(rev) : __builtin_amdgcn_sinf(rev); }
            }
            (which == 0 ? d128 : (which == 1 ? ds64 : ds32))[i & 65535] = (bf16_t)f2bf(v);
        }
    }
    if (parts & 16) {
        bf16_t* cs = (bf16_t*)(F.ws + WS_CS);
        for (int i = F.vcu * (NWAVES * 64) + F.tid; i < 512 * 256; i += F.G * NWAVES * 64) {
            const int r = i >> 8, k = i & 255, part = r >> 8, c = r & 255;
            const float rev = (float)((c * k) & 255) * (1.f / 256.f) - (part ? 0.25f : 0.f);
            cs[i] = (bf16_t)f2bf(__builtin_amdgcn_cosf(rev) * (1.f / 16.f));
        }
        bf16_t* kb = (bf16_t*)(F.ws + WS_KEYS); const float* const a_keys = karg(A_KEYS);
        for (int i = F.vcu * (NWAVES * 64) + F.tid; i < PH * 2 * PNK * PHALF; i += F.G * NWAVES * 64) kb[i] = (bf16_t)f2bf(a_keys[i]);
    }
}

template <bool SECOND>
__device__ __forceinline__ void p_normmod(Frame& F) {
    LAS float* Av = (LAS float*)(F.lds); LAS float* Bv = Av + DM;
    const float* const g = karg(SECOND ? A_N2G : A_N1G); const float* const a_bada = karg(A_BADA); const float* const a_xp = karg(A_XP); const float* const a_xs = karg(A_XS);
    const float* modp = (const float*)(F.ws + WS_MODP); const float* modf = (const float*)(F.ws + WS_MODF);
    bf16_t* H = (bf16_t*)(F.ws + WS_H);
    for (int cb = 0; cb < 4; ++cb) {
        for (int i = F.tid; i < DM; i += NWAVES * 64) {
            float sh, sc;
            if (SECOND) { sh = modf[cb * 6 * DM + 3 * DM + i]; sc = modf[cb * 6 * DM + 4 * DM + i]; }
            else { sh = a_bada[i]; sc = a_bada[DM + i];
#pragma unroll
                for (int ks = 0; ks < 8; ++ks) { sh += modp[((size_t)ks * 4 + cb) * (6 * DM) + i]; sc += modp[((size_t)ks * 4 + cb) * (6 * DM) + DM + i]; } }
            Av[i] = g[i] * (1.f + sc); Bv[i] = sh;
        }
        __syncthreads();
        const int base = cb == 0 ? 0 : (cb == 1 ? SP : (cb == 2 ? TP : TP + SS)), n = cb < 2 ? SP : SS;
        for (int r = F.vcu * NWAVES + F.wave; r < n; r += F.G * NWAVES) {
            const int m = base + r;
            if constexpr (SECOND) {
                const GAS u32x4* xr = (const GAS u32x4*)((const bf16_t*)(F.ws + WS_GF) + (size_t)m * DM) + F.lane;
                u32x4 raw[8]; float ss = 0.f;
#pragma unroll
                for (int j = 0; j < 8; ++j) raw[j] = xr[64 * j];
                __builtin_amdgcn_sched_barrier(0);
                f32x4 v[8][2];
#pragma unroll
                for (int j = 0; j < 8; ++j) { unpack8(raw[j], v[j][0], v[j][1]);
                    ss += ((v[j][0].x * v[j][0].x + v[j][0].y * v[j][0].y) + (v[j][0].z * v[j][0].z + v[j][0].w * v[j][0].w)) + ((v[j][1].x * v[j][1].x + v[j][1].y * v[j][1].y) + (v[j][1].z * v[j][1].z + v[j][1].w * v[j][1].w)); }
                const float rs = __builtin_amdgcn_rsqf(wave_sum(ss) * (1.f / DM) + EPS);
                GAS u32x4* o16 = (GAS u32x4*)(H + (size_t)m * DM) + F.lane;
#pragma unroll
                for (int j = 0; j < 8; ++j) { const int c4 = 2 * (F.lane + 64 * j);
                    const f32x4 a0 = ((LAS f32x4*)Av)[c4], a1 = ((LAS f32x4*)Av)[c4 + 1], b0 = ((LAS f32x4*)Bv)[c4], b1 = ((LAS f32x4*)Bv)[c4 + 1];
                    o16[64 * j] = pack8(v[j][0] * rs * a0 + b0, v[j][1] * rs * a1 + b1); }
            } else {
            const GAS f32x4* xr = (const GAS f32x4*)(m < TP ? a_xp + (size_t)m * DM : a_xs + (size_t)(m - TP) * DM) + F.lane;
            f32x4 v[16]; float ss = 0.f;
#pragma unroll
            for (int j = 0; j < 16; ++j) v[j] = xr[64 * j];
            __builtin_amdgcn_sched_barrier(0);
#pragma unroll
            for (int j = 0; j < 16; ++j) ss += (v[j].x * v[j].x + v[j].y * v[j].y) + (v[j].z * v[j].z + v[j].w * v[j].w);
            const float rs = __builtin_amdgcn_rsqf(wave_sum(ss) * (1.f / DM) + EPS);
            GAS unsigned* o4 = (GAS unsigned*)((unsigned char*)H + (size_t)m * DM) + F.lane;
#pragma unroll
            for (int j = 0; j < 16; ++j) { const f32x4 a = ((LAS f32x4*)Av)[F.lane + 64 * j], b = ((LAS f32x4*)Bv)[F.lane + 64 * j];
                f32x4 y = v[j] * rs * a + b;
#pragma unroll
                for (int i = 0; i < 4; ++i) y[i] = __builtin_amdgcn_fmed3f(y[i], -448.f, 448.f);
                int w = 0; w = __builtin_amdgcn_cvt_pk_fp8_f32(y.x, y.y, w, false); w = __builtin_amdgcn_cvt_pk_fp8_f32(y.z, y.w, w, true); o4[64 * j] = (unsigned)w; }
            }
        }
        __syncthreads();
    }
    if (!SECOND) {
        float* mf = (float*)(F.ws + WS_MODF);
        for (int i = F.vcu * (NWAVES * 64) + F.tid; i < 4 * 6 * DM; i += F.G * NWAVES * 64) { const int cb = i / (6 * DM), n = i % (6 * DM); float s = a_bada[n];
#pragma unroll
            for (int ks = 0; ks < 8; ++ks) s += modp[((size_t)ks * 4 + cb) * (6 * DM) + n];
            mf[i] = s; }
    }
}

__device__ __forceinline__ u32x2 pack8_fp8(f32x4 y0, f32x4 y1) { int w0 = 0, w1 = 0;
#pragma unroll
    for (int i = 0; i < 4; ++i) { y0[i] = __builtin_amdgcn_fmed3f(y0[i], -448.f, 448.f); y1[i] = __builtin_amdgcn_fmed3f(y1[i], -448.f, 448.f); }
    w0 = __builtin_amdgcn_cvt_pk_fp8_f32(y0[0], y0[1], w0, false); w0 = __builtin_amdgcn_cvt_pk_fp8_f32(y0[2], y0[3], w0, true);
    w1 = __builtin_amdgcn_cvt_pk_fp8_f32(y1[0], y1[1], w1, false); w1 = __builtin_amdgcn_cvt_pk_fp8_f32(y1[2], y1[3], w1, true);
    return (u32x2){(unsigned)w0, (unsigned)w1}; }
typedef f32x4 AccT[2][2][4][2];
#define EPI_LOOP_BEGIN _Pragma("unroll") for (int ai = 0; ai < 2; ++ai) _Pragma("unroll") for (int m = 0; m < 4; ++m) { const int row = u.pm * 256 + wr * 64 + fr + ai * 128 + m * 16; _Pragma("unroll") for (int bj = 0; bj < 2; ++bj) { const int ct = wc * 32 + 8 * fq + bj * 128; f32x4 v0 = acc[ai][bj][m][0], v1 = acc[ai][bj][m][1];
#define EPI_LOOP_END } }

struct EpiProj {
    unsigned char* ws;
    __device__ __forceinline__ void operator()(const AccT& acc, const pg8::Unit& u, int wr, int wc, int fr, int fq) const {
        const float isc = *(const GAS float*)(ws + WS_SCIN + 0 * (size_t)(fr & 0));
        const int colt = u.pn * 256; unsigned char* base; int ld, c0, kind = 1;
        if (colt < 4096) { base = ws + WS_Q; ld = 4096; c0 = colt; }
        else if (colt < 5120) { base = ws + WS_K; ld = 1024; c0 = colt - 4096; }
        else if (colt < 6144) { base = ws + WS_V; ld = 1024; c0 = colt - 5120; }
        else if (colt < 8192) { base = ws + WS_F; ld = 2048; c0 = colt - 6144; kind = 0; }
        else if (colt < 12288) { base = ws + WS_GA8; ld = 4096; c0 = colt - 8192; kind = 2; }
        else { base = ws + WS_GF; ld = 4096; c0 = colt - 12288; kind = 2; }
        if (kind == 0) {
            EPI_LOOP_BEGIN
                v0 = v0 * isc; v1 = v1 * isc;
                *(GAS u32x4*)((bf16_t*)base + (size_t)row * ld + c0 + ct) = pack8(v0, v1);
            EPI_LOOP_END
        } else if (kind == 1) {
            EPI_LOOP_BEGIN
                v0 = v0 * isc; v1 = v1 * isc;
                *(GAS u32x2*)(base + (size_t)row * ld + c0 + ct) = pack8_fp8(v0, v1);
            EPI_LOOP_END
        } else {
            EPI_LOOP_BEGIN
                v0 = v0 * isc; v1 = v1 * isc;
#pragma unroll
                for (int j = 0; j < 4; ++j) { v0[j] = sigmoidf_(v0[j]) * GATE8; v1[j] = sigmoidf_(v1[j]) * GATE8; }
                *(GAS u32x2*)(base + (size_t)row * ld + c0 + ct) = pack8_u8(v0, v1);
            EPI_LOOP_END
        }
    }
};
struct GemmSt0 {
    const bf16_t* A; const bf16_t* Fb; int K, lda, ldb; int S1, lg_tpg, lg_tps; long row_base, S;
    __device__ __forceinline__ const char* a_ptr(const pg8::Unit& u) const { return (const char*)A + (size_t)u.pm * 256 * lda * 2; }
    __device__ __forceinline__ const char* b_ptr(const pg8::Unit& u) const { const long g = u.pn >> lg_tpg, tt = u.pn & ((1 << lg_tpg) - 1), b = tt >> lg_tps, ti = tt & ((1 << lg_tps) - 1);
        return (const char*)Fb + ((row_base + b * S + 2 * ti) * ldb + g * 256) * 2; }
    __device__ __forceinline__ int b_rowoff(int Rb) const { return S1 * Rb; }
    __device__ __forceinline__ size_t b_hstep() const { return (size_t)ldb * 2; }
};
struct EpiSt0 {
    bf16_t* L0; int S1, lg_tpg, lg_tps;
    __device__ __forceinline__ void operator()(const AccT& acc, const pg8::Unit& u, int wr_, int wc_, int, int) const {
        const int tz = opaque_tid(wr_ * 4 + wc_), wid = __builtin_amdgcn_readfirstlane(tz >> 6), lane = tz & 63, wr = wid >> 2, wc = wid & 3, fr = lane & 15, fq = lane >> 4;
        const int g = u.pn >> lg_tpg, tt = u.pn & ((1 << lg_tpg) - 1), b = tt >> lg_tps, ti = tt & ((1 << lg_tps) - 1), bg = b * 8 + g, part = u.pm;
        const unsigned loff = ((unsigned)(64 * wr + fr) * (unsigned)S1 * 256u + (unsigned)(wc * 32 + 8 * fq)) * 2u;
#pragma unroll
        for (int ai = 0; ai < 2; ++ai)
#pragma unroll
            for (int m = 0; m < 4; ++m)
#pragma unroll
                for (int bj = 0; bj < 2; ++bj) {
                    const char* ub = (const char*)(L0 + ((((size_t)(bg * 256 + 128 * ai + 16 * m) * S1 + 2 * ti + bj) * 2 + part) * 128));
                    *(GAS u32x4*)(ub + loff) = pack8(acc[ai][bj][m][0], acc[ai][bj][m][1]);
                }
    }
};
struct EpiSt1 {
    bf16_t* L1p; bf16_t* L1s;
    __device__ __forceinline__ void operator()(const AccT& acc, const pg8::Unit& u, int wr_, int wc_, int, int) const {
        const int tz = opaque_tid(wr_ * 4 + wc_), wid = __builtin_amdgcn_readfirstlane(tz >> 6), lane = tz & 63, wr = wid >> 2, wc = wid & 3, fr = lane & 15, fq = lane >> 4;
        const bool smp = u.pn >= 512; const int lgS1 = smp ? 6 : 5, S1 = 1 << lgS1, nt0 = (smp ? u.pn - 512 : u.pn) * 256;
        const float invS = smp ? (1.f / 8192.f) : (1.f / 4096.f);
        const char* base = (const char*)(smp ? L1s : L1p);
#pragma unroll
        for (int m = 0; m < 4; ++m)
#pragma unroll
            for (int bj = 0; bj < 2; ++bj) {
                const int k2 = 64 * wr + 16 * m + fr, n0 = nt0 + wc * 32 + 8 * fq + bj * 128, bgc = n0 >> lgS1, n10 = n0 & (S1 - 1), bg = bgc >> 8, c = bgc & 255;
                const f32x4 r0 = acc[0][bj][m][0], r1 = acc[0][bj][m][1], i0 = acc[1][bj][m][0], i1 = acc[1][bj][m][1];
                float re[8] = {r0[0], r0[1], r0[2], r0[3], r1[0], r1[1], r1[2], r1[3]}, im[8] = {i0[0], i0[1], i0[2], i0[3], i1[0], i1[1], i1[2], i1[3]}, ore[8], oim[8];
#pragma unroll
                for (int j = 0; j < 8; ++j) { const float rev = (float)((n10 + j) * k2) * invS, cs = __builtin_amdgcn_cosf(rev), sn = __builtin_amdgcn_sinf(rev);
                    ore[j] = re[j] * cs + im[j] * sn; oim[j] = im[j] * cs - re[j] * sn; }
                const unsigned off = (((unsigned)((bg * 128 + k2) * 256 + c) * 2u) * (unsigned)S1 + (unsigned)n10) * 2u;
                *(GAS u32x4*)(base + off) = (u32x4){cvt_pk_bf16(ore[0], ore[1]), cvt_pk_bf16(ore[2], ore[3]), cvt_pk_bf16(ore[4], ore[5]), cvt_pk_bf16(ore[6], ore[7])};
                *(GAS u32x4*)(base + off + 2 * S1) = (u32x4){cvt_pk_bf16(oim[0], oim[1]), cvt_pk_bf16(oim[2], oim[3]), cvt_pk_bf16(oim[4], oim[5]), cvt_pk_bf16(oim[6], oim[7])};
            }
    }
};
struct EpiSt2 {
    unsigned char* out; int S1; long S; float scale;
    __device__ __forceinline__ void operator()(const AccT& acc, const pg8::Unit& u, int wr_, int wc_, int, int) const {
        const int tz = opaque_tid(wr_ * 4 + wc_), wid = __builtin_amdgcn_readfirstlane(tz >> 6), lane = tz & 63, wr = wid >> 2, wc = wid & 3, fr = lane & 15, fq = lane >> 4;
        const long bg = u.pn >> 7, k2 = u.pn & 127, b = bg >> 3, g = bg & 7;
        if (wr == 0) {
#pragma unroll
            for (int m = 0; m < 4; ++m) if (16 * m < S1)
#pragma unroll
                for (int bj = 0; bj < 2; ++bj) {
                    const long k1 = 16 * m + fr, ct = wc * 32 + 8 * fq + bj * 128;
                    *(GAS u32x2*)(out + (b * S + 128 * k1 + k2) * FW + g * 256 + ct) = pack8_fp8(acc[0][bj][m][0] * scale, acc[0][bj][m][1] * scale);
                }
        }
    }
};
#define EPI_ROWCOL(ai, m, bj) const int row = u.pm * 256 + wr * 64 + fr + (ai) * 128 + (m) * 16, ct = wc * 32 + 8 * fq + (bj) * 128
struct EpiGateA {
    bf16_t* ga; const unsigned char* ga8; const float* scp;
    __device__ __forceinline__ void operator()(const AccT& acc, const pg8::Unit& u, int wr, int wc, int fr, int fq) const {
        const float sc = *(const GAS float*)(scp + (fr & 0)) * (1.f / (ACT8 * GATE8));
#pragma unroll
        for (int ai = 0; ai < 2; ++ai) {
            u32x2 gv[4][2];
#pragma unroll
            for (int m = 0; m < 4; ++m)
#pragma unroll
                for (int bj = 0; bj < 2; ++bj) { EPI_ROWCOL(ai, m, bj); gv[m][bj] = *(const GAS u32x2*)(ga8 + (size_t)row * DM + u.pn * 256 + ct); }
            __builtin_amdgcn_sched_barrier(0);
#pragma unroll
            for (int m = 0; m < 4; ++m)
#pragma unroll
                for (int bj = 0; bj < 2; ++bj) { EPI_ROWCOL(ai, m, bj); f32x4 g0, g1; unpack8_u8(gv[m][bj], g0, g1);
                    *(GAS u32x4*)(ga + (size_t)row * DM + u.pn * 256 + ct) = pack8(g0 * (acc[ai][bj][m][0] * sc), g1 * (acc[ai][bj][m][1] * sc)); }
        }
    }
};
struct EpiGateF {
    const bf16_t* ga; const unsigned char* gf; unsigned char* m8; const float* scp;
    __device__ __forceinline__ void operator()(const AccT& acc, const pg8::Unit& u, int wr, int wc, int fr, int fq) const {
        const float sc = *(const GAS float*)(scp + (fr & 0)) * (1.f / GATE8);
#pragma unroll
        for (int ai = 0; ai < 2; ++ai) {
            u32x4 mv[4][2]; u32x2 gv[4][2];
#pragma unroll
            for (int m = 0; m < 4; ++m)
#pragma unroll
                for (int bj = 0; bj < 2; ++bj) { EPI_ROWCOL(ai, m, bj); mv[m][bj] = *(const GAS u32x4*)(ga + (size_t)row * DM + u.pn * 256 + ct); gv[m][bj] = *(const GAS u32x2*)(gf + (size_t)row * DM + u.pn * 256 + ct); }
            __builtin_amdgcn_sched_barrier(0);
#pragma unroll
            for (int m = 0; m < 4; ++m)
#pragma unroll
                for (int bj = 0; bj < 2; ++bj) { EPI_ROWCOL(ai, m, bj); f32x4 m0, m1, g0, g1; unpack8(mv[m][bj], m0, m1); unpack8_u8(gv[m][bj], g0, g1);
                    *(GAS u32x2*)(m8 + (size_t)row * DM + u.pn * 256 + ct) = pack8_fp8(m0 + g0 * (acc[ai][bj][m][0] * sc), m1 + g1 * (acc[ai][bj][m][1] * sc)); }
        }
    }
};
struct EpiResid {
    const float* xp; const float* xs; const float* modf; bf16_t* out; const float* scp;
    __device__ __forceinline__ void operator()(const AccT& acc, const pg8::Unit& u, int wr, int wc, int fr, int fq) const {
        const float sc = *(const GAS float*)(scp + (fr & 0));
        const int cb = cb_of_row(u.pm * 256); const float* g1 = modf + (size_t)cb * 6 * DM + 2 * DM + u.pn * 256;
        f32x4 q[2][2];
#pragma unroll
        for (int bj = 0; bj < 2; ++bj) { const int ct = wc * 32 + 8 * fq + bj * 128; q[bj][0] = *(const GAS f32x4*)(g1 + ct) * sc; q[bj][1] = *(const GAS f32x4*)(g1 + ct + 4) * sc; }
#pragma unroll
        for (int ai = 0; ai < 2; ++ai) {
            f32x4 xv[4][2][2];
#pragma unroll
            for (int m = 0; m < 4; ++m)
#pragma unroll
                for (int bj = 0; bj < 2; ++bj) { EPI_ROWCOL(ai, m, bj);
                    const float* xr = (row < TP ? xp + (size_t)row * DM : xs + (size_t)(row - TP) * DM) + u.pn * 256 + ct;
                    xv[m][bj][0] = *(const GAS f32x4*)xr; xv[m][bj][1] = *(const GAS f32x4*)(xr + 4); }
            __builtin_amdgcn_sched_barrier(0);
#pragma unroll
            for (int m = 0; m < 4; ++m)
#pragma unroll
                for (int bj = 0; bj < 2; ++bj) { EPI_ROWCOL(ai, m, bj);
                    *(GAS u32x4*)(out + (size_t)row * DM + u.pn * 256 + ct) = pack8(xv[m][bj][0] + q[bj][0] * acc[ai][bj][m][0], xv[m][bj][1] + q[bj][1] * acc[ai][bj][m][1]); }
        }
    }
};
struct EpiPlain {
    bf16_t* out; int ld;
    __device__ __forceinline__ void operator()(const AccT& acc, const pg8::Unit& u, int wr, int wc, int fr, int fq) const {
        EPI_LOOP_BEGIN
            *(GAS u32x4*)(out + (size_t)row * ld + u.pn * 256 + ct) = pack8(v0, v1);
        EPI_LOOP_END
    }
};

__device__ __forceinline__ void p3_qk_rope(Frame& F) {
    const int lane = F.lane, li = lane & 15;
    bf16_t* Q = (bf16_t*)(F.ws + WS_Q); bf16_t* K = (bf16_t*)(F.ws + WS_K); unsigned char* const O8 = (unsigned char*)F.out;
    float gq[8], gk[8], ifr[4]; const float* const a_qng = karg(A_QNG); const float* const a_kng = karg(A_KNG);
#pragma unroll
    for (int d = 0; d < 8; ++d) { gq[d] = a_qng[8 * li + d]; gk[d] = a_kng[8 * li + d]; }
#pragma unroll
    for (int t = 0; t < 4; ++t) ifr[t] = __builtin_amdgcn_exp2f(-(float)((4 * li + t) & 31) * (13.287712379549449f / 32.f));
    for (int m = F.vcu * NWAVES + F.wave; m < TT; m += F.G * NWAVES) {
        const int pos = m < TP ? (m & (SP - 1)) : ((m - TP) & (SS - 1));
        const float id = (float)(li < 8 ? (pos >> 6) : (pos & 63));
        float cs[4], sn[4];
#pragma unroll
        for (int t = 0; t < 4; ++t) { const float ang = id * ifr[t]; cs[t] = __cosf(ang); sn[t] = __sinf(ang); }
        u32x2 raw[10];
#pragma unroll
        for (int jj = 0; jj < 10; ++jj) raw[jj] = *(jj < 8 ? (const GAS u32x2*)((const unsigned char*)Q + (size_t)m * 4096 + jj * 512 + lane * 8) : (const GAS u32x2*)((const unsigned char*)K + (size_t)m * 1024 + (jj - 8) * 512 + lane * 8));
        __builtin_amdgcn_sched_barrier(0);
#pragma unroll
        for (int jj = 0; jj < 10; ++jj) {
            GAS u32x4* p = jj < 8 ? (GAS u32x4*)(Q + (size_t)m * 4096 + jj * 512 + lane * 8) : (GAS u32x4*)(K + (size_t)m * 1024 + (jj - 8) * 512 + lane * 8);
            f32x4 v0, v1; unpack8_fp8(raw[jj], v0, v1);
            float ss = (v0.x * v0.x + v0.y * v0.y) + (v0.z * v0.z + v0.w * v0.w) + (v1.x * v1.x + v1.y * v1.y) + (v1.z * v1.z + v1.w * v1.w);
            ss += __shfl_xor(ss, 1); ss += __shfl_xor(ss, 2); ss += __shfl_xor(ss, 4); ss += __shfl_xor(ss, 8);
            const float rs = __builtin_amdgcn_rsqf(ss * (1.f / 128.f) + EPS);
            const float* g = jj < 8 ? gq : gk;
            float y[8] = {v0.x * rs * g[0], v0.y * rs * g[1], v0.z * rs * g[2], v0.w * rs * g[3], v1.x * rs * g[4], v1.y * rs * g[5], v1.z * rs * g[6], v1.w * rs * g[7]};
            float o[8];
#pragma unroll
            for (int t = 0; t < 4; ++t) { o[2 * t] = y[2 * t] * cs[t] - y[2 * t + 1] * sn[t]; o[2 * t + 1] = y[2 * t] * sn[t] + y[2 * t + 1] * cs[t]; }
#if ATTN_FP8
            (void)p;
            const float qm = jj < 8 ? attn8::QMUL : 1.f;
            const u32x2 pk = pack8_fp8((f32x4){o[0], o[1], o[2], o[3]} * qm, (f32x4){o[4], o[5], o[6], o[7]} * qm);
            if (jj < 8) *(GAS u32x2*)(O8 + DO_Q8 + (size_t)m * 4096 + jj * 512 + lane * 8) = pk;
            else { const int kvh = (jj - 8) * 4 + (lane >> 4), key = m & 63;
                *(GAS u32x2*)(O8 + DO_K8 + ((size_t)(m >> 6) * 8 + kvh) * 8192 + key * 128 + (((li >> 1) ^ ((key >> 1) & 7)) << 4) + (li & 1) * 8) = pk; }
#else
            *p = (u32x4){cvt_pk_bf16(o[0], o[1]), cvt_pk_bf16(o[2], o[3]), cvt_pk_bf16(o[4], o[5]), cvt_pk_bf16(o[6], o[7])};
#endif
        }
    }
}

__device__ __forceinline__ void p3_vt(Frame& F) {
    const int lane = F.lane;
    const unsigned char* V = F.ws + WS_V; unsigned char* const O8 = (unsigned char*)F.out + DO_V8;
    for (int item = F.vcu * NWAVES + F.wave; item < (TT / 64) * 16; item += F.G * NWAVES) {
        const int tile = item >> 4, kvh = (item >> 1) & 7, d = (item & 1) * 64 + lane;
        const GAS unsigned char* src = (const GAS unsigned char*)(V + (size_t)tile * 64 * 1024 + kvh * 128 + d);
        unsigned raw[64];
#pragma unroll
        for (int k = 0; k < 64; ++k) raw[k] = src[(size_t)k * 1024];
        unsigned char* row = O8 + ((size_t)tile * 8 + kvh) * 8192 + d * 64; const int sv = (d >> 2) & 3;
#pragma unroll
        for (int c = 0; c < 4; ++c) { u32x4 w;
#pragma unroll
            for (int q = 0; q < 4; ++q) { unsigned x = 0;
#pragma unroll
                for (int b = 0; b < 4; ++b) { const int beta = 16 * c + 4 * q + b, hi = beta >> 5, pp = (beta >> 4) & 1, r = beta & 15, key = 32 * pp + (r & 3) + 8 * (r >> 2) + 4 * hi;
                    x |= raw[key] << (8 * b); }
                w[q] = x; }
            *(GAS u32x4*)(row + ((c ^ sv) << 4)) = w; }
    }
}

__device__ __forceinline__ void p4_attention(Frame& F, char* lds, bool dummy) {
    bf16_t* Q = (bf16_t*)(F.ws + WS_Q); const bf16_t* K = (const bf16_t*)(F.ws + WS_K); const bf16_t* V = (const bf16_t*)(F.ws + WS_V);
    for (int L = blockIdx.x; L < 2048 + 1024; L += F.G) {
        const bool smp = L < 2048; const long Lp = smp ? L : L - 2048;
        const long x = Lp & 7, w = (Lp >> 3) & 31, i = Lp >> 8;
        const long j = smp ? (i >> 2) : (i >> 1), uu = smp ? ((i & 3) * 32 + w) : ((i & 1) * 32 + w);
        const long pair = x + 8 * j, b = pair >> 3, kvh = pair & 7;
        const long h = kvh * 4 + (smp ? (uu >> 5) : (uu >> 4)), qb = smp ? (uu & 31) : (uu & 15), S = smp ? SS : SP;
        const long r0 = (smp ? (long)TP : 0) + b * S;
        bf16_t* qp = Q + (r0 + qb * 256) * 4096 + h * 128;
        unsigned char* op = (dummy ? (unsigned char*)F.out + (size_t)256 * MiB : F.ws + WS_H) + (r0 + qb * 256) * 4096 + h * 128;
#if ATTN_FP8
        (void)qp; (void)K; (void)V; (void)lds;
        const unsigned char* const o8 = (const unsigned char*)F.out;
        if (dummy) attn8::body<ATT_PROBE>(o8 + DO_Q8 + (r0 + qb * 256) * 4096 + h * 128, o8 + DO_K8 + ((r0 >> 6) * 8 + kvh) * 8192, o8 + DO_V8 + ((r0 >> 6) * 8 + kvh) * 8192, op, (int)S, (A8_LAS char*)F.lds, F.wave);
        else attn8::body128(o8 + DO_Q8 + (r0 + qb * 256) * 4096 + h * 128, o8 + DO_K8 + ((r0 >> 6) * 8 + kvh) * 8192, o8 + DO_V8 + ((r0 >> 6) * 8 + kvh) * 8192, op, (int)S, (A8_LAS char*)F.lds, F.wave);
#else
        attn::attn_dense_body<attn::bf16>((const attn::bf16*)qp, (const attn::bf16*)(K + r0 * 1024 + kvh * 128), (const attn::bf16*)(V + r0 * 1024 + kvh * 128), (float*)op, (int)S, lds);
#endif
    }
}

__device__ __forceinline__ unsigned f2ord(float f) { const unsigned u = __float_as_uint(f); return (u & 0x80000000u) ? ~u : (u | 0x80000000u); }
__device__ __forceinline__ float ord2f(unsigned o) { return __uint_as_float((o & 0x80000000u) ? (o & 0x7fffffffu) : ~o); }
__device__ __forceinline__ unsigned umax3(unsigned a, unsigned b, unsigned c) { return max(max(a, b), c); }

#define CE_DESC(x, y) do { const unsigned _hi = max(x, y), _lo = min(x, y); x = _hi; y = _lo; } while (0)
__device__ __forceinline__ void bitonic_merge16(unsigned (&a)[16]) {
#pragma unroll
    for (int j = 8; j >= 1; j >>= 1)
#pragma unroll
        for (int i = 0; i < 16; ++i) { const int l = i ^ j; if (l > i) CE_DESC(a[i], a[l]); }
}
__device__ __forceinline__ void sort16(unsigned (&a)[16]) {
#pragma unroll
    for (int k = 2; k <= 16; k <<= 1)
#pragma unroll
        for (int j = k >> 1; j >= 1; j >>= 1)
#pragma unroll
            for (int i = 0; i < 16; ++i) { const int l = i ^ j; if (l > i) { if ((i & k) == 0) CE_DESC(a[i], a[l]); else CE_DESC(a[l], a[i]); } }
}
__device__ __forceinline__ void top16_merge(unsigned (&a)[16], const unsigned (&b)[16]) {
#pragma unroll
    for (int i = 0; i < 16; ++i) a[i] = max(a[i], b[15 - i]);
    bitonic_merge16(a);
}

__device__ __forceinline__ void p9_route(Frame& F) {
    const int lane = F.lane, r32 = lane & 31, hi = lane >> 5;
    const bf16_t* PQ = (const bf16_t*)(F.ws + WS_Q); const bf16_t* KB = (const bf16_t*)(F.ws + WS_KEYS);
    int* IDX = (int*)(F.ws + WS_IDX); float* GATE = (float*)(F.ws + WS_GATE);
    LAS unsigned* cpt = (LAS unsigned*)(F.lds + F.wave * 8192) + lane * 25;
    for (int task = F.vcu * NWAVES + F.wave; task < (TT / 32) * PH; task += F.G * NWAVES) {
        const int tile = task >> 3, h = task & 7, t0 = tile * 32;
        unsigned key[8][16];
        {
            const bf16_t* qrow = PQ + (size_t)(t0 + r32) * PQW + h * 256 + hi * 8;
            f32x16 acc[2][4];
            unsigned koff = (unsigned)(((h * 256 + r32) * 128 + hi * 8) * 2);
            asm volatile("" : "+v"(koff));
#pragma unroll
            for (int p = 0; p < 2; ++p) {
                bf16x8 bq[8];
#pragma unroll
                for (int ks = 0; ks < 8; ++ks) bq[ks] = *(const GAS bf16x8*)(qrow + p * 128 + ks * 16);
#pragma unroll
                for (int nb = 0; nb < 4; ++nb) {
                    const char* krow = (const char*)KB + (size_t)(p * 128 + nb * 32) * 256;
                    bf16x8 ka[8];
#pragma unroll
                    for (int ks = 0; ks < 8; ++ks) ka[ks] = *(const GAS bf16x8*)(krow + koff + ks * 32);
                    f32x16 a = {};
#pragma unroll
                    for (int ks = 0; ks < 8; ++ks) a = __builtin_amdgcn_mfma_f32_32x32x16_bf16(ka[ks], bq[ks], a, 0, 0, 0);
                    acc[p][nb] = a;
                    __builtin_amdgcn_sched_barrier(0);
                }
            }
#pragma unroll
            for (int nb = 0; nb < 4; ++nb)
#pragma unroll
                for (int r = 0; r < 16; ++r) {
                    auto rr = __builtin_amdgcn_permlane32_swap(__float_as_uint(acc[0][nb][r]), __float_as_uint(acc[1][nb][r]), false, false);
                    unsigned k0 = (f2ord(__uint_as_float(rr[0])) & ~127u) | (unsigned)r, k1 = (f2ord(__uint_as_float(rr[1])) & ~127u) | (unsigned)r;
                    asm volatile("" : "+v"(k0), "+v"(k1));
                    key[2 * nb][r] = k0 | (unsigned)(nb << 5); key[2 * nb + 1][r] = k1 | (unsigned)(16 + (nb << 5));
                }
        }
#pragma unroll
        for (int g = 0; g < 8; ++g) sort16(key[g]);
        top16_merge(key[0], key[1]); top16_merge(key[2], key[3]); top16_merge(key[4], key[5]); top16_merge(key[6], key[7]);
        top16_merge(key[0], key[2]); top16_merge(key[4], key[6]); top16_merge(key[0], key[4]);
        float va[16], vb[16]; int ia[16], ib[16];
#pragma unroll
        for (int i = 0; i < 16; ++i) { auto rr = __builtin_amdgcn_permlane32_swap(key[0][i], key[0][i], false, false);
            const unsigned la = rr[0] & 127u, lb = rr[1] & 127u;
            va[i] = ord2f(rr[0] & ~127u); ia[i] = (int)((la & 96u) + (la & 3u) + ((la & 12u) << 1) + ((la & 16u) >> 2));
            vb[i] = ord2f(rr[1] & ~127u); ib[i] = (int)((lb & 96u) + (lb & 3u) + ((lb & 12u) << 1) + ((lb & 16u) >> 2)); }
        unsigned ck[4][16]; int nc = 0; unsigned pend = 0u;
#pragma unroll
        for (int i = 0; i < 16; ++i)
#pragma unroll
            for (int j = 0; j < 16; ++j) if ((i + 1) * (j + 1) <= 16) {
                ck[nc >> 4][nc & 15] = (f2ord(va[i] + vb[j]) & ~63u) | (unsigned)nc;
                const unsigned id = (unsigned)(ia[i] * 128 + ib[j]);
                if (nc & 1) cpt[nc >> 1] = pend | (id << 16); else pend = id;
                ++nc; }
#pragma unroll
        for (int q = 50; q < 64; ++q) ck[q >> 4][q & 15] = 0u;
        sort16(ck[1]); sort16(ck[2]); sort16(ck[3]);
        top16_merge(ck[0], ck[1]); top16_merge(ck[2], ck[3]); top16_merge(ck[0], ck[2]);
        float bv[16]; int bi[16];
#pragma unroll
        for (int rd = 0; rd < 16; ++rd) { const unsigned mx = ck[0][rd], slot = mx & 63u;
            bv[rd] = ord2f(mx & ~63u); bi[rd] = (int)((cpt[slot >> 1] >> ((slot & 1u) * 16u)) & 0xffffu); }
        float e[16], es = 0.f;
#pragma unroll
        for (int k = 0; k < 16; ++k) { e[k] = __builtin_amdgcn_exp2f((bv[k] - bv[0]) * 1.4426950408889634f); es += e[k]; }
        const float inv = 1.f / es;
        const size_t ob = (size_t)(t0 + r32) * NSEL + h * 16 + hi * 8;
#pragma unroll
        for (int k = 0; k < 8; ++k) { IDX[ob + k] = hi ? bi[8 + k] : bi[k]; GATE[ob + k] = (hi ? e[8 + k] : e[k]) * inv; }
    }
}

__device__ __forceinline__ float dpp_row_sum(float v) {
    v += __builtin_bit_cast(float, __builtin_amdgcn_update_dpp(0, __builtin_bit_cast(int, v), 0xB1, 0xF, 0xF, false));
    v += __builtin_bit_cast(float, __builtin_amdgcn_update_dpp(0, __builtin_bit_cast(int, v), 0x4E, 0xF, 0xF, false));
    v += __builtin_bit_cast(float, __builtin_amdgcn_update_dpp(0, __builtin_bit_cast(int, v), 0x141, 0xF, 0xF, false));
    v += __builtin_bit_cast(float, __builtin_amdgcn_update_dpp(0, __builtin_bit_cast(int, v), 0x140, 0xF, 0xF, false));
    return v;
}
__device__ __forceinline__ float wave_sum_u(float v) {
    v = dpp_row_sum(v);
    return __builtin_bit_cast(float, __builtin_amdgcn_readlane(__builtin_bit_cast(int, v), 0)) + __builtin_bit_cast(float, __builtin_amdgcn_readlane(__builtin_bit_cast(int, v), 16)) +
           __builtin_bit_cast(float, __builtin_amdgcn_readlane(__builtin_bit_cast(int, v), 32)) + __builtin_bit_cast(float, __builtin_amdgcn_readlane(__builtin_bit_cast(int, v), 48));
}
#define FP8_DEC(WV, o) do { const f32x2 _a = __builtin_amdgcn_cvt_pk_f32_fp8((int)(WV)[0], false), _b = __builtin_amdgcn_cvt_pk_f32_fp8((int)(WV)[0], true), _c = __builtin_amdgcn_cvt_pk_f32_fp8((int)(WV)[1], false), _d = __builtin_amdgcn_cvt_pk_f32_fp8((int)(WV)[1], true), \
    _e = __builtin_amdgcn_cvt_pk_f32_fp8((int)(WV)[2], false), _f = __builtin_amdgcn_cvt_pk_f32_fp8((int)(WV)[2], true), _g = __builtin_amdgcn_cvt_pk_f32_fp8((int)(WV)[3], false), _h = __builtin_amdgcn_cvt_pk_f32_fp8((int)(WV)[3], true); \
    o[0] = _a.x; o[1] = _a.y; o[2] = _b.x; o[3] = _b.y; o[4] = _c.x; o[5] = _c.y; o[6] = _d.x; o[7] = _d.y; o[8] = _e.x; o[9] = _e.y; o[10] = _f.x; o[11] = _f.y; o[12] = _g.x; o[13] = _g.y; o[14] = _h.x; o[15] = _h.y; } while (0)

__device__ __forceinline__ void sort128_by_id(int& i0, float& g0, int& i1, float& g1, const int lane) {
#pragma unroll
    for (int k = 2; k <= 128; k <<= 1)
#pragma unroll
        for (int j = k >> 1; j >= 1; j >>= 1) {
            if (j == 64) { if (i0 > i1) { const int ti = i0; i0 = i1; i1 = ti; const float tg = g0; g0 = g1; g1 = tg; } }
            else {
                const bool lower = (lane & j) == 0;
                const bool up0 = (k == 128) ? true : ((lane & k) == 0), up1 = up0;
                const bool upr0 = (k == 64) ? true : up0, upr1 = (k == 64) ? false : up1;
                const int oi0 = __shfl_xor(i0, j), oi1 = __shfl_xor(i1, j); const float og0 = __shfl_xor(g0, j), og1 = __shfl_xor(g1, j);
                { const bool keep_min = (lower == upr0); const bool take = keep_min ? (oi0 < i0) : (oi0 > i0); i0 = take ? oi0 : i0; g0 = take ? og0 : g0; }
                { const bool keep_min = (lower == upr1); const bool take = keep_min ? (oi1 < i1) : (oi1 > i1); i1 = take ? oi1 : i1; g1 = take ? og1 : g1; }
            }
        }
}

__device__ __forceinline__ void p10_peer(Frame& F, const bool dummy) {
    const int lane = F.lane;
    const bf16_t* H = (const bf16_t*)(F.ws + WS_H);
    const unsigned char* U8 = F.ws + WS_U8; const unsigned char* V8 = F.ws + WS_V8;
    const float* SCU = (const float*)(F.ws + WS_SCU); const float* SCV = (const float*)(F.ws + WS_SCV);
    const int* IDX = (const int*)(F.ws + WS_IDX); const float* GATE = (const float*)(F.ws + WS_GATE);
    const float* modf = (const float*)(F.ws + WS_MODF); const float* const a_fing = karg(A_FING);
    constexpr int RING = 5;
    LAS unsigned char* const ring = F.lds + F.wave * 16384;
#define P10_FENCE() do { asm volatile("" ::: "memory"); __builtin_amdgcn_sched_barrier(0); } while (0)
#define PEER_ISSUE(TAB, slot, e) do { const int _e = (e) < NSEL ? (e) : NSEL - 1; const int _row = __builtin_amdgcn_readlane(_e < 64 ? i0 : i1, _e & 63); const char* _p = (const char*)(TAB) + (size_t)_row * PROW + 16 * lane; \
        _Pragma("unroll") for (int _s = 0; _s < 3; ++_s) __builtin_amdgcn_global_load_lds((const unsigned*)(_p + 1024 * _s), (LAS unsigned*)(ring + (slot) * PROW + 1024 * _s), 16, 0, 0); } while (0)
#define PEER_WAIT() asm volatile("s_waitcnt vmcnt(12)" ::: "memory")
#define PEER_RAW(slot) u32x4 _w0 = *(const LAS u32x4*)(ring + (slot) * PROW + 16 * lane), _w1 = *(const LAS u32x4*)(ring + (slot) * PROW + 1024 + 16 * lane), _w2 = *(const LAS u32x4*)(ring + (slot) * PROW + 2048 + 16 * lane)
#define PEER_DEC_A() __builtin_amdgcn_cvt_scalef32_pk32_f32_fp6((u32x6){_w0.x, _w0.y, _w0.z, _w0.w, _w1.x, _w1.y}, 1.0f)
#define PEER_DEC_B() __builtin_amdgcn_cvt_scalef32_pk32_f32_fp6((u32x6){_w1.z, _w1.w, _w2.x, _w2.y, _w2.z, _w2.w}, 1.0f)
#define PEER_PIN_B() asm volatile("" : "+v"(_w1.z), "+v"(_w1.w), "+v"(_w2.x), "+v"(_w2.y), "+v"(_w2.z), "+v"(_w2.w))
    for (int t = F.vcu * NWAVES + F.wave; t < TT; t += F.G * NWAVES) {
        int i0 = IDX[(size_t)t * NSEL + lane], i1 = IDX[(size_t)t * NSEL + 64 + lane];
        float g0 = GATE[(size_t)t * NSEL + lane], g1 = GATE[(size_t)t * NSEL + 64 + lane];
        sort128_by_id(i0, g0, i1, g1, lane);
        const float su0 = SCU[i0], su1 = SCU[i1], sv0 = SCV[i0], sv1 = SCV[i1];
        float a0, a1;
        {
            float hv[64];
#pragma unroll
            for (int grp = 0; grp < 2; ++grp) { const GAS u32x4* hp = (const GAS u32x4*)(H + (size_t)t * DM + grp * 2048 + 32 * lane);
#pragma unroll
                for (int q = 0; q < 4; ++q) { const u32x4 w = hp[q]; f32x4 a, b; unpack8(w, a, b); const int o = 32 * grp + 8 * q;
                    hv[o + 0] = a.x; hv[o + 1] = a.y; hv[o + 2] = a.z; hv[o + 3] = a.w; hv[o + 4] = b.x; hv[o + 5] = b.y; hv[o + 6] = b.z; hv[o + 7] = b.w; } }
            asm volatile("s_waitcnt vmcnt(0)" ::: "memory");
            P10_FENCE();
            float z0 = 0.f, z1 = 0.f;
#pragma unroll
            for (int k = 0; k < RING; ++k) PEER_ISSUE(U8, k, k);
            P10_FENCE();
            for (int e0 = 0; e0 < NSEL + RING - 1; e0 += RING) {
#pragma unroll
                for (int k = 0; k < RING; ++k) {
                    const int e = e0 + k; float p0 = 0.f, p1 = 0.f, p2 = 0.f, p3 = 0.f;
                    PEER_WAIT();
                    PEER_RAW(k);
                    { const f32x32 d = PEER_DEC_A();
#pragma unroll
                      for (int i = 0; i < 8; ++i) { p0 = fmaf(hv[i], d[i], p0); p1 = fmaf(hv[8 + i], d[8 + i], p1); p2 = fmaf(hv[16 + i], d[16 + i], p2); p3 = fmaf(hv[24 + i], d[24 + i], p3); } }
                    asm volatile("" : "+v"(p0), "+v"(p1), "+v"(p2), "+v"(p3)); PEER_PIN_B(); __builtin_amdgcn_sched_barrier(0);
                    { const f32x32 d = PEER_DEC_B();
#pragma unroll
                      for (int i = 0; i < 8; ++i) { p0 = fmaf(hv[32 + i], d[i], p0); p1 = fmaf(hv[40 + i], d[8 + i], p1); p2 = fmaf(hv[48 + i], d[16 + i], p2); p3 = fmaf(hv[56 + i], d[24 + i], p3); } }
                    float pz = (p0 + p1) + (p2 + p3);
                    asm volatile("" : "+v"(pz) :: "memory"); __builtin_amdgcn_sched_barrier(0);
                    PEER_ISSUE(U8, k, e + RING);
                    P10_FENCE();
                    const float z = wave_sum_u(pz);
                    z0 = (lane == e) ? z : z0; z1 = (lane == e - 64) ? z : z1;
                }
            }
            asm volatile("s_waitcnt vmcnt(0)" ::: "memory");
            z0 *= su0; z1 *= su1;
            a0 = 0.5f * z0 * (1.f + erff(z0 * 0.70710678118654752f)) * g0 * sv0; a1 = 0.5f * z1 * (1.f + erff(z1 * 0.70710678118654752f)) * g1 * sv1;
        }
        P10_FENCE();
        float ov[64];
#pragma unroll
        for (int i = 0; i < 64; ++i) ov[i] = 0.f;
#pragma unroll
        for (int k = 0; k < RING; ++k) PEER_ISSUE(V8, k, k);
        P10_FENCE();
        for (int e0 = 0; e0 < NSEL + RING - 1; e0 += RING) {
#pragma unroll
            for (int k = 0; k < RING; ++k) {
                const int e = e0 + k;
                float w = __builtin_bit_cast(float, __builtin_amdgcn_readlane(__builtin_bit_cast(int, e < 64 ? a0 : a1), e & 63));
                w = e < NSEL ? w : 0.f;
                PEER_WAIT();
                PEER_RAW(k);
                { const f32x32 d = PEER_DEC_A();
#pragma unroll
                  for (int i = 0; i < 32; ++i) asm("v_fmac_f32_e32 %0, %1, %2" : "+v"(ov[i]) : "v"(w), "v"(d[i])); }
                asm volatile("" : "+v"(ov[31]), "+v"(ov[15])); PEER_PIN_B(); __builtin_amdgcn_sched_barrier(0);
                { const f32x32 d = PEER_DEC_B();
#pragma unroll
                  for (int i = 0; i < 32; ++i) asm("v_fmac_f32_e32 %0, %1, %2" : "+v"(ov[32 + i]) : "v"(w), "v"(d[i])); }
                asm volatile("" : "+v"(ov[31]), "+v"(ov[63]) :: "memory"); __builtin_amdgcn_sched_barrier(0);
                PEER_ISSUE(V8, k, e + RING);
                P10_FENCE();
            }
        }
        asm volatile("s_waitcnt vmcnt(0)" ::: "memory");
        P10_FENCE();
        const int cb = cb_of_row(t);
        float* orow = F.out + (size_t)t * DM + 32 * lane;
        const float* g2 = modf + (size_t)cb * 6 * DM + 5 * DM + 32 * lane; const float* fg = a_fing + 32 * lane;
        float ss = 0.f;
        const bf16_t* x1r = (const bf16_t*)(F.ws + WS_GF) + (size_t)t * DM + 32 * lane;
#pragma unroll
        for (int grp = 0; grp < 2; ++grp) {
            u32x4 xr[4]; f32x4 gv[8];
#pragma unroll
            for (int q = 0; q < 4; ++q) xr[q] = *(const GAS u32x4*)(x1r + 2048 * grp + 8 * q);
#pragma unroll
            for (int q = 0; q < 8; ++q) gv[q] = *(const GAS f32x4*)(g2 + 2048 * grp + 4 * q);
            __builtin_amdgcn_sched_barrier(0);
#pragma unroll
            for (int q = 0; q < 4; ++q) { f32x4 xa, xb; unpack8(xr[q], xa, xb);
#pragma unroll
                for (int i = 0; i < 4; ++i) { const float x2 = xa[i] + gv[2 * q][i] * ov[32 * grp + 8 * q + i]; ov[32 * grp + 8 * q + i] = x2; ss = fmaf(x2, x2, ss); }
#pragma unroll
                for (int i = 0; i < 4; ++i) { const float x2 = xb[i] + gv[2 * q + 1][i] * ov[32 * grp + 8 * q + 4 + i]; ov[32 * grp + 8 * q + 4 + i] = x2; ss = fmaf(x2, x2, ss); } }
        }
        const float rs = __builtin_amdgcn_rsqf(wave_sum_u(ss) * (1.f / DM) + EPS);
        if (dummy) { if (lane == 0) ((float*)(F.ws + WS_MODP))[t] = rs; }
        else {
#pragma unroll
        for (int grp = 0; grp < 2; ++grp) {
            f32x4 fv[8];
#pragma unroll
            for (int q = 0; q < 8; ++q) fv[q] = *(const GAS f32x4*)(fg + 2048 * grp + 4 * q);
            __builtin_amdgcn_sched_barrier(0);
#pragma unroll
            for (int q = 0; q < 8; ++q) { f32x4 y;
#pragma unroll
                for (int i = 0; i < 4; ++i) y[i] = ov[32 * grp + 4 * q + i] * rs * fv[q][i];
                *(GAS f32x4*)(orow + 2048 * grp + 4 * q) = y; }
        }
        }
        asm volatile("s_waitcnt vmcnt(0)" ::: "memory");
        P10_FENCE();
    }
#undef PEER_ISSUE
#undef PEER_WAIT
#undef PEER_RAW
#undef PEER_DEC_A
#undef PEER_DEC_B
#undef PEER_PIN_B
#undef P10_FENCE
}

typedef __bf16 bf16x32_t __attribute__((ext_vector_type(32)));
typedef __bf16 bf16x2_t __attribute__((ext_vector_type(2)));
#define BM_DOT2(D, J, HW, ACC) __builtin_amdgcn_fdot2_f32_bf16((bf16x2_t){(D)[2 * (J)], (D)[2 * (J) + 1]}, __builtin_bit_cast(bf16x2_t, (unsigned)(HW)), (ACC), false)
#ifndef BM_LGNB
#define BM_LGNB 3
#endif
__device__ __forceinline__ void p10_peer_bm(Frame& F) { const bool dummy = false;
    const int lane = F.lane;
    const bf16_t* H = (const bf16_t*)(F.ws + WS_H);
    const unsigned char* U8 = F.ws + WS_U8; const unsigned char* V8 = F.ws + WS_V8;
    const float* SCU = (const float*)(F.ws + WS_SCU); const float* SCV = (const float*)(F.ws + WS_SCV);
    const int* IDX = (const int*)(F.ws + WS_IDX); const float* GATE = (const float*)(F.ws + WS_GATE);
    const float* modf = (const float*)(F.ws + WS_MODF); const float* const a_fing = karg(A_FING);
    constexpr int RING = 5;
    LAS unsigned char* const ring = F.lds + F.wave * 16384;
#define P10_FENCE() do { asm volatile("" ::: "memory"); __builtin_amdgcn_sched_barrier(0); } while (0)
#define PEER_ISSUE(TAB, slot, e) do { const int _e = (e) < NSEL ? (e) : NSEL - 1; const int _row = __builtin_amdgcn_readlane(_e < 64 ? i0 : i1, _e & 63); const char* _p = (const char*)(TAB) + (size_t)_row * PROW + 16 * lane; \
        _Pragma("unroll") for (int _s = 0; _s < 3; ++_s) __builtin_amdgcn_global_load_lds((const unsigned*)(_p + 1024 * _s), (LAS unsigned*)(ring + (slot) * PROW + 1024 * _s), 16, 0, 0); } while (0)
#define PEER_WAIT() asm volatile("s_waitcnt vmcnt(12)" ::: "memory")
#define PEER_RAW(slot) u32x4 _w0 = *(const LAS u32x4*)(ring + (slot) * PROW + 16 * lane), _w1 = *(const LAS u32x4*)(ring + (slot) * PROW + 1024 + 16 * lane), _w2 = *(const LAS u32x4*)(ring + (slot) * PROW + 2048 + 16 * lane)
#define PEER_DEC_A() __builtin_amdgcn_cvt_scalef32_pk32_f32_fp6((u32x6){_w0.x, _w0.y, _w0.z, _w0.w, _w1.x, _w1.y}, 1.0f)
#define PEER_DEC_B() __builtin_amdgcn_cvt_scalef32_pk32_f32_fp6((u32x6){_w1.z, _w1.w, _w2.x, _w2.y, _w2.z, _w2.w}, 1.0f)
#define PEER_PIN_B() asm volatile("" : "+v"(_w1.z), "+v"(_w1.w), "+v"(_w2.x), "+v"(_w2.y), "+v"(_w2.z), "+v"(_w2.w))
    float* const Zb = (float*)(F.ws + WS_Q + (size_t)96 * MiB);
    {
      const int tbase = F.vcu * NWAVES + F.wave, tstride = F.G * NWAVES, ntk = (TT - tbase + tstride - 1) / tstride;
#define BM_NEXT(M0, M1, E) do { if (M0) { E = (int)__builtin_ctzll(M0); M0 &= M0 - 1ull; } else { E = 64 + (int)__builtin_ctzll(M1); M1 &= M1 - 1ull; } } while (0)
#define BM_FETCH(B, J) do { if (m0 | m1) { int _e; BM_NEXT(m0, m1, _e); rowl = __builtin_amdgcn_readlane(_e < 64 ? gi0[J] : gi1[J], _e & 63); } \
        const char* _p = (const char*)U8 + (size_t)rowl * PROW + 16 * lane; \
        asm volatile("global_load_dwordx4 %0, %3, off\n\tglobal_load_dwordx4 %1, %3, off offset:1024\n\tglobal_load_dwordx4 %2, %3, off offset:2048" : "=&v"(B##0), "=&v"(B##1), "=&v"(B##2) : "v"(_p) : "memory"); } while (0)
#define BM_ROWWAIT(B) asm volatile("s_waitcnt vmcnt(9)" : "+v"(B##0), "+v"(B##1), "+v"(B##2) :: "memory")
#define BM_EAT(B, J) do { { BM_ROWWAIT(B); float p0 = 0.f, p1 = 0.f, p2 = 0.f, p3 = 0.f; \
          { const bf16x32_t d = __builtin_amdgcn_cvt_scalef32_pk32_bf16_fp6((u32x6){(B##0).x, (B##0).y, (B##0).z, (B##0).w, (B##1).x, (B##1).y}, 1.0f); \
            _Pragma("unroll") for (int j = 0; j < 4; ++j) { p0 = BM_DOT2(d, 4 * j, cur[J][4 * j], p0); p1 = BM_DOT2(d, 4 * j + 1, cur[J][4 * j + 1], p1); p2 = BM_DOT2(d, 4 * j + 2, cur[J][4 * j + 2], p2); p3 = BM_DOT2(d, 4 * j + 3, cur[J][4 * j + 3], p3); } } \
          { const bf16x32_t d = __builtin_amdgcn_cvt_scalef32_pk32_bf16_fp6((u32x6){(B##1).z, (B##1).w, (B##2).x, (B##2).y, (B##2).z, (B##2).w}, 1.0f); \
            _Pragma("unroll") for (int j = 0; j < 4; ++j) { p0 = BM_DOT2(d, 4 * j, cur[J][16 + 4 * j], p0); p1 = BM_DOT2(d, 4 * j + 1, cur[J][16 + 4 * j + 1], p1); p2 = BM_DOT2(d, 4 * j + 2, cur[J][16 + 4 * j + 2], p2); p3 = BM_DOT2(d, 4 * j + 3, cur[J][16 + 4 * j + 3], p3); } } \
          const float z = wave_sum_u((p0 + p1) + (p2 + p3)); int e = 255; if (c0 | c1) BM_NEXT(c0, c1, e); gz0[J] = (lane == e) ? z : gz0[J]; gz1[J] = (lane == e - 64) ? z : gz1[J]; } } while (0)
#define BM_UNIT(J) do { unsigned long long m0 = __ballot((gi0[J] >> (14 - BM_LGNB)) == bkt), m1 = __ballot((gi1[J] >> (14 - BM_LGNB)) == bkt); \
        const int n = __popcll(m0) + __popcll(m1); unsigned long long c0 = m0, c1 = m1; \
        if (n > 0) { int rowl = 0; u32x4 ra0, ra1, ra2, rb0, rb1, rb2, rc0, rc1, rc2, rd0, rd1, rd2; \
          BM_FETCH(ra, J); BM_FETCH(rb, J); BM_FETCH(rc, J); BM_FETCH(rd, J); \
          for (int done = 0; done < n; done += 4) { BM_EAT(ra, J); BM_FETCH(ra, J); BM_EAT(rb, J); BM_FETCH(rb, J); BM_EAT(rc, J); BM_FETCH(rc, J); BM_EAT(rd, J); BM_FETCH(rd, J); } \
          asm volatile("s_waitcnt vmcnt(0)" : "+v"(ra0), "+v"(ra1), "+v"(ra2), "+v"(rb0), "+v"(rb1), "+v"(rb2), "+v"(rc0), "+v"(rc1), "+v"(rc2), "+v"(rd0), "+v"(rd1), "+v"(rd2) :: "memory"); } } while (0)
      for (int g0 = 0; g0 < ntk; g0 += 4) {
        int gi0[4], gi1[4]; unsigned cur[4][32]; float gz0[4], gz1[4];
#pragma unroll
        for (int j = 0; j < 4; ++j) { const int kk = g0 + j < ntk ? g0 + j : ntk - 1; const int t = tbase + kk * tstride;
            gi0[j] = IDX[(size_t)t * NSEL + lane]; gi1[j] = IDX[(size_t)t * NSEL + 64 + lane]; gz0[j] = 0.f; gz1[j] = 0.f;
#pragma unroll
            for (int g = 0; g < 2; ++g) { const GAS u32x4* hp = (const GAS u32x4*)(H + (size_t)t * DM + g * 2048 + 32 * lane);
#pragma unroll
                for (int q = 0; q < 4; ++q) { const u32x4 w = hp[q]; cur[j][16 * g + 4 * q] = w.x; cur[j][16 * g + 4 * q + 1] = w.y; cur[j][16 * g + 4 * q + 2] = w.z; cur[j][16 * g + 4 * q + 3] = w.w; } } }
        asm volatile("s_waitcnt vmcnt(0)" ::: "memory");
        P10_FENCE();
        for (int bkt = 0; bkt < (1 << BM_LGNB); ++bkt) { BM_UNIT(0); BM_UNIT(1); BM_UNIT(2); BM_UNIT(3); }
#pragma unroll
        for (int j = 0; j < 4; ++j) { const int kk = g0 + j < ntk ? g0 + j : ntk - 1; const int t = tbase + kk * tstride; Zb[(size_t)t * NSEL + lane] = gz0[j]; Zb[(size_t)t * NSEL + 64 + lane] = gz1[j]; }
        asm volatile("s_waitcnt vmcnt(0)" ::: "memory");
        P10_FENCE();
      }
#undef BM_NEXT
#undef BM_FETCH
#undef BM_ROWWAIT
#undef BM_EAT
#undef BM_UNIT
    }
    for (int t = F.vcu * NWAVES + F.wave; t < TT; t += F.G * NWAVES) {
        int i0 = IDX[(size_t)t * NSEL + lane], i1 = IDX[(size_t)t * NSEL + 64 + lane];
        const float g0 = GATE[(size_t)t * NSEL + lane], g1 = GATE[(size_t)t * NSEL + 64 + lane];
        float z0 = Zb[(size_t)t * NSEL + lane], z1 = Zb[(size_t)t * NSEL + 64 + lane];
        const float su0 = SCU[i0], su1 = SCU[i1], sv0 = SCV[i0], sv1 = SCV[i1];
        z0 *= su0; z1 *= su1;
        float a0 = 0.5f * z0 * (1.f + erff(z0 * 0.70710678118654752f)) * g0 * sv0, a1 = 0.5f * z1 * (1.f + erff(z1 * 0.70710678118654752f)) * g1 * sv1;
        sort128_by_id(i0, a0, i1, a1, lane);
        asm volatile("s_waitcnt vmcnt(0)" ::: "memory");
        P10_FENCE();
        float ov[64];
#pragma unroll
        for (int i = 0; i < 64; ++i) ov[i] = 0.f;
#pragma unroll
        for (int k = 0; k < RING; ++k) PEER_ISSUE(V8, k, k);
        P10_FENCE();
        for (int e0 = 0; e0 < NSEL + RING - 1; e0 += RING) {
#pragma unroll
            for (int k = 0; k < RING; ++k) {
                const int e = e0 + k;
                float w = __builtin_bit_cast(float, __builtin_amdgcn_readlane(__builtin_bit_cast(int, e < 64 ? a0 : a1), e & 63));
                w = e < NSEL ? w : 0.f;
                PEER_WAIT();
                PEER_RAW(k);
                { const f32x32 d = PEER_DEC_A();
#pragma unroll
                  for (int i = 0; i < 32; ++i) asm("v_fmac_f32_e32 %0, %1, %2" : "+v"(ov[i]) : "v"(w), "v"(d[i])); }
                asm volatile("" : "+v"(ov[31]), "+v"(ov[15])); PEER_PIN_B(); __builtin_amdgcn_sched_barrier(0);
                { const f32x32 d = PEER_DEC_B();
#pragma unroll
                  for (int i = 0; i < 32; ++i) asm("v_fmac_f32_e32 %0, %1, %2" : "+v"(ov[32 + i]) : "v"(w), "v"(d[i])); }
                asm volatile("" : "+v"(ov[31]), "+v"(ov[63]) :: "memory"); __builtin_amdgcn_sched_barrier(0);
                PEER_ISSUE(V8, k, e + RING);
                P10_FENCE();
            }
        }
        asm volatile("s_waitcnt vmcnt(0)" ::: "memory");
        P10_FENCE();
        const int cb = cb_of_row(t);
        float* orow = F.out + (size_t)t * DM + 32 * lane;
        const float* g2 = modf + (size_t)cb * 6 * DM + 5 * DM + 32 * lane; const float* fg = a_fing + 32 * lane;
        float ss = 0.f;
        const bf16_t* x1r = (const bf16_t*)(F.ws + WS_GF) + (size_t)t * DM + 32 * lane;
#pragma unroll
        for (int grp = 0; grp < 2; ++grp) {
            u32x4 xr[4]; f32x4 gv[8];
#pragma unroll
            for (int q = 0; q < 4; ++q) xr[q] = *(const GAS u32x4*)(x1r + 2048 * grp + 8 * q);
#pragma unroll
            for (int q = 0; q < 8; ++q) gv[q] = *(const GAS f32x4*)(g2 + 2048 * grp + 4 * q);
            __builtin_amdgcn_sched_barrier(0);
#pragma unroll
            for (int q = 0; q < 4; ++q) { f32x4 xa, xb; unpack8(xr[q], xa, xb);
#pragma unroll
                for (int i = 0; i < 4; ++i) { const float x2 = xa[i] + gv[2 * q][i] * ov[32 * grp + 8 * q + i]; ov[32 * grp + 8 * q + i] = x2; ss = fmaf(x2, x2, ss); }
#pragma unroll
                for (int i = 0; i < 4; ++i) { const float x2 = xb[i] + gv[2 * q + 1][i] * ov[32 * grp + 8 * q + 4 + i]; ov[32 * grp + 8 * q + 4 + i] = x2; ss = fmaf(x2, x2, ss); } }
        }
        const float rs = __builtin_amdgcn_rsqf(wave_sum_u(ss) * (1.f / DM) + EPS);
        if (dummy) { if (lane == 0) ((float*)(F.ws + WS_MODP))[t] = rs; }
        else {
#pragma unroll
        for (int grp = 0; grp < 2; ++grp) {
            f32x4 fv[8];
#pragma unroll
            for (int q = 0; q < 8; ++q) fv[q] = *(const GAS f32x4*)(fg + 2048 * grp + 4 * q);
            __builtin_amdgcn_sched_barrier(0);
#pragma unroll
            for (int q = 0; q < 8; ++q) { f32x4 y;
#pragma unroll
                for (int i = 0; i < 4; ++i) y[i] = ov[32 * grp + 4 * q + i] * rs * fv[q][i];
                *(GAS f32x4*)(orow + 2048 * grp + 4 * q) = y; }
        }
        }
        asm volatile("s_waitcnt vmcnt(0)" ::: "memory");
        P10_FENCE();
    }
#undef PEER_ISSUE
#undef PEER_WAIT
#undef PEER_RAW
#undef PEER_DEC_A
#undef PEER_DEC_B
#undef PEER_PIN_B
#undef P10_FENCE
}

#ifdef PEER_REF_PROBE
__device__ __forceinline__ void p10_peer_ref(Frame& F) {
    const int lane = F.lane;
    const bf16_t* H = (const bf16_t*)(F.ws + WS_H);
    const int* IDX = (const int*)(F.ws + WS_IDX); const float* GATE = (const float*)(F.ws + WS_GATE);
    const float* modf = (const float*)(F.ws + WS_MODF); const float* const a_fing = karg(A_FING); const float* const a_pu = karg(A_PU); const float* const a_pv = karg(A_PV);
    for (int t = F.vcu * NWAVES + F.wave; t < TT; t += F.G * NWAVES) {
        const int i0 = IDX[(size_t)t * NSEL + lane], i1 = IDX[(size_t)t * NSEL + 64 + lane];
        const float g0 = GATE[(size_t)t * NSEL + lane], g1 = GATE[(size_t)t * NSEL + 64 + lane];
        float hv[64];
#pragma unroll
        for (int grp = 0; grp < 2; ++grp) { const GAS u32x4* hp = (const GAS u32x4*)(H + (size_t)t * DM + grp * 2048 + 32 * lane);
#pragma unroll
            for (int q = 0; q < 4; ++q) { const u32x4 w = hp[q]; f32x4 a, b; unpack8(w, a, b); const int o = 32 * grp + 8 * q;
                hv[o + 0] = a.x; hv[o + 1] = a.y; hv[o + 2] = a.z; hv[o + 3] = a.w; hv[o + 4] = b.x; hv[o + 5] = b.y; hv[o + 6] = b.z; hv[o + 7] = b.w; } }
        float z0 = 0.f, z1 = 0.f;
        for (int e = 0; e < NSEL; ++e) {
            const int row = __builtin_amdgcn_readlane(e < 64 ? i0 : i1, e & 63); const float* up = a_pu + (size_t)row * DM + 32 * lane; float part = 0.f;
#pragma unroll
            for (int grp = 0; grp < 2; ++grp)
#pragma unroll
                for (int q = 0; q < 8; ++q) { const f32x4 u = *(const GAS f32x4*)(up + 2048 * grp + 4 * q);
#pragma unroll
                    for (int i = 0; i < 4; ++i) part = fmaf(hv[32 * grp + 4 * q + i], u[i], part); }
            const float z = wave_sum_u(part);
            z0 = (lane == e) ? z : z0; z1 = (lane == e - 64) ? z : z1;
        }
        const float a0 = 0.5f * z0 * (1.f + erff(z0 * 0.70710678118654752f)) * g0, a1 = 0.5f * z1 * (1.f + erff(z1 * 0.70710678118654752f)) * g1;
        float ov[64];
#pragma unroll
        for (int i = 0; i < 64; ++i) ov[i] = 0.f;
        for (int e = 0; e < NSEL; ++e) {
            const int row = __builtin_amdgcn_readlane(e < 64 ? i0 : i1, e & 63); const float* vp = a_pv + (size_t)row * DM + 32 * lane;
            const float w = __builtin_bit_cast(float, __builtin_amdgcn_readlane(__builtin_bit_cast(int, e < 64 ? a0 : a1), e & 63));
#pragma unroll
            for (int grp = 0; grp < 2; ++grp)
#pragma unroll
                for (int q = 0; q < 8; ++q) { const f32x4 v = *(const GAS f32x4*)(vp + 2048 * grp + 4 * q);
#pragma unroll
                    for (int i = 0; i < 4; ++i) asm("v_fmac_f32_e32 %0, %1, %2" : "+v"(ov[32 * grp + 4 * q + i]) : "v"(w), "v"(v[i])); }
        }
        const int cb = cb_of_row(t);
        float* orow = F.out + (size_t)t * DM + 32 * lane;
        const float* g2 = modf + (size_t)cb * 6 * DM + 5 * DM + 32 * lane; const float* fg = a_fing + 32 * lane;
        float ss = 0.f;
#pragma unroll
        for (int grp = 0; grp < 2; ++grp)
#pragma unroll
            for (int q = 0; q < 8; ++q) { const f32x4 gv = *(const GAS f32x4*)(g2 + 2048 * grp + 4 * q); const bf16_t* xb = (const bf16_t*)(F.ws + WS_GF) + (size_t)t * DM + 32 * lane + 2048 * grp + 4 * q;
#pragma unroll
                for (int i = 0; i < 4; ++i) { const float x2 = __uint_as_float((unsigned)xb[i] << 16) + gv[i] * ov[32 * grp + 4 * q + i]; ov[32 * grp + 4 * q + i] = x2; ss = fmaf(x2, x2, ss); } }
        const float rs = __builtin_amdgcn_rsqf(wave_sum_u(ss) * (1.f / DM) + EPS);
#pragma unroll
        for (int grp = 0; grp < 2; ++grp)
#pragma unroll
            for (int q = 0; q < 8; ++q) { const f32x4 fv = *(const GAS f32x4*)(fg + 2048 * grp + 4 * q); f32x4 y;
#pragma unroll
                for (int i = 0; i < 4; ++i) y[i] = ov[32 * grp + 4 * q + i] * rs * fv[i];
                *(GAS f32x4*)(orow + 2048 * grp + 4 * q) = y; }
    }
}
#endif

#ifndef DUP_PHASE
#define DUP_PHASE -1
#endif
#define DUP(k) for (int _rep = 0; _rep < ((DUP_PHASE == (k)) ? 2 : 1); ++_rep)
#ifndef MK_N_LAUNCHES
#define MK_N_LAUNCHES 1
#endif
constexpr int N_PHASES = 12;
struct Args { const float* in[19]; float* out; unsigned char* ws; int ph_lo, ph_hi; };
__global__ void __launch_bounds__(NWAVES * 64, 2) fwd(Args args) {
    extern __shared__ __attribute__((aligned(16))) unsigned char lds[];
    Frame F;
    F.lds = (LAS unsigned char*)lds;
    F.tid = threadIdx.x; F.lane = F.tid & 63; F.wave = __builtin_amdgcn_readfirstlane(F.tid >> 6);
    F.G = gridDim.x; { const int bx = blockIdx.x; F.vcu = (F.G % 8 == 0) ? (bx % 8) * (F.G / 8) + bx / 8 : bx; }
    F.out = args.out; F.ws = args.ws;
    unsigned char* ws = args.ws;
    volatile LAS unsigned* MISC = (volatile LAS unsigned*)(F.lds + MISC_OFF);
    if (F.tid < 32) MISC[F.tid] = 0u;
    __syncthreads();
    const int lo = args.ph_lo, hi = args.ph_hi;
    XcdBarrier bar; bar.bar = (unsigned*)(ws + WS_CTL) + CW_BAR; bar.x = 0; bar.st = nullptr;
    if (hi - lo > 1) bar = xcd_barrier_post((unsigned*)(ws + WS_CTL) + CW_BAR, MISC + 8, F.tid);
#ifdef ONLY_PHASE
#define IN(k) ((k) == ONLY_PHASE && lo <= (k) && (k) < hi)
#else
#define IN(k) (lo <= (k) && (k) < hi)
#endif
#define SEAM(k) do { if (IN(k) && IN((k) + 1)) { xcd_barrier(bar, opaque_tid(F.wave)); } } while (0)
    bf16_t* const Hb = (bf16_t*)(ws + WS_H); bf16_t* const Qb = (bf16_t*)(ws + WS_Q); bf16_t* const Fb = (bf16_t*)(ws + WS_F);
    bf16_t* const GAb = (bf16_t*)(ws + WS_GA); bf16_t* const GFb = (bf16_t*)(ws + WS_GF);
    bf16_t* const L0P = Hb; bf16_t* const L0S = Hb + (size_t)2 * NFG * FG * (2 * SP);
    unsigned char* const M8 = ws + WS_H + (size_t)96 * MiB;
    bf16_t* const L1P = (bf16_t*)(ws + WS_L1); bf16_t* const L1S = L1P + (size_t)2 * NFG * FG * (2 * SP);

#define REFRESH() do { F.tid = opaque_tid(F.wave); F.lane = F.tid & 63; } while (0)
    if (IN(0)) { REFRESH(); p0_prologue(F); if (DUP_PHASE == 0) { __syncthreads(); REFRESH(); p0_prologue(F); } } SEAM(0);
    if (IN(1)) { DUP(1) { REFRESH(); p_normmod<false>(F); } } SEAM(1);
    if (IN(2)) {
        pg8::GemmPlain g{Hb, (const bf16_t*)(ws + WS_WIN), DM / 2, DM / 2, DM / 2}; pg8::StaticOrder S; S.init(TT, NIN, F.G, (int)blockIdx.x);
        EpiProj E{ws}; DUP(2) pg8::gemm_phase<EpiProj, pg8::GemmPlain, true, true, true>(F.lds, g, S, E, F.wave);
    } SEAM(2);
    if (IN(3)) {
        REFRESH(); p3_qk_rope(F);
#if ATTN_FP8
        REFRESH(); p3_vt(F);
#endif
        if (blockIdx.x == 0 && F.tid < 128) ((unsigned*)(ws + WS_L1 + (size_t)192 * MiB))[F.tid] = 0u;
        int kc_ = FG; asm volatile("" : "+s"(kc_));
        DUP(3) {
        { GemmSt0 g{(const bf16_t*)(ws + WS_CS), Fb, kc_, FG, FW, 32, 5, 4, 0, SP}; pg8::StaticOrder S; S.init(512, NFG * TP, F.G, (int)blockIdx.x);
          EpiSt0 E{L0P, 32, 5, 4}; pg8::gemm_phase<EpiSt0, GemmSt0>(F.lds, g, S, E, F.wave); }
        { GemmSt0 g{(const bf16_t*)(ws + WS_CS), Fb, kc_, FG, FW, 64, 6, 5, TP, SS}; pg8::StaticOrder S; S.init(512, NFG * TS, F.G, (int)blockIdx.x);
          EpiSt0 E{L0S, 64, 6, 5}; pg8::gemm_phase<EpiSt0, GemmSt0>(F.lds, g, S, E, F.wave); }
        }
    } SEAM(3);
    if (IN(4)) {
        int kc_ = 256; asm volatile("" : "+s"(kc_));
        pg8::GemmPlain g{(const bf16_t*)(ws + WS_D128), L0P, kc_, 256, 256}; pg8::StaticOrder S; S.init(256, 2 * NFG * FG * (32 + 64), F.G, (int)blockIdx.x);
        EpiSt1 E{L1P, L1S}; DUP(4) pg8::gemm_phase<EpiSt1, pg8::GemmPlain>(F.lds, g, S, E, F.wave);
    } SEAM(4);
    if (IN(5)) {
        int kc_ = 128; asm volatile("" : "+s"(kc_));
        DUP(51) {
        { pg8::GemmPlain g{(const bf16_t*)(ws + WS_DS32), L1P, kc_, 256, 64}; pg8::StaticOrder S; S.init(256, 2 * NFG * 128 * FG, F.G, (int)blockIdx.x);
          EpiSt2 E{(unsigned char*)Fb, 32, SP, 0.015625f}; pg8::gemm_phase<EpiSt2, pg8::GemmPlain>(F.lds, g, S, E, F.wave); }
        { pg8::GemmPlain g{(const bf16_t*)(ws + WS_DS64), L1S, kc_, 256, 128}; pg8::StaticOrder S; S.init(256, 2 * NFG * 128 * FG, F.G, (int)blockIdx.x);
          EpiSt2 E{(unsigned char*)Fb + (size_t)TP * FW, 64, SS, 0.011048543456039806f}; pg8::gemm_phase<EpiSt2, pg8::GemmPlain>(F.lds, g, S, E, F.wave); }
        }
        if (DUP_PHASE == 50) { REFRESH(); p4_attention(F, (char*)lds, true); }
        REFRESH(); p4_attention(F, (char*)lds, false);
    } SEAM(5);
    if (IN(6)) {
        { pg8::GemmPlain g{Hb, (const bf16_t*)(ws + WS_WATT), DM / 2, DM / 2, DM / 2}; pg8::StaticOrder S; S.init(TT, DM, F.G, (int)blockIdx.x);
          EpiGateA E{GAb, ws + WS_GA8, (const float*)(ws + WS_SCIN) + 1}; pg8::gemm_phase<EpiGateA, pg8::GemmPlain, true, true, true>(F.lds, g, S, E, F.wave); }
        { pg8::GemmPlain g{Fb, (const bf16_t*)(ws + WS_WFOUR), FW / 2, FW / 2, FW / 2}; pg8::StaticOrder S; S.init(TT, DM, F.G, (int)blockIdx.x);
          EpiGateF E{GAb, ws + WS_GF, M8, (const float*)(ws + WS_SCIN) + 3}; pg8::gemm_phase<EpiGateF, pg8::GemmPlain, true, true, true>(F.lds, g, S, E, F.wave); }
    } SEAM(6);
    if (IN(7)) {
        pg8::GemmPlain g{(const bf16_t*)M8, (const bf16_t*)(ws + WS_WOUT), DM / 2, DM / 2, DM / 2}; pg8::StaticOrder S; S.init(TT, DM, F.G, (int)blockIdx.x);
        EpiResid E{karg(A_XP), karg(A_XS), (const float*)(ws + WS_MODF), GFb, (const float*)(ws + WS_SCIN) + 2}; DUP(7) pg8::gemm_phase<EpiResid, pg8::GemmPlain, true, true, true>(F.lds, g, S, E, F.wave);
    } SEAM(7);
    if (IN(8)) { REFRESH(); p_normmod<true>(F); } SEAM(8);
    if (IN(9)) {
        pg8::GemmPlain g{Hb, (const bf16_t*)(ws + WS_WPQ), DM, DM, DM}; pg8::StaticOrder S; S.init(TT, PQW, F.G, (int)blockIdx.x);
        EpiPlain E{Qb, PQW}; DUP(9) pg8::gemm_phase<EpiPlain, pg8::GemmPlain>(F.lds, g, S, E, F.wave);
    } SEAM(9);
    if (IN(10)) { DUP(10) { REFRESH(); p9_route(F); } } SEAM(10);
#ifdef PEER_REF_PROBE
    if (IN(11)) { REFRESH(); p10_peer_ref(F); }
#else
    if (IN(11)) { if (DUP_PHASE == 11) { REFRESH(); p10_peer(F, true); } REFRESH(); p10_peer_bm(F); }
#endif
#undef IN
#undef SEAM
}

extern "C" void kernel_launch(void* const* d_in, const int* in_sizes, int n_in, void* d_out, int out_size, void* d_ws, size_t ws_size, hipStream_t stream) {
    static int grid = 0;
    if (grid == 0) {
        if (n_in != 19 || in_sizes[0] != TP * DM || in_sizes[1] != TS * DM || out_size != TT * DM || ws_size < WS_END) {
            fprintf(stderr, "kernel_launch: unexpected shapes: n_in %d in0 %d in1 %d out %d ws %zu (need %zu); nothing launched\n", n_in, n_in > 0 ? in_sizes[0] : -1, n_in > 1 ? in_sizes[1] : -1, out_size, ws_size, (size_t)WS_END); grid = -1; return; }
        int dev = 0, cus = 0, per_cu = 0;
        if (hipGetDevice(&dev) != hipSuccess || hipDeviceGetAttribute(&cus, hipDeviceAttributeMultiprocessorCount, dev) != hipSuccess) { grid = -1; return; }
        if (hipFuncSetAttribute((const void*)fwd, hipFuncAttributeMaxDynamicSharedMemorySize, LDS_BYTES) != hipSuccess) { fprintf(stderr, "kernel_launch: hipFuncSetAttribute failed\n"); grid = -1; return; }
        if (hipOccupancyMaxActiveBlocksPerMultiprocessor(&per_cu, (const void*)fwd, NWAVES * 64, LDS_BYTES) != hipSuccess || per_cu < 1) { fprintf(stderr, "kernel_launch: occupancy query says %d workgroups per CU\n", per_cu); (void)hipGetLastError(); grid = -1; return; }
        grid = cus;
    }
    if (grid < 0) return;
    if (hipMemsetAsync((char*)d_ws + WS_CTL, 0, CTL_ZERO_BYTES, stream) != hipSuccess) return;
    Args a{};
    for (int i = 0; i < 19; ++i) a.in[i] = (const float*)d_in[i];
    a.out = (float*)d_out; a.ws = (unsigned char*)d_ws;
#if MK_N_LAUNCHES == 1
    a.ph_lo = 0; a.ph_hi = N_PHASES;
    hipLaunchKernelGGL(fwd, dim3(grid), dim3(NWAVES * 64), LDS_BYTES, stream, a);
#else
    for (int p = 0; p < N_PHASES; ++p) { a.ph_lo = p; a.ph_hi = p + 1; hipLaunchKernelGGL(fwd, dim3(grid), dim3(NWAVES * 64), LDS_BYTES, stream, a); }
#endif
}
```
